# Optimizing an MI355X kernel written in HIP

```python
import jax, jax.numpy as jnp
from jax import lax
import numpy as np

D_MODEL = 1024
BATCH = 32
SEQ = 2048
DEPTH = 1
DEC_BATCH = 32
DEC_SEQ = 16
PAST_LEN = 4096

CHUNK = 64
WINDOW = 128
WIN_CHUNKS = WINDOW // CHUNK
HEAD_DIM = 64
ATT_HEADS = 8
ATT_KV_HEADS = 2
ATT_GROUP = ATT_HEADS // ATT_KV_HEADS
ATT_SCALE = HEAD_DIM ** -0.5
ROPE_THETA = 10000.0
RWKV_HEADS = 8
RWKV_N = 64
RWKV_W = RWKV_HEADS * RWKV_N
DECAY_LORA = 64
AAA_LORA = 64
GATE_LORA = 160
D_FF = 4 * D_MODEL
ATT_Q = ATT_HEADS * HEAD_DIM
ATT_KV = ATT_KV_HEADS * HEAD_DIM
ATT_COLS = ATT_Q + 2 * ATT_KV
RWKV_COLS = 3 * RWKV_W + DECAY_LORA + AAA_LORA + GATE_LORA
IN_COLS = ATT_COLS + RWKV_COLS
MIX_W = ATT_Q + RWKV_W
RWKV_SPLITS = (RWKV_W, 2 * RWKV_W, 3 * RWKV_W, 3 * RWKV_W + DECAY_LORA, 3 * RWKV_W + DECAY_LORA + AAA_LORA)
NORM_EPS = 1e-6
GN_EPS = 64e-5

kernel_name = 'hymba_swa_sink_rwkv7_stream_step'


def _rms(x, g, eps=NORM_EPS):
    xf = x.astype(jnp.float32)
    y = xf * lax.rsqrt(jnp.mean(xf * xf, axis=-1, keepdims=True) + eps)
    return (y * g.astype(jnp.float32)).astype(x.dtype)


def _rope(x, pos):
    half = HEAD_DIM // 2
    inv = ROPE_THETA ** (-jnp.arange(half, dtype=jnp.float32) / half)
    ang = pos.astype(jnp.float32)[:, None] * inv[None, :]
    cos = jnp.cos(ang)[:, None, :]
    sin = jnp.sin(ang)[:, None, :]
    xf = x.astype(jnp.float32)
    x1, x2 = xf[..., :half], xf[..., half:]
    return jnp.concatenate([x1 * cos - x2 * sin, x2 * cos + x1 * sin], axis=-1).astype(x.dtype)


def _sink_probs(s, sink):
    m = jnp.maximum(jnp.max(s, axis=-1), sink)
    p = jnp.exp(s - m[..., None])
    denom = jnp.sum(p, axis=-1) + jnp.exp(sink - m)
    return p / denom[..., None]


def _swa_prompt(q, k, v, sinks):
    B, S = q.shape[:2]
    nc = S // CHUNK
    span = (WIN_CHUNKS + 1) * CHUNK
    qb = q.reshape(B, nc, CHUNK, ATT_KV_HEADS, ATT_GROUP, HEAD_DIM)
    pad = ((0, 0), (WIN_CHUNKS * CHUNK, 0), (0, 0), (0, 0))
    kp = jnp.pad(k, pad).reshape(B, nc + WIN_CHUNKS, CHUNK, ATT_KV_HEADS, HEAD_DIM)
    vp = jnp.pad(v, pad).reshape(B, nc + WIN_CHUNKS, CHUNK, ATT_KV_HEADS, HEAD_DIM)
    kb = jnp.concatenate([kp[:, j:j + nc] for j in range(WIN_CHUNKS + 1)], axis=2)
    vb = jnp.concatenate([vp[:, j:j + nc] for j in range(WIN_CHUNKS + 1)], axis=2)
    s = jnp.einsum('bnqkgd,bnskd->bnkgqs', qb, kb, preferred_element_type=jnp.float32) * ATT_SCALE
    key_chunk = jnp.arange(nc)[:, None] + jnp.arange(span)[None, :] // CHUNK - WIN_CHUNKS
    s = jnp.where((key_chunk >= 0)[None, :, None, None, None, :], s, -jnp.inf)
    sink = sinks.reshape(ATT_KV_HEADS, ATT_GROUP)[:, :, None].astype(jnp.float32)
    pr = _sink_probs(s, sink)
    o = jnp.einsum('bnkgqs,bnskd->bnqkgd', pr.astype(vb.dtype), vb, preferred_element_type=jnp.float32)
    return o.reshape(B, S, ATT_Q).astype(q.dtype)


def _swa_sample(q, k_all, v_all, sinks):
    B, T = q.shape[:2]
    qg = q.reshape(B, T, ATT_KV_HEADS, ATT_GROUP, HEAD_DIM)
    s = jnp.einsum('btkgd,bskd->bkgts', qg, k_all, preferred_element_type=jnp.float32) * ATT_SCALE
    sink = sinks.reshape(ATT_KV_HEADS, ATT_GROUP)[:, :, None].astype(jnp.float32)
    pr = _sink_probs(s, sink)
    o = jnp.einsum('bkgts,bskd->btkgd', pr.astype(v_all.dtype), v_all, preferred_element_type=jnp.float32)
    return o.reshape(B, T, ATT_Q).astype(q.dtype)


def _wkv_scan(r, w, k, v, a, b, s0):
    def step(S, inp):
        r_t, w_t, k_t, v_t, a_t, b_t = inp
        sa = jnp.einsum('bhij,bhj->bhi', S, a_t)
        S = S * w_t[:, :, None, :] + sa[..., None] * b_t[:, :, None, :] + v_t[..., None] * k_t[:, :, None, :]
        y = jnp.einsum('bhij,bhj->bhi', S, r_t)
        return S, y
    xs = tuple(jnp.moveaxis(t, 1, 0) for t in (r, w, k, v, a, b))
    s_last, ys = lax.scan(step, s0.astype(jnp.float32), xs)
    return jnp.moveaxis(ys, 0, 1), s_last


def _rwkv(p_rw, shift_prev, wkv0, shift_mu, decay_w0, decay_w2, iclr_a0, iclr_a2, gate_g2,
          k_k, k_a, r_k, lnx_g, lnx_b):
    B, T = p_rw.shape[:2]
    f32 = jnp.float32
    prev = jnp.concatenate([shift_prev[:, None, :].astype(p_rw.dtype), p_rw[:, :-1]], axis=1)
    xs = p_rw + (prev - p_rw) * shift_mu
    r, k, v, wd, ad, gd = jnp.split(xs, RWKV_SPLITS, axis=-1)
    w = -jax.nn.softplus(-(decay_w0 + jnp.tanh(wd) @ decay_w2)) - 0.5
    a = jax.nn.sigmoid(iclr_a0 + ad @ iclr_a2)
    g = jax.nn.sigmoid(gd) @ gate_g2
    heads = lambda t: t.reshape(B, T, RWKV_HEADS, RWKV_N).astype(f32)
    kk = heads(k * k_k)
    kk = kk / jnp.maximum(jnp.sqrt(jnp.sum(kk * kk, axis=-1, keepdims=True)), 1e-12)
    k = k * (1 + (a - 1) * k_a)
    rh, kh, vh, ah = heads(r), heads(k), heads(v), heads(a)
    decay = jnp.exp(-jnp.exp(heads(w)))
    y, wkv = _wkv_scan(rh, decay, kh, vh, -kk, kk * ah, wkv0)
    mu = jnp.mean(y, axis=-1, keepdims=True)
    var = jnp.mean(jnp.square(y - mu), axis=-1, keepdims=True)
    y = ((y - mu) * lax.rsqrt(var + GN_EPS)).reshape(B, T, RWKV_W) * lnx_g.astype(f32) + lnx_b.astype(f32)
    bonus = jnp.sum(rh * kh * r_k.astype(f32), axis=-1, keepdims=True) * vh
    y = (y + bonus.reshape(B, T, RWKV_W)) * g.astype(f32)
    return y.astype(p_rw.dtype), wkv, p_rw[:, -1]


def _layer(x, pos, k_past, v_past, shift_prev, wkv0, ln1_g, w_in, q_norm_g, k_norm_g, attn_sinks,
           shift_mu, decay_w0, decay_w2, iclr_a0, iclr_a2, gate_g2, k_k, k_a, r_k, lnx_g, lnx_b,
           w_out, ln2_g, w_up, w_down):
    B, T, _ = x.shape
    h = _rms(x, ln1_g)
    p = h @ w_in
    q, k, v, p_rw = jnp.split(p, (ATT_Q, ATT_Q + ATT_KV, ATT_COLS), axis=-1)
    q = _rope(_rms(q.reshape(B, T, ATT_HEADS, HEAD_DIM), q_norm_g), pos)
    k = _rope(_rms(k.reshape(B, T, ATT_KV_HEADS, HEAD_DIM), k_norm_g), pos)
    v = v.reshape(B, T, ATT_KV_HEADS, HEAD_DIM)
    if k_past is None:
        att = _swa_prompt(q, k, v, attn_sinks)
        rows = min(WINDOW, T)
        new_k, new_v = k[:, T - rows:], v[:, T - rows:]
    else:
        k_all = jnp.concatenate([k_past.astype(k.dtype), k], axis=1)
        v_all = jnp.concatenate([v_past.astype(v.dtype), v], axis=1)
        att = _swa_sample(q, k_all, v_all, attn_sinks)
        new_k, new_v = k, v
    rw, wkv, shift_last = _rwkv(p_rw, shift_prev, wkv0, shift_mu, decay_w0, decay_w2, iclr_a0, iclr_a2,
                                gate_g2, k_k, k_a, r_k, lnx_g, lnx_b)
    x = x + jnp.concatenate([att, rw], axis=-1) @ w_out
    u = jax.nn.relu(_rms(x, ln2_g) @ w_up)
    x = x + (u * u) @ w_down
    return x, new_k, new_v, wkv, shift_last


def setup_inputs(seed: int = 0) -> dict:
    key = jax.random.key(seed)
    ks = iter(jax.random.split(key, 32))
    nrm = lambda shape, scale: jax.random.normal(next(ks), shape, jnp.float32) * scale
    L = DEPTH
    kv_rows = min(WINDOW, PAST_LEN)
    return {
        'x_prompt': nrm((BATCH, SEQ, D_MODEL), 1.0),
        'x_sample': nrm((DEC_BATCH, DEC_SEQ, D_MODEL), 1.0),
        'cache_attn_k': nrm((L, DEC_BATCH, kv_rows, ATT_KV_HEADS, HEAD_DIM), 1.0),
        'cache_attn_v': nrm((L, DEC_BATCH, kv_rows, ATT_KV_HEADS, HEAD_DIM), 1.0),
        'state_rwkv_wkv': nrm((L, DEC_BATCH, RWKV_HEADS, RWKV_N, RWKV_N), 0.3),
        'state_rwkv_shift': nrm((L, DEC_BATCH, RWKV_COLS), 1.0),
        'ln1_g': 1.0 + nrm((L, D_MODEL), 0.02),
        'w_in': nrm((L, D_MODEL, IN_COLS), D_MODEL ** -0.5),
        'q_norm_g': 1.0 + nrm((L, HEAD_DIM), 0.02),
        'k_norm_g': 1.0 + nrm((L, HEAD_DIM), 0.02),
        'attn_sinks': nrm((L, ATT_HEADS), 0.5),
        'shift_mu': jax.random.uniform(next(ks), (L, RWKV_COLS), jnp.float32),
        'decay_w0': -1.0 + nrm((L, RWKV_W), 0.5),
        'decay_w2': nrm((L, DECAY_LORA, RWKV_W), 0.5 * DECAY_LORA ** -0.5),
        'iclr_a0': nrm((L, RWKV_W), 0.3),
        'iclr_a2': nrm((L, AAA_LORA, RWKV_W), 0.5 * AAA_LORA ** -0.5),
        'gate_g2': nrm((L, GATE_LORA, RWKV_W), GATE_LORA ** -0.5),
        'k_k': 0.85 + nrm((L, RWKV_W), 0.02),
        'k_a': 1.0 + nrm((L, RWKV_W), 0.02),
        'r_k': nrm((L, RWKV_HEADS, RWKV_N), 0.1),
        'lnx_g': 1.0 + nrm((L, RWKV_W), 0.02),
        'lnx_b': nrm((L, RWKV_W), 0.02),
        'w_out': nrm((L, MIX_W, D_MODEL), MIX_W ** -0.5),
        'ln2_g': 1.0 + nrm((L, D_MODEL), 0.02),
        'w_up': nrm((L, D_MODEL, D_FF), D_MODEL ** -0.5),
        'w_down': nrm((L, D_FF, D_MODEL), D_FF ** -0.5),
    }


def reference(x_prompt, x_sample, cache_attn_k, cache_attn_v, state_rwkv_wkv, state_rwkv_shift,
              ln1_g, w_in, q_norm_g, k_norm_g, attn_sinks, shift_mu, decay_w0, decay_w2, iclr_a0, iclr_a2,
              gate_g2, k_k, k_a, r_k, lnx_g, lnx_b, w_out, ln2_g, w_up, w_down):
    Bp, Tp = x_prompt.shape[:2]
    Bs, Ts = x_sample.shape[:2]
    pos_p = jnp.arange(Tp)
    pos_s = PAST_LEN + jnp.arange(Ts)
    hp, hs = x_prompt, x_sample
    p_k, p_v, p_wkv, p_shift = [], [], [], []
    s_k, s_v, s_wkv, s_shift = [], [], [], []
    for l in range(DEPTH):
        lw = (ln1_g[l], w_in[l], q_norm_g[l], k_norm_g[l], attn_sinks[l], shift_mu[l], decay_w0[l],
              decay_w2[l], iclr_a0[l], iclr_a2[l], gate_g2[l], k_k[l], k_a[l], r_k[l], lnx_g[l], lnx_b[l],
              w_out[l], ln2_g[l], w_up[l], w_down[l])
        zero_shift = jnp.zeros((Bp, RWKV_COLS), hp.dtype)
        zero_wkv = jnp.zeros((Bp, RWKV_HEADS, RWKV_N, RWKV_N), jnp.float32)
        hp, a1, a2, a3, a4 = _layer(hp, pos_p, None, None, zero_shift, zero_wkv, *lw)
        hs, b1, b2, b3, b4 = _layer(hs, pos_s, cache_attn_k[l], cache_attn_v[l], state_rwkv_shift[l],
                                    state_rwkv_wkv[l], *lw)
        p_k.append(a1); p_v.append(a2); p_wkv.append(a3); p_shift.append(a4)
        s_k.append(b1); s_v.append(b2); s_wkv.append(b3); s_shift.append(b4)
    return (hp, hs, jnp.stack(p_k), jnp.stack(p_v), jnp.stack(p_wkv), jnp.stack(p_shift),
            jnp.stack(s_k), jnp.stack(s_v), jnp.stack(s_wkv), jnp.stack(s_shift))
```

```cpp
#include <hip/hip_runtime.h>
#include <hip/hip_cooperative_groups.h>
#include <cstdio>
#include <cstdint>
namespace cg = cooperative_groups;

#ifndef MK_N_LAUNCHES
#define MK_N_LAUNCHES 6
#endif

#define GAS __attribute__((address_space(1)))
#define LAS __attribute__((address_space(3)))
typedef unsigned short bf16_t;
typedef short bf16x8 __attribute__((ext_vector_type(8)));
typedef short s16x4 __attribute__((ext_vector_type(4)));
typedef float f32x2 __attribute__((ext_vector_type(2)));
typedef float f32x4 __attribute__((ext_vector_type(4)));
typedef float f32x16 __attribute__((ext_vector_type(16)));
typedef unsigned u32x2 __attribute__((ext_vector_type(2)));
typedef unsigned u32x4 __attribute__((ext_vector_type(4)));
typedef __bf16 bf16v2 __attribute__((ext_vector_type(2)));
#define DI __device__ __forceinline__

constexpr int D_MODEL = 1024, SEQ = 2048, BATCH = 32, DEC_SEQ = 16;
constexpr int MP = BATCH * SEQ;
constexpr int MS = BATCH * DEC_SEQ;
constexpr int MT = MP + MS;
constexpr int IN_COLS = 2592, IN_PAD = 2816;
constexpr int RW_COLS = 1824, D_FF = 4096;
constexpr int NPOS = SEQ + DEC_SEQ;

constexpr size_t O_PK = 67633152, O_PV = 68157440, O_PW = 68681728, O_PS = 69730304, O_SK = 69788672, O_SV = 69854208, O_SW = 69919744, O_SS = 70968320;

constexpr size_t al256(size_t x) { return (x + 255) & ~(size_t)255; }
constexpr size_t WS_WIN = 0;
constexpr size_t WS_WOUT = WS_WIN + (size_t)IN_PAD * 1024 * 2;
constexpr size_t WS_WUP = WS_WOUT + (size_t)1024 * 1024 * 2;
constexpr size_t WS_WDN = WS_WUP + (size_t)4096 * 1024 * 2;
constexpr size_t WS_W2T = WS_WDN + (size_t)4096 * 1024 * 2;
constexpr size_t WS_A2T = WS_W2T + 512 * 64 * 2;
constexpr size_t WS_G2T = WS_A2T + 512 * 64 * 2;
constexpr size_t WS_ROPE = al256(WS_G2T + 512 * 160 * 2);
constexpr size_t WS_SSQ = al256(WS_ROPE + (size_t)NPOS * 64 * 4);
constexpr size_t WS_X1B = al256(WS_SSQ + (size_t)MT * 16 * 4);
constexpr size_t WS_H = al256(WS_X1B + (size_t)MT * 1024 * 2);
constexpr size_t WS_Q = WS_H + (size_t)MT * 1024 * 2;
constexpr size_t WS_K = WS_Q + (size_t)MT * 512 * 2;
constexpr size_t WS_V = WS_K + (size_t)MT * 128 * 2;
constexpr size_t WS_PRW = WS_V + (size_t)MT * 128 * 2;
constexpr size_t WS_MIX = WS_PRW + (size_t)MT * RW_COLS * 2;
constexpr size_t WS_AEND = WS_MIX + (size_t)MT * 1024 * 2;
constexpr size_t WS_U = WS_H;
static_assert(WS_U + (size_t)MT * 4096 * 2 <= WS_AEND, "U overlay");
constexpr size_t WS_END = WS_AEND;
static_assert(WS_END <= (size_t)1 << 30, "workspace");

constexpr int LDS_BYTES = 147456;

DI unsigned pk2(float lo, float hi) { f32x2 v = {lo, hi}; return __builtin_bit_cast(unsigned, __builtin_convertvector(v, bf16v2)); }
DI float bf2f(unsigned short b) { return __builtin_bit_cast(float, (unsigned)b << 16); }
DI float bflo(unsigned w) { return __builtin_bit_cast(float, w << 16); }
DI float bfhi(unsigned w) { return __builtin_bit_cast(float, w & 0xffff0000u); }
DI u32x4 pk8(f32x4 a, f32x4 b) { u32x4 w; w.x = pk2(a[0], a[1]); w.y = pk2(a[2], a[3]); w.z = pk2(b[0], b[1]); w.w = pk2(b[2], b[3]); return w; }
DI float wave_sum(float v) {
#pragma unroll
    for (int o = 1; o < 64; o <<= 1) v += __shfl_xor(v, o);
    return v;
}
template <int CTRL> DI float dpp_f(float x) { return __builtin_bit_cast(float, __builtin_amdgcn_mov_dpp(__builtin_bit_cast(int, x), CTRL, 0xf, 0xf, true)); }
DI float quad_sum(float x) { x += dpp_f<0xB1>(x); x += dpp_f<0x4E>(x); return x; }
DI float oct_sum(float x) { x = quad_sum(x); x += dpp_f<0x141>(x); return x; }
#define LDS_WAIT() asm volatile("s_waitcnt lgkmcnt(0)" ::: "memory")

namespace pg8 {
constexpr int BM = 256, BK = 64, HALF = 128, HTB = HALF * BK * 2, STAGE_BYTES = 8 * HTB, NXCD = 8, WGM = 8;
__host__ __device__ __forceinline__ int lds_byte(int r, int c) { const int st = (r >> 4) * 2 + (c >> 5), rr = r & 15, cc = c & 31, ob = rr * 64 + cc * 2; return st * 1024 + (ob ^ (((ob >> 9) & 1) << 5)); }
__host__ __device__ __forceinline__ void stage_rc(int b, int& R, int& C) { const int st = b / 1024, sb = b % 1024, swz = sb ^ (((sb >> 9) & 1) << 5); R = (st >> 1) * 16 + swz / 64; C = (st & 1) * 32 + (swz % 64) / 2; }
struct Unit { int pm, pn; };
struct Gemm { const bf16_t* A; const bf16_t* Bt; int M, N, K; };
struct StaticOrder {
    int nM, nN, nwg, G, c;
    __host__ __device__ void init(int M, int N, int G_, int c_) { nM = M / BM; nN = N / BM; nwg = nM * nN; G = G_; c = c_; }
    __host__ __device__ bool next(int i, Unit& u) const {
        const long L = (long)i * G + c; if (L >= nwg) return false;
        int wgid = (int)L; { const int q = nwg / NXCD, r = nwg % NXCD, xcd = wgid % NXCD, off = wgid / NXCD; wgid = (xcd < r ? xcd * (q + 1) : r * (q + 1) + (xcd - r) * q) + off; }
        const int nig = WGM * nN, gid = wgid / nig, fm = gid * WGM, gsz = (nM - fm) < WGM ? (nM - fm) : WGM;
        u.pm = fm + ((wgid % nig) % gsz); u.pn = (wgid % nig) / gsz; return true;
    }
};
template <class Epi, class Sched, bool ALIGN_EPI = true, bool SP2 = true>
__device__ __forceinline__ void gemm_phase(LAS unsigned char* lds, const Gemm g, const Sched& S, const Epi& E) {
    const int tid = threadIdx.x, wid = __builtin_amdgcn_readfirstlane(tid >> 6), lane = tid & 63, wr = wid >> 2, wc = wid & 3, fr = lane & 15, fq = lane >> 4;
    const int K = g.K, nt = K / BK;
    unsigned voffA[2];
#pragma unroll
    for (int i = 0; i < 2; ++i) { int R, C; stage_rc(tid * 16 + i * 8192, R, C); voffA[i] = (unsigned)(R * K + C) * 2u; }
    const size_t kstep = (size_t)(BK * 2);
    const size_t hstep = (size_t)HALF * K * 2;
    const size_t tstep = 2 * hstep;
    const unsigned ldsw = (unsigned)wid * 1024u;
    const int aoff = lds_byte(wr * 64 + fr, fq * 8), boff = lds_byte(wc * 32 + fr, fq * 8);
#define PG8_SA(b, h) (((b) * 2 + (h)) * HTB)
#define PG8_SB(b, h) ((4 + (b) * 2 + (h)) * HTB)
#define PG8_STAGE(bufoff, gbase, voff) do { _Pragma("unroll") for (int _i = 0; _i < 2; ++_i) \
        __builtin_amdgcn_global_load_lds((const unsigned*)((const char*)(gbase) + (voff)[_i]), (LAS unsigned*)(lds + (bufoff) + ldsw + _i * 8192), 16, 0, 0); } while (0)
#define PG8_LDA(dst, b, h) do { _Pragma("unroll") for (int m = 0; m < 4; ++m) _Pragma("unroll") for (int k = 0; k < 2; ++k) dst[m][k] = *(const LAS bf16x8*)(lds + PG8_SA(b, h) + aoff + m * 2048 + k * 1024); } while (0)
#define PG8_LDB(dst, b, h) do { _Pragma("unroll") for (int n = 0; n < 2; ++n) _Pragma("unroll") for (int k = 0; k < 2; ++k) dst[n][k] = *(const LAS bf16x8*)(lds + PG8_SB(b, h) + boff + n * 2048 + k * 1024); } while (0)
#define PG8_MMA(ai, bj, At, Bt) do { __builtin_amdgcn_s_setprio(1); _Pragma("unroll") for (int m = 0; m < 4; ++m) _Pragma("unroll") for (int n = 0; n < 2; ++n) _Pragma("unroll") for (int k = 0; k < 2; ++k) \
        acc[ai][bj][m][n] = __builtin_amdgcn_mfma_f32_16x16x32_bf16(Bt[n][k], At[m][k], acc[ai][bj][m][n], 0, 0, 0); __builtin_amdgcn_s_setprio(0); } while (0)
#define PG8_WAIT_V(n) asm volatile("s_waitcnt vmcnt(" #n ")" ::: "memory")
#define PG8_WAIT_L(n) asm volatile("s_waitcnt lgkmcnt(" #n ")" ::: "memory")
#define PG8_BAR __builtin_amdgcn_s_barrier()
#define PG8_SCHED __builtin_amdgcn_sched_barrier(0)
    Unit cur, nxt; int ui = 0;
    if (!S.next(0, cur)) return;
    f32x4 acc[2][2][4][2];
#pragma unroll
    for (int a = 0; a < 2; ++a)
#pragma unroll
        for (int b = 0; b < 2; ++b)
#pragma unroll
            for (int m = 0; m < 4; ++m)
#pragma unroll
                for (int n = 0; n < 2; ++n) acc[a][b][m][n] = (f32x4){0.f, 0.f, 0.f, 0.f};
    bf16x8 At[4][2], B0[2][2], B1[2][2];
    const char* cA = (const char*)g.A + (size_t)cur.pm * tstep; const char* cB = (const char*)g.Bt + (size_t)cur.pn * tstep;
    if constexpr (SP2) {
        PG8_STAGE(PG8_SB(0, 0), cB, voffA); PG8_STAGE(PG8_SB(0, 1), cB + hstep, voffA); PG8_STAGE(PG8_SA(0, 0), cA, voffA); PG8_STAGE(PG8_SA(0, 1), cA + hstep, voffA);
        if (wr == 1) PG8_BAR;
        PG8_WAIT_V(2); PG8_BAR;
        PG8_STAGE(PG8_SB(1, 0), cB + kstep, voffA); PG8_STAGE(PG8_SA(1, 0), cA + kstep, voffA); PG8_STAGE(PG8_SB(1, 1), cB + hstep + kstep, voffA);
        PG8_WAIT_V(6); PG8_BAR;
    } else {
        PG8_STAGE(PG8_SB(0, 0), cB, voffA); PG8_STAGE(PG8_SA(0, 0), cA, voffA); PG8_STAGE(PG8_SB(0, 1), cB + hstep, voffA); PG8_STAGE(PG8_SA(0, 1), cA + hstep, voffA);
        if (wr == 1) PG8_BAR;
        PG8_WAIT_V(4); PG8_BAR;
        PG8_STAGE(PG8_SB(1, 0), cB + kstep, voffA); PG8_STAGE(PG8_SA(1, 0), cA + kstep, voffA); PG8_STAGE(PG8_SB(1, 1), cB + hstep + kstep, voffA);
        PG8_WAIT_V(6); PG8_BAR;
    }
    for (;;) {
        const bool has_next = S.next(ui + 1, nxt);
        const char* nA = has_next ? (const char*)g.A + (size_t)nxt.pm * tstep : cA; const char* nB = has_next ? (const char*)g.Bt + (size_t)nxt.pn * tstep : cB;
        for (int t = 0; t < nt; t += 2) {
            const bool last = (t == nt - 2);
            const char* a1 = cA + (size_t)(t + 1) * kstep;
            const char* a2 = last ? nA : cA + (size_t)(t + 2) * kstep; const char* b2 = last ? nB : cB + (size_t)(t + 2) * kstep;
            const char* a3 = a2 + kstep; const char* b3 = b2 + kstep;
            if constexpr (SP2) {
            PG8_LDB(B0, 0, 0); PG8_LDB(B1, 0, 1); PG8_SCHED; PG8_LDA(At, 0, 0); PG8_STAGE(PG8_SA(1, 1), a1 + hstep, voffA);
            PG8_WAIT_V(8); PG8_WAIT_L(0); PG8_BAR; PG8_MMA(0, 0, At, B0); PG8_MMA(0, 1, At, B1); PG8_BAR; PG8_SCHED;
            PG8_LDA(At, 0, 1); PG8_STAGE(PG8_SB(0, 0), b2, voffA); PG8_STAGE(PG8_SB(0, 1), b2 + hstep, voffA); PG8_STAGE(PG8_SA(0, 0), a2, voffA);
            PG8_WAIT_V(8); PG8_WAIT_L(0); PG8_BAR; PG8_MMA(1, 0, At, B0); PG8_MMA(1, 1, At, B1); PG8_BAR; PG8_SCHED;
            PG8_LDB(B0, 1, 0); PG8_LDB(B1, 1, 1); PG8_SCHED; PG8_LDA(At, 1, 0); PG8_STAGE(PG8_SA(0, 1), a2 + hstep, voffA);
            PG8_WAIT_V(8); PG8_WAIT_L(0); PG8_BAR; PG8_MMA(0, 0, At, B0); PG8_MMA(0, 1, At, B1); PG8_BAR; PG8_SCHED;
            PG8_LDA(At, 1, 1); PG8_STAGE(PG8_SB(1, 0), b3, voffA); PG8_STAGE(PG8_SB(1, 1), b3 + hstep, voffA); PG8_STAGE(PG8_SA(1, 0), a3, voffA);
            PG8_WAIT_V(8); PG8_WAIT_L(0); PG8_BAR; PG8_MMA(1, 0, At, B0); PG8_MMA(1, 1, At, B1); PG8_BAR; PG8_SCHED;
            } else {
            PG8_LDB(B0, 0, 0); PG8_SCHED; PG8_LDA(At, 0, 0); PG8_STAGE(PG8_SA(1, 1), a1 + hstep, voffA);
            PG8_WAIT_L(8); PG8_BAR; PG8_WAIT_L(0); PG8_MMA(0, 0, At, B0); PG8_BAR; PG8_SCHED;
            PG8_LDB(B1, 0, 1); PG8_STAGE(PG8_SB(0, 0), b2, voffA);
            PG8_BAR; PG8_WAIT_L(0); PG8_MMA(0, 1, At, B1); PG8_BAR;
            PG8_LDA(At, 0, 1); PG8_STAGE(PG8_SA(0, 0), a2, voffA);
            PG8_BAR; PG8_WAIT_L(0); PG8_MMA(1, 0, At, B0); PG8_BAR; PG8_SCHED;
            PG8_STAGE(PG8_SB(0, 1), b2 + hstep, voffA);
            PG8_WAIT_V(6); PG8_BAR; PG8_MMA(1, 1, At, B1); PG8_BAR;
            PG8_LDB(B0, 1, 0); PG8_SCHED; PG8_LDA(At, 1, 0); PG8_STAGE(PG8_SA(0, 1), a2 + hstep, voffA);
            PG8_WAIT_L(8); PG8_BAR; PG8_WAIT_L(0); PG8_MMA(0, 0, At, B0); PG8_BAR; PG8_SCHED;
            PG8_LDB(B1, 1, 1); PG8_STAGE(PG8_SB(1, 0), b3, voffA);
            PG8_BAR; PG8_WAIT_L(0); PG8_MMA(0, 1, At, B1); PG8_BAR;
            PG8_LDA(At, 1, 1); PG8_STAGE(PG8_SA(1, 0), a3, voffA);
            PG8_BAR; PG8_WAIT_L(0); PG8_MMA(1, 0, At, B0); PG8_BAR; PG8_SCHED;
            PG8_STAGE(PG8_SB(1, 1), b3 + hstep, voffA);
            PG8_WAIT_V(6); PG8_BAR; PG8_MMA(1, 1, At, B1); PG8_BAR;
            }
        }
        if constexpr (ALIGN_EPI) { if (wr == 0) PG8_BAR; }
        E(acc, cur, wr, wc, fr, fq);
        if (!has_next) break;
#pragma unroll
        for (int a = 0; a < 2; ++a)
#pragma unroll
            for (int b = 0; b < 2; ++b)
#pragma unroll
                for (int m = 0; m < 4; ++m)
#pragma unroll
                    for (int n = 0; n < 2; ++n) acc[a][b][m][n] = (f32x4){0.f, 0.f, 0.f, 0.f};
        cur = nxt; cA = nA; cB = nB; ++ui;
        if constexpr (ALIGN_EPI) { if (wr == 1) PG8_BAR; }
    }
    PG8_WAIT_V(0);
    if constexpr (!ALIGN_EPI) { if (wr == 0) PG8_BAR; }
    PG8_BAR;
#undef PG8_SA
#undef PG8_SB
#undef PG8_STAGE
#undef PG8_LDA
#undef PG8_LDB
#undef PG8_MMA
#undef PG8_WAIT_V
#undef PG8_WAIT_L
#undef PG8_BAR
#undef PG8_SCHED
}
}

enum { MAP_NAT = 0, MAP_A = 1, MAP_B = 2 };
DI int rowmap(int mode, int c) {
    if (mode == MAP_NAT) return c;
    if (mode == MAP_A) { const int rem = c & 31; return (c & ~31) + 16 * ((rem >> 2) & 1) + 4 * (rem >> 3) + (rem & 3); }
    const int rem = c & 255; return (c & ~255) + 128 * ((rem >> 5) & 1) + 32 * (rem >> 6) + 16 * ((rem >> 2) & 1) + 4 * ((rem >> 3) & 3) + (rem & 3);
}

struct EpiIn {
    GAS bf16_t* Q; GAS bf16_t* Kb; GAS bf16_t* Vb; GAS bf16_t* PRW; GAS float* out; const GAS float* rope; const GAS float* qg; const GAS float* kg;
    DI void operator()(const f32x4 (&acc)[2][2][4][2], const pg8::Unit& u, int wr, int wc, int fr, int fq) const {
        const int H = u.pn * 4 + wc;
        const int row0 = u.pm * 256 + wr * 64 + fr;
        if (H < 10) {
            const bool isq = H < 8;
            const GAS float* g = isq ? qg : kg;
            f32x4 gv[2][2];
#pragma unroll
            for (int bj = 0; bj < 2; ++bj)
#pragma unroll
                for (int n = 0; n < 2; ++n) gv[bj][n] = *(const GAS f32x4*)(g + 32 * bj + 8 * fq + 4 * n);
#pragma unroll
            for (int ai = 0; ai < 2; ++ai)
#pragma unroll
                for (int m = 0; m < 4; ++m) {
                    const int row = row0 + ai * 128 + m * 16;
                    float ss = 0.f;
#pragma unroll
                    for (int bj = 0; bj < 2; ++bj)
#pragma unroll
                        for (int n = 0; n < 2; ++n) { const f32x4 x = acc[ai][bj][m][n]; ss += (x[0] * x[0] + x[1] * x[1]) + (x[2] * x[2] + x[3] * x[3]); }
                    ss += __shfl_xor(ss, 16); ss += __shfl_xor(ss, 32);
                    float rinv = __builtin_amdgcn_rsqf(ss * (1.f / 64.f) + 1e-6f);
                    if (isq) rinv *= 0.125f;
                    const bool samp = row >= MP;
                    const int rs = row - MP;
                    const int b = samp ? (rs >> 4) : (row >> 11), t = samp ? (rs & 15) : (row & 2047);
                    const int pi = samp ? (SEQ + t) : t;
                    const GAS float* rp = rope + (size_t)pi * 64 + 8 * fq;
                    f32x4 o1[2], o2[2];
#pragma unroll
                    for (int n = 0; n < 2; ++n) {
                        const f32x4 c4 = *(const GAS f32x4*)(rp + 4 * n), s4 = *(const GAS f32x4*)(rp + 32 + 4 * n);
                        const f32x4 x1 = acc[ai][0][m][n] * rinv * gv[0][n], x2 = acc[ai][1][m][n] * rinv * gv[1][n];
                        o1[n] = x1 * c4 - x2 * s4; o2[n] = x2 * c4 + x1 * s4;
                    }
                    if (isq) {
                        GAS bf16_t* qp = Q + (size_t)row * 512 + 64 * H + 8 * fq;
                        *(GAS u32x4*)qp = pk8(o1[0], o1[1]); *(GAS u32x4*)(qp + 32) = pk8(o2[0], o2[1]);
                    } else {
                        const int kvh = H - 8;
                        GAS bf16_t* kp = Kb + (size_t)row * 128 + 64 * kvh + 8 * fq;
                        *(GAS u32x4*)kp = pk8(o1[0], o1[1]); *(GAS u32x4*)(kp + 32) = pk8(o2[0], o2[1]);
                        if (samp || t >= SEQ - 128) {
                            GAS float* op = samp ? out + O_SK + ((size_t)(b * 16 + t) * 2 + kvh) * 64 + 8 * fq : out + O_PK + ((size_t)(b * 128 + (t - (SEQ - 128))) * 2 + kvh) * 64 + 8 * fq;
                            *(GAS f32x4*)op = o1[0]; *(GAS f32x4*)(op + 4) = o1[1]; *(GAS f32x4*)(op + 32) = o2[0]; *(GAS f32x4*)(op + 36) = o2[1];
                        }
                    }
                }
        } else if (H < 12) {
            const int kvh = H - 10;
#pragma unroll
            for (int ai = 0; ai < 2; ++ai)
#pragma unroll
                for (int m = 0; m < 4; ++m) {
                    const int row = row0 + ai * 128 + m * 16;
                    const bool samp = row >= MP;
                    const int rs = row - MP;
                    const int b = samp ? (rs >> 4) : (row >> 11), t = samp ? (rs & 15) : (row & 2047);
                    GAS bf16_t* vp = Vb + (size_t)row * 128 + 64 * kvh + 8 * fq;
                    *(GAS u32x4*)vp = pk8(acc[ai][0][m][0], acc[ai][0][m][1]); *(GAS u32x4*)(vp + 32) = pk8(acc[ai][1][m][0], acc[ai][1][m][1]);
                    if (samp || t >= SEQ - 128) {
                        GAS float* op = samp ? out + O_SV + ((size_t)(b * 16 + t) * 2 + kvh) * 64 + 8 * fq : out + O_PV + ((size_t)(b * 128 + (t - (SEQ - 128))) * 2 + kvh) * 64 + 8 * fq;
                        *(GAS f32x4*)op = acc[ai][0][m][0]; *(GAS f32x4*)(op + 4) = acc[ai][0][m][1]; *(GAS f32x4*)(op + 32) = acc[ai][1][m][0]; *(GAS f32x4*)(op + 36) = acc[ai][1][m][1];
                    }
                }
        } else {
            const int cr0 = (H - 12) * 64 + 8 * fq;
#pragma unroll
            for (int ai = 0; ai < 2; ++ai)
#pragma unroll
                for (int m = 0; m < 4; ++m) {
                    const int row = row0 + ai * 128 + m * 16;
                    const bool samp = row >= MP;
                    const int rs = row - MP;
                    const int b = samp ? (rs >> 4) : (row >> 11), t = samp ? (rs & 15) : (row & 2047);
                    const bool lastrow = samp ? (t == DEC_SEQ - 1) : (t == SEQ - 1);
#pragma unroll
                    for (int bj = 0; bj < 2; ++bj) {
                        const int cr = cr0 + 32 * bj;
                        if (cr < RW_COLS) {
                            *(GAS u32x4*)(PRW + (size_t)row * RW_COLS + cr) = pk8(acc[ai][bj][m][0], acc[ai][bj][m][1]);
                            if (lastrow) { GAS float* op = out + (samp ? O_SS : O_PS) + (size_t)b * RW_COLS + cr; *(GAS f32x4*)op = acc[ai][bj][m][0]; *(GAS f32x4*)(op + 4) = acc[ai][bj][m][1]; }
                        }
                    }
                }
        }
    }
};
struct EpiOut {
    const GAS float* xp; const GAS float* xs; GAS float* out; GAS bf16_t* X1B; GAS float* SSQ;
    DI void operator()(const f32x4 (&acc)[2][2][4][2], const pg8::Unit& u, int wr, int wc, int fr, int fq) const {
        const int row0 = u.pm * 256 + wr * 64 + fr, col0 = u.pn * 256 + wc * 32 + 4 * fq;
        const GAS float* xin = (u.pm < 256) ? xp : xs - (size_t)MP * 1024;
#pragma unroll
        for (int ai = 0; ai < 2; ++ai)
#pragma unroll
            for (int m = 0; m < 4; ++m) {
                const int row = row0 + ai * 128 + m * 16; const size_t off = (size_t)row * 1024 + col0;
                float ss = 0.f;
#pragma unroll
                for (int bj = 0; bj < 2; ++bj)
#pragma unroll
                    for (int n = 0; n < 2; ++n) {
                        const f32x4 o = *(const GAS f32x4*)(xin + off + bj * 128 + n * 16) + acc[ai][bj][m][n];
                        *(GAS f32x4*)(out + off + bj * 128 + n * 16) = o;
                        u32x2 w; w.x = pk2(o[0], o[1]); w.y = pk2(o[2], o[3]);
                        *(GAS u32x2*)(X1B + off + bj * 128 + n * 16) = w;
                        ss += (o[0] * o[0] + o[1] * o[1]) + (o[2] * o[2] + o[3] * o[3]);
                    }
                ss += __shfl_xor(ss, 16); ss += __shfl_xor(ss, 32);
                if (fq == 0) SSQ[(size_t)row * 16 + u.pn * 4 + wc] = ss;
            }
    }
};
struct EpiUp {
    const GAS float* SSQ; GAS bf16_t* U;
    DI void operator()(const f32x4 (&acc)[2][2][4][2], const pg8::Unit& u, int wr, int wc, int fr, int fq) const {
        const int row0 = u.pm * 256 + wr * 64 + fr, col0 = u.pn * 256 + wc * 32 + 8 * fq;
#pragma unroll
        for (int ai = 0; ai < 2; ++ai)
#pragma unroll
            for (int m = 0; m < 4; ++m) {
                const int row = row0 + ai * 128 + m * 16;
                const GAS f32x4* sp = (const GAS f32x4*)(SSQ + (size_t)row * 16);
                const f32x4 a = sp[0], b = sp[1], c = sp[2], d = sp[3];
                const f32x4 t4 = (a + b) + (c + d);
                const float tot = (t4[0] + t4[1]) + (t4[2] + t4[3]);
                const float s2 = 1.0f / (tot * (1.f / 1024.f) + 1e-6f);
#pragma unroll
                for (int bj = 0; bj < 2; ++bj) {
                    f32x4 v0 = acc[ai][bj][m][0], v1 = acc[ai][bj][m][1];
#pragma unroll
                    for (int j = 0; j < 4; ++j) { const float r0 = fmaxf(v0[j], 0.f), r1 = fmaxf(v1[j], 0.f); v0[j] = r0 * r0 * s2; v1[j] = r1 * r1 * s2; }
                    *(GAS u32x4*)(U + (size_t)row * D_FF + col0 + bj * 128) = pk8(v0, v1);
                }
            }
    }
};
struct EpiDown {
    GAS float* out;
    DI void operator()(const f32x4 (&acc)[2][2][4][2], const pg8::Unit& u, int wr, int wc, int fr, int fq) const {
        const int row0 = u.pm * 256 + wr * 64 + fr, col0 = u.pn * 256 + wc * 32 + 4 * fq;
#pragma unroll
        for (int ai = 0; ai < 2; ++ai)
#pragma unroll
            for (int m = 0; m < 4; ++m) {
                const size_t off = (size_t)(row0 + ai * 128 + m * 16) * 1024 + col0;
#pragma unroll
                for (int bj = 0; bj < 2; ++bj)
#pragma unroll
                    for (int n = 0; n < 2; ++n) { GAS float* p = out + off + bj * 128 + n * 16; *(GAS f32x4*)p = *(const GAS f32x4*)p + acc[ai][bj][m][n]; }
            }
    }
};

DI void p0_transpose_item(const GAS float* W, int K, int N, GAS bf16_t* WT, int mode, const GAS float* kscale, LAS float* scr, int item, int lane) {
    const int nblk = N / 32, kb = item / nblk, nb = item % nblk, k0 = 64 * kb, n0 = 32 * nb;
#pragma unroll 8
    for (int i = 0; i < 32; ++i) { const int kk = 2 * i + (lane >> 5); float v = W[(size_t)(k0 + kk) * N + n0 + (lane & 31)]; if (kscale) v *= kscale[k0 + kk]; scr[kk * 33 + (lane & 31)] = v; }
    LDS_WAIT();
    const int c = lane & 7;
#pragma unroll
    for (int j = 0; j < 4; ++j) { const int n = (lane >> 3) + 8 * j; const LAS float* s = scr + (8 * c) * 33 + n;
        u32x4 o; o.x = pk2(s[0 * 33], s[1 * 33]); o.y = pk2(s[2 * 33], s[3 * 33]); o.z = pk2(s[4 * 33], s[5 * 33]); o.w = pk2(s[6 * 33], s[7 * 33]);
        *(GAS u32x4*)(WT + (size_t)rowmap(mode, n0 + n) * K + k0 + 8 * c) = o; }
    LDS_WAIT();
}
DI void sincos_d(double x, double& s, double& c) {
    const double TWO_PI = 6.283185307179586476925287;
    const double n = __builtin_rint(x * (1.0 / TWO_PI));
    const double r = x - n * TWO_PI, r2 = r * r;
    double ps = 1.0, pc = 1.0;
#pragma unroll
    for (int k = 14; k >= 1; --k) { ps = 1.0 - ps * r2 / (double)((2 * k) * (2 * k + 1)); pc = 1.0 - pc * r2 / (double)((2 * k - 1) * (2 * k)); }
    s = r * ps; c = pc;
}

struct Params { const float* in[26]; float* out; unsigned char* ws; int ph_lo, ph_hi; };

DI void phase0(const Params& p, LAS unsigned char* lds, int G) {
    const int tid = threadIdx.x, lane = tid & 63, wave = tid >> 6;
    const int gw = blockIdx.x * 8 + wave, NGW = G * 8;
    LAS float* scr = (LAS float*)(lds + wave * 8704);
    unsigned char* ws = p.ws;
    const GAS float* w_in = (const GAS float*)p.in[7]; const GAS float* w_out = (const GAS float*)p.in[22]; const GAS float* w_up = (const GAS float*)p.in[24]; const GAS float* w_dn = (const GAS float*)p.in[25];
    const GAS float* ln2 = (const GAS float*)p.in[23];
    constexpr int I_IN = 16 * (IN_COLS / 32), I_OUT = 16 * 32, I_UP = 16 * 128, I_DN = 64 * 32, NITEMS = I_IN + I_OUT + I_UP + I_DN;
    for (int it = gw; it < NITEMS; it += NGW) {
        int r = it;
        if (r < I_IN) { p0_transpose_item(w_in, 1024, IN_COLS, (GAS bf16_t*)(ws + WS_WIN), MAP_B, nullptr, scr, r, lane); continue; } r -= I_IN;
        if (r < I_OUT) { p0_transpose_item(w_out, 1024, 1024, (GAS bf16_t*)(ws + WS_WOUT), MAP_NAT, nullptr, scr, r, lane); continue; } r -= I_OUT;
        if (r < I_UP) { p0_transpose_item(w_up, 1024, 4096, (GAS bf16_t*)(ws + WS_WUP), MAP_A, ln2, scr, r, lane); continue; } r -= I_UP;
        p0_transpose_item(w_dn, 4096, 1024, (GAS bf16_t*)(ws + WS_WDN), MAP_NAT, nullptr, scr, r, lane);
    }
    const int gt = blockIdx.x * 512 + tid, NGT = G * 512;
    for (int i = gt; i < (IN_PAD - IN_COLS) * 128; i += NGT) { const int c = IN_COLS + i / 128; *(GAS u32x4*)((GAS bf16_t*)(ws + WS_WIN) + (size_t)rowmap(MAP_B, c) * 1024 + (i % 128) * 8) = (u32x4){0u, 0u, 0u, 0u}; }
    { const GAS float* w2 = (const GAS float*)p.in[13]; const GAS float* a2 = (const GAS float*)p.in[15]; const GAS float* g2 = (const GAS float*)p.in[16];
      GAS bf16_t* W2T = (GAS bf16_t*)(ws + WS_W2T); GAS bf16_t* A2T = (GAS bf16_t*)(ws + WS_A2T); GAS bf16_t* G2T = (GAS bf16_t*)(ws + WS_G2T);
      for (int i = gt; i < 512 * 32; i += NGT) { const int n = i >> 5, k2 = (i & 31) * 2;
          *(GAS unsigned*)(W2T + n * 64 + k2) = pk2(w2[k2 * 512 + n], w2[(k2 + 1) * 512 + n]);
          *(GAS unsigned*)(A2T + n * 64 + k2) = pk2(a2[k2 * 512 + n], a2[(k2 + 1) * 512 + n]); }
      for (int i = gt; i < 512 * 80; i += NGT) { const int n = i / 80, k2 = (i % 80) * 2; *(GAS unsigned*)(G2T + n * 160 + k2) = pk2(g2[k2 * 512 + n], g2[(k2 + 1) * 512 + n]); } }
    { GAS float* rope = (GAS float*)(ws + WS_ROPE);
      for (int i = gt; i < NPOS * 32; i += NGT) { const int pi = i >> 5, f = i & 31; const int pos = pi < SEQ ? pi : 4096 + (pi - SEQ);
          const float inv = (float)exp(-(double)f * (9.210340371976182736 / 32.0));
          const float ang = (float)pos * inv;
          double s, c; sincos_d((double)ang, s, c);
          rope[(size_t)pi * 64 + f] = (float)c; rope[(size_t)pi * 64 + 32 + f] = (float)s; } }
    { const GAS float* g1 = (const GAS float*)p.in[6]; GAS bf16_t* Hh = (GAS bf16_t*)(ws + WS_H);
      f32x4 gv[4];
#pragma unroll
      for (int j = 0; j < 4; ++j) gv[j] = *((const GAS f32x4*)g1 + lane + 64 * j);
      for (int m = gw; m < MT; m += NGW) {
          const GAS float* xrow = (m < MP) ? (const GAS float*)p.in[0] + (size_t)m * 1024 : (const GAS float*)p.in[1] + (size_t)(m - MP) * 1024;
          const GAS f32x4* xr = (const GAS f32x4*)xrow + lane;
          f32x4 v[4]; float s = 0.f;
#pragma unroll
          for (int j = 0; j < 4; ++j) { v[j] = xr[64 * j]; s += (v[j][0] * v[j][0] + v[j][1] * v[j][1]) + (v[j][2] * v[j][2] + v[j][3] * v[j][3]); }
          const float rinv = __builtin_amdgcn_rsqf(wave_sum(s) * (1.f / 1024.f) + 1e-6f);
          GAS u32x2* o8 = (GAS u32x2*)(Hh + (size_t)m * 1024) + lane;
#pragma unroll
          for (int j = 0; j < 4; ++j) { const f32x4 y = v[j] * rinv * gv[j]; u32x2 w; w.x = pk2(y[0], y[1]); w.y = pk2(y[2], y[3]); o8[64 * j] = w; }
      } }
}

constexpr int KS_STRIDE = 144;
constexpr int VT_STRIDE = 392;
constexpr int VT_OFF = 192 * KS_STRIDE;
#define MFMA32(a, b, c) __builtin_amdgcn_mfma_f32_32x32x16_bf16((a), (b), (c), 0, 0, 0)

DI void attn_store_kv(LAS unsigned char* lds, int row, int ch, u32x4 kv, u32x4 vv) {
    *(LAS u32x4*)(lds + row * KS_STRIDE + ch * 16) = kv;
    LAS unsigned short* vt = (LAS unsigned short*)(lds + VT_OFF + (8 * ch) * VT_STRIDE + row * 2);
    const unsigned w[4] = {vv.x, vv.y, vv.z, vv.w};
#pragma unroll
    for (int i = 0; i < 4; ++i) { vt[(2 * i) * (VT_STRIDE / 2)] = (unsigned short)(w[i] & 0xffffu); vt[(2 * i + 1) * (VT_STRIDE / 2)] = (unsigned short)(w[i] >> 16); }
}
DI void attn_wave(LAS unsigned char* lds, const GAS bf16_t* qptr  , GAS bf16_t* optr, float sink, int kt0, int nkt, bool mask_last_half, bool do_store, int lane) {
    const int r = lane & 31, h = lane >> 5;
    bf16x8 qf[4];
#pragma unroll
    for (int ks = 0; ks < 4; ++ks) qf[ks] = *(const GAS bf16x8*)(qptr + 16 * ks + 8 * h);
    f32x16 st[6];
#pragma unroll
    for (int kt = 0; kt < 6; ++kt) {
#pragma unroll
        for (int i = 0; i < 16; ++i) st[kt][i] = 0.f;
        if (kt >= kt0 && kt < nkt) {
#pragma unroll
            for (int ks = 0; ks < 4; ++ks) { const bf16x8 kf = *(const LAS bf16x8*)(lds + (32 * kt + r) * KS_STRIDE + (16 * ks + 8 * h) * 2); st[kt] = MFMA32(kf, qf[ks], st[kt]); }
        }
    }
    float mx = sink;
#pragma unroll
    for (int kt = 0; kt < 6; ++kt) if (kt >= kt0 && kt < nkt) {
#pragma unroll
        for (int i = 0; i < 16; ++i) { const bool dead = mask_last_half && kt == nkt - 1 && i >= 8; if (!dead) mx = fmaxf(mx, st[kt][i]); }
    }
    mx = fmaxf(mx, __shfl_xor(mx, 32));
    float l = 0.f;
#pragma unroll
    for (int kt = 0; kt < 6; ++kt) if (kt >= kt0 && kt < nkt) {
#pragma unroll
        for (int i = 0; i < 16; ++i) { const bool dead = mask_last_half && kt == nkt - 1 && i >= 8; const float pv = dead ? 0.f : __expf(st[kt][i] - mx); st[kt][i] = pv; l += pv; }
    }
    l += __shfl_xor(l, 32);
    const float inv = 1.0f / (l + __expf(sink - mx));
    f32x16 ot[2];
#pragma unroll
    for (int dt = 0; dt < 2; ++dt)
#pragma unroll
        for (int i = 0; i < 16; ++i) ot[dt][i] = 0.f;
#pragma unroll
    for (int kt = 0; kt < 6; ++kt) if (kt >= kt0 && kt < nkt) {
#pragma unroll
        for (int s = 0; s < 2; ++s) {
            u32x4 pw; pw.x = pk2(st[kt][8 * s], st[kt][8 * s + 1]); pw.y = pk2(st[kt][8 * s + 2], st[kt][8 * s + 3]); pw.z = pk2(st[kt][8 * s + 4], st[kt][8 * s + 5]); pw.w = pk2(st[kt][8 * s + 6], st[kt][8 * s + 7]);
            const bf16x8 pf = __builtin_bit_cast(bf16x8, pw);
#pragma unroll
            for (int dt = 0; dt < 2; ++dt) {
                const LAS unsigned char* vp = lds + VT_OFF + (32 * dt + r) * VT_STRIDE + (32 * kt + 16 * s + 4 * h) * 2;
                const u32x2 v0 = *(const LAS u32x2*)vp, v1 = *(const LAS u32x2*)(vp + 16);
                u32x4 vw; vw.x = v0.x; vw.y = v0.y; vw.z = v1.x; vw.w = v1.y;
                ot[dt] = MFMA32(__builtin_bit_cast(bf16x8, vw), pf, ot[dt]);
            }
        }
    }
    if (do_store) {
#pragma unroll
        for (int dt = 0; dt < 2; ++dt)
#pragma unroll
            for (int rg = 0; rg < 4; ++rg) {
                u32x2 w; w.x = pk2(ot[dt][4 * rg] * inv, ot[dt][4 * rg + 1] * inv); w.y = pk2(ot[dt][4 * rg + 2] * inv, ot[dt][4 * rg + 3] * inv);
                *(GAS u32x2*)(optr + 32 * dt + 8 * rg + 4 * h) = w;
            }
    }
}
DI void attn_phase(const Params& p, LAS unsigned char* lds, int G) {
    const int tid = threadIdx.x, lane = tid & 63, wid = __builtin_amdgcn_readfirstlane(tid >> 6);
    unsigned char* ws = p.ws;
    const GAS bf16_t* Q = (const GAS bf16_t*)(ws + WS_Q); const GAS bf16_t* Kb = (const GAS bf16_t*)(ws + WS_K); const GAS bf16_t* Vb = (const GAS bf16_t*)(ws + WS_V);
    GAS bf16_t* MIX = (GAS bf16_t*)(ws + WS_MIX);
    const GAS float* sinks = (const GAS float*)p.in[10];
    constexpr int NPI = BATCH * 32 * 2, NSI = BATCH * 2;
    for (int it = blockIdx.x; it < NPI + NSI; it += G) {
        __syncthreads();
        if (it < NPI) {
            const int g = it & 1, n = (it >> 1) & 31, b = it >> 6;
            const int kt0 = n >= 2 ? 0 : (2 - n) * 2;
            const int krow0 = b * SEQ + 64 * (n - 2);
#pragma unroll
            for (int i = 0; i < 3; ++i) {
                const int cid = tid + 512 * i, row = cid >> 3, ch = cid & 7;
                if (row >= 32 * kt0) {
                    const size_t go = (size_t)(krow0 + row) * 128 + 64 * g + 8 * ch;
                    attn_store_kv(lds, row, ch, *(const GAS u32x4*)(Kb + go), *(const GAS u32x4*)(Vb + go));
                }
            }
            __syncthreads();
            const int hq = 4 * g + (wid >> 1);
            const int qrow = b * SEQ + 64 * n + 32 * (wid & 1) + (lane & 31);
            attn_wave(lds, Q + (size_t)qrow * 512 + 64 * hq, MIX + (size_t)qrow * 1024 + 64 * hq, sinks[hq], kt0, 6, false, true, lane);
        } else {
            const int si = it - NPI, g = si & 1, b = si >> 1;
            const GAS float* ck = (const GAS float*)p.in[2]; const GAS float* cv = (const GAS float*)p.in[3];
#pragma unroll
            for (int i = 0; i < 3; ++i) {
                const int cid = tid + 512 * i, row = cid >> 3, ch = cid & 7;
                if (row < 160) {
                    u32x4 kv = {0u, 0u, 0u, 0u}, vv = {0u, 0u, 0u, 0u};
                    if (row < 128) {
                        const size_t go = ((size_t)(b * 128 + row) * 2 + g) * 64 + 8 * ch;
                        kv = pk8(*(const GAS f32x4*)(ck + go), *(const GAS f32x4*)(ck + go + 4)); vv = pk8(*(const GAS f32x4*)(cv + go), *(const GAS f32x4*)(cv + go + 4));
                    } else if (row < 144) {
                        const size_t go = (size_t)(MP + b * 16 + (row - 128)) * 128 + 64 * g + 8 * ch;
                        kv = *(const GAS u32x4*)(Kb + go); vv = *(const GAS u32x4*)(Vb + go);
                    }
                    attn_store_kv(lds, row, ch, kv, vv);
                }
            }
            __syncthreads();
            if (wid < 4) {
                const int hq = 4 * g + wid;
                const int qrow = MP + b * 16 + (lane & 15);
                attn_wave(lds, Q + (size_t)qrow * 512 + 64 * hq, MIX + (size_t)qrow * 1024 + 64 * hq, sinks[hq], 0, 5, true, (lane & 31) < 16, lane);
            }
        }
    }
    __syncthreads();
}

constexpr int TSTR = 388;
constexpr int RW_OPB = 0;
constexpr int RW_SC = RW_OPB + 2 * 16 * TSTR * 4;
constexpr int RW_GB = RW_SC + 2 * 16 * 4 * 4;
constexpr int RW_YB = RW_GB + 2 * 16 * 64 * 4;
constexpr int RW_LW2 = RW_YB + 2 * 16 * 64 * 4;
constexpr int RW_LA2 = RW_LW2 + 64 * 144;
constexpr int RW_LG2 = RW_LA2 + 64 * 144;
constexpr int RW_CV = RW_LG2 + 64 * 336;
constexpr int RW_MUL = RW_CV + 10 * 64 * 4;
constexpr int RW_END = RW_MUL + 288 * 4;
static_assert(RW_END <= LDS_BYTES, "rwkv LDS");
enum { CV_W0 = 0, CV_A0, CV_KK, CV_KA, CV_RK, CV_LG, CV_LB, CV_MR, CV_MK, CV_MV };
#define MFMA16(a, b, c) __builtin_amdgcn_mfma_f32_16x16x32_bf16((a), (b), (c), 0, 0, 0)

struct RwSeq { const GAS bf16_t* prw; const GAS float* shift0; const GAS float* wkv0; GAS float* wkv_out; GAS bf16_t* mix; int ntok; int h; };

DI f32x4 ld4bf(const GAS bf16_t* p) { const u32x2 w = *(const GAS u32x2*)p; return (f32x4){bflo(w.x), bfhi(w.x), bflo(w.y), bfhi(w.y)}; }
DI void ld8bf(const GAS bf16_t* p, float (&o)[8]) { const u32x4 w = *(const GAS u32x4*)p; o[0] = bflo(w.x); o[1] = bfhi(w.x); o[2] = bflo(w.y); o[3] = bfhi(w.y); o[4] = bflo(w.z); o[5] = bfhi(w.z); o[6] = bflo(w.w); o[7] = bfhi(w.w); }

DI void rwkv_prep(LAS unsigned char* lds, const RwSeq& sq, int n, int buf, int lane) {
    const int tk = lane & 15, q = lane >> 4, t = 16 * n + tk;
    const GAS bf16_t* prow = sq.prw + (size_t)t * RW_COLS;
    const bool hasprev = t > 0, hass0 = sq.shift0 != nullptr;
    const LAS float* CV = (const LAS float*)(lds + RW_CV);
    const LAS float* MUL = (const LAS float*)(lds + RW_MUL);
    f32x4 aw[4], aa[4], ag[4];
#pragma unroll
    for (int ct = 0; ct < 4; ++ct) { aw[ct] = (f32x4){0.f, 0.f, 0.f, 0.f}; aa[ct] = aw[ct]; ag[ct] = aw[ct]; }
#pragma unroll
    for (int ks = 0; ks < 9; ++ks) {
        const int col = 1536 + 32 * ks + 8 * q;
        float pc[8], pp[8];
        ld8bf(prow + col, pc);
        if (hasprev) ld8bf(prow - RW_COLS + col, pp);
        else {
#pragma unroll
            for (int j = 0; j < 8; ++j) pp[j] = hass0 ? sq.shift0[col + j] : 0.f;
        }
        float xs[8];
#pragma unroll
        for (int j = 0; j < 8; ++j) {
            const float x = pc[j] + (pp[j] - pc[j]) * MUL[32 * ks + 8 * q + j];
            if (ks < 2) xs[j] = 1.0f - 2.0f / (__expf(2.0f * x) + 1.0f);
            else if (ks < 4) xs[j] = x;
            else xs[j] = 1.0f / (1.0f + __expf(-x));
        }
        u32x4 w; w.x = pk2(xs[0], xs[1]); w.y = pk2(xs[2], xs[3]); w.z = pk2(xs[4], xs[5]); w.w = pk2(xs[6], xs[7]);
        const bf16x8 f = __builtin_bit_cast(bf16x8, w);
#pragma unroll
        for (int ct = 0; ct < 4; ++ct) {
            const int wrow = 16 * ct + tk;
            if (ks < 2) aw[ct] = MFMA16(*(const LAS bf16x8*)(lds + RW_LW2 + wrow * 144 + (32 * ks + 8 * q) * 2), f, aw[ct]);
            else if (ks < 4) aa[ct] = MFMA16(*(const LAS bf16x8*)(lds + RW_LA2 + wrow * 144 + (32 * (ks - 2) + 8 * q) * 2), f, aa[ct]);
            else ag[ct] = MFMA16(*(const LAS bf16x8*)(lds + RW_LG2 + wrow * 336 + (32 * (ks - 4) + 8 * q) * 2), f, ag[ct]);
        }
        asm volatile("" ::: "memory");
    }
    float ssq = 0.f, br = 0.f, kr = 0.f, bon = 0.f;
    LAS float* ob = (LAS float*)(lds + RW_OPB) + (buf * 16 + tk) * TSTR;
#pragma unroll
    for (int ct = 0; ct < 4; ++ct) {
        const int c = 16 * ct + 4 * q;
        const int gc = 64 * sq.h + c;
        f32x4 pr = ld4bf(prow + gc), pk = ld4bf(prow + 512 + gc), pv = ld4bf(prow + 1024 + gc), qr, qk, qv;
        if (hasprev) { qr = ld4bf(prow - RW_COLS + gc); qk = ld4bf(prow - RW_COLS + 512 + gc); qv = ld4bf(prow - RW_COLS + 1024 + gc); }
        else if (hass0) { qr = *(const GAS f32x4*)(sq.shift0 + gc); qk = *(const GAS f32x4*)(sq.shift0 + 512 + gc); qv = *(const GAS f32x4*)(sq.shift0 + 1024 + gc); }
        else { qr = (f32x4){0.f, 0.f, 0.f, 0.f}; qk = qr; qv = qr; }
        const f32x4 mr = *(const LAS f32x4*)(CV + CV_MR * 64 + c), mk = *(const LAS f32x4*)(CV + CV_MK * 64 + c), mv = *(const LAS f32x4*)(CV + CV_MV * 64 + c);
        const f32x4 rr = pr + (qr - pr) * mr, kx = pk + (qk - pk) * mk, vv = pv + (qv - pv) * mv;
        const f32x4 w0 = *(const LAS f32x4*)(CV + CV_W0 * 64 + c), a0 = *(const LAS f32x4*)(CV + CV_A0 * 64 + c), kkc = *(const LAS f32x4*)(CV + CV_KK * 64 + c),
                    kac = *(const LAS f32x4*)(CV + CV_KA * 64 + c), rkc = *(const LAS f32x4*)(CV + CV_RK * 64 + c);
        f32x4 dec, asg, kp;
#pragma unroll
        for (int j = 0; j < 4; ++j) {
            const float z = -(w0[j] + aw[ct][j]);
            const float sp = fmaxf(z, 0.f) + __logf(1.0f + __expf(-fabsf(z)));
            dec[j] = __expf(-__expf(-sp - 0.5f));
            asg[j] = 1.0f / (1.0f + __expf(-(a0[j] + aa[ct][j])));
            kp[j] = kx[j] * (1.0f + (asg[j] - 1.0f) * kac[j]);
        }
        const f32x4 kkr = kx * kkc, bun = kkr * asg;
        ssq += (kkr[0] * kkr[0] + kkr[1] * kkr[1]) + (kkr[2] * kkr[2] + kkr[3] * kkr[3]);
        br += (bun[0] * rr[0] + bun[1] * rr[1]) + (bun[2] * rr[2] + bun[3] * rr[3]);
        kr += (kp[0] * rr[0] + kp[1] * rr[1]) + (kp[2] * rr[2] + kp[3] * rr[3]);
        bon += (rr[0] * kp[0] * rkc[0] + rr[1] * kp[1] * rkc[1]) + (rr[2] * kp[2] * rkc[2] + rr[3] * kp[3] * rkc[3]);
        *(LAS f32x4*)(ob + 0 * 64 + c) = -kkr;
        *(LAS f32x4*)(ob + 1 * 64 + c) = dec * rr;
        *(LAS f32x4*)(ob + 2 * 64 + c) = dec;
        *(LAS f32x4*)(ob + 3 * 64 + c) = bun;
        *(LAS f32x4*)(ob + 4 * 64 + c) = kp;
        *(LAS f32x4*)(ob + 5 * 64 + c) = vv;
        *(LAS f32x4*)((LAS float*)(lds + RW_GB) + (buf * 16 + tk) * 64 + c) = ag[ct];
    }
    ssq += __shfl_xor(ssq, 16); ssq += __shfl_xor(ssq, 32);
    br += __shfl_xor(br, 16); br += __shfl_xor(br, 32);
    kr += __shfl_xor(kr, 16); kr += __shfl_xor(kr, 32);
    bon += __shfl_xor(bon, 16); bon += __shfl_xor(bon, 32);
    const float kinv = 1.0f / fmaxf(sqrtf(ssq), 1e-12f);
    if (q == 0) *(LAS f32x4*)((LAS float*)(lds + RW_SC) + (buf * 16 + tk) * 4) = (f32x4){br, kr, bon, kinv * kinv};
}
DI void rwkv_post(LAS unsigned char* lds, const RwSeq& sq, int n, int buf, int lane) {
    const int tk = lane >> 2, cq = lane & 3, c0 = 16 * cq, t = 16 * n + tk;
    const LAS float* yb = (const LAS float*)(lds + RW_YB) + (buf * 16 + tk) * 64 + c0;
    const LAS float* CV = (const LAS float*)(lds + RW_CV);
    f32x4 y[4]; float s = 0.f;
#pragma unroll
    for (int i = 0; i < 4; ++i) { y[i] = *(const LAS f32x4*)(yb + 4 * i); s += (y[i][0] + y[i][1]) + (y[i][2] + y[i][3]); }
    const float mu = quad_sum(s) * (1.f / 64.f);
    float qv = 0.f;
#pragma unroll
    for (int i = 0; i < 4; ++i) { y[i] = y[i] - mu; qv += (y[i][0] * y[i][0] + y[i][1] * y[i][1]) + (y[i][2] * y[i][2] + y[i][3] * y[i][3]); }
    const float rs = __builtin_amdgcn_rsqf(quad_sum(qv) * (1.f / 64.f) + 64e-5f);
    const float bon = ((const LAS float*)(lds + RW_SC))[(buf * 16 + tk) * 4 + 2];
    const LAS float* vb = (const LAS float*)(lds + RW_OPB) + (buf * 16 + tk) * TSTR + 5 * 64 + c0;
    const LAS float* gb = (const LAS float*)(lds + RW_GB) + (buf * 16 + tk) * 64 + c0;
    f32x4 o[4];
#pragma unroll
    for (int i = 0; i < 4; ++i) {
        const f32x4 lg = *(const LAS f32x4*)(CV + CV_LG * 64 + c0 + 4 * i), lb = *(const LAS f32x4*)(CV + CV_LB * 64 + c0 + 4 * i);
        const f32x4 v = *(const LAS f32x4*)(vb + 4 * i), g = *(const LAS f32x4*)(gb + 4 * i);
        o[i] = ((y[i] * rs) * lg + lb + v * bon) * g;
    }
    GAS bf16_t* op = sq.mix + (size_t)t * 1024 + 512 + 64 * sq.h + c0;
    *(GAS u32x4*)op = pk8(o[0], o[1]); *(GAS u32x4*)(op + 8) = pk8(o[2], o[3]);
}
DI void rwkv_phase(const Params& p, LAS unsigned char* lds, int G) {
    const int tid = threadIdx.x, lane = tid & 63, wid = __builtin_amdgcn_readfirstlane(tid >> 6);
    unsigned char* ws = p.ws;
    for (int it = blockIdx.x; it < 2 * BATCH * 8; it += G) {
        const bool samp = it >= BATCH * 8;
        const int bh = samp ? it - BATCH * 8 : it, b = bh >> 3, h = bh & 7;
        RwSeq sq;
        const int row0 = samp ? MP + b * DEC_SEQ : b * SEQ;
        sq.prw = (const GAS bf16_t*)(ws + WS_PRW) + (size_t)row0 * RW_COLS;
        sq.mix = (GAS bf16_t*)(ws + WS_MIX) + (size_t)row0 * 1024;
        sq.shift0 = samp ? (const GAS float*)p.in[5] + (size_t)b * RW_COLS : nullptr;
        sq.wkv0 = samp ? (const GAS float*)p.in[4] + (size_t)bh * 4096 : nullptr;
        sq.wkv_out = (GAS float*)p.out + (samp ? O_SW : O_PW) + (size_t)bh * 4096;
        sq.ntok = samp ? DEC_SEQ : SEQ; sq.h = h;
        const int NC = sq.ntok / 16;
        __syncthreads();
        { const GAS bf16_t* W2T = (const GAS bf16_t*)(ws + WS_W2T) + (size_t)(64 * h) * 64; const GAS bf16_t* A2T = (const GAS bf16_t*)(ws + WS_A2T) + (size_t)(64 * h) * 64;
          const GAS bf16_t* G2T = (const GAS bf16_t*)(ws + WS_G2T) + (size_t)(64 * h) * 160;
          { const int row = tid >> 3, ch = tid & 7;
            *(LAS u32x4*)(lds + RW_LW2 + row * 144 + ch * 16) = *(const GAS u32x4*)(W2T + row * 64 + ch * 8);
            *(LAS u32x4*)(lds + RW_LA2 + row * 144 + ch * 16) = *(const GAS u32x4*)(A2T + row * 64 + ch * 8); }
          for (int i = tid; i < 64 * 20; i += 512) { const int row = i / 20, ch = i % 20; *(LAS u32x4*)(lds + RW_LG2 + row * 336 + ch * 16) = *(const GAS u32x4*)(G2T + row * 160 + ch * 8); }
          LAS float* CV = (LAS float*)(lds + RW_CV);
          if (tid < 64) {
              const int c = 64 * h + tid;
              CV[CV_W0 * 64 + tid] = ((const GAS float*)p.in[12])[c]; CV[CV_A0 * 64 + tid] = ((const GAS float*)p.in[14])[c];
              CV[CV_KK * 64 + tid] = ((const GAS float*)p.in[17])[c]; CV[CV_KA * 64 + tid] = ((const GAS float*)p.in[18])[c];
              CV[CV_RK * 64 + tid] = ((const GAS float*)p.in[19])[c]; CV[CV_LG * 64 + tid] = ((const GAS float*)p.in[20])[c];
              CV[CV_LB * 64 + tid] = ((const GAS float*)p.in[21])[c];
              const GAS float* mu = (const GAS float*)p.in[11];
              CV[CV_MR * 64 + tid] = mu[c]; CV[CV_MK * 64 + tid] = mu[512 + c]; CV[CV_MV * 64 + tid] = mu[1024 + c];
          }
          if (tid >= 64 && tid < 64 + 288) ((LAS float*)(lds + RW_MUL))[tid - 64] = ((const GAS float*)p.in[11])[1536 + tid - 64];
        }
        __syncthreads();
        if (wid == 4) rwkv_prep(lds, sq, 0, 0, lane);
        const int pp = lane >> 3, o = lane & 7, irow = 16 * wid + 2 * pp;
        float s0[8], s1[8];
#pragma unroll
        for (int j = 0; j < 8; ++j) { s0[j] = 0.f; s1[j] = 0.f; }
        if (wid < 4 && sq.wkv0) {
            const f32x4 a = *(const GAS f32x4*)(sq.wkv0 + irow * 64 + 8 * o), b2 = *(const GAS f32x4*)(sq.wkv0 + irow * 64 + 8 * o + 4);
            const f32x4 c = *(const GAS f32x4*)(sq.wkv0 + (irow + 1) * 64 + 8 * o), d = *(const GAS f32x4*)(sq.wkv0 + (irow + 1) * 64 + 8 * o + 4);
#pragma unroll
            for (int j = 0; j < 4; ++j) { s0[j] = a[j]; s0[4 + j] = b2[j]; s1[j] = c[j]; s1[4 + j] = d[j]; }
        }
        __syncthreads();
        for (int n = 0; n < NC; ++n) {
            const int buf = n & 1;
            if (wid < 4) {
                const LAS float* ob = (const LAS float*)(lds + RW_OPB) + (buf * 16) * TSTR + 8 * o;
                const LAS float* sc = (const LAS float*)(lds + RW_SC) + (buf * 16) * 4;
                LAS float* yb = (LAS float*)(lds + RW_YB) + (buf * 16) * 64 + irow;
#pragma unroll 2
                for (int t = 0; t < 16; ++t) {
                    const LAS float* ot = ob + t * TSTR;
                    float av[8], qv[8], wv[8], bv[8], kv[8];
                    { const f32x4 x0 = *(const LAS f32x4*)(ot), x1 = *(const LAS f32x4*)(ot + 4);
                      const f32x4 y0 = *(const LAS f32x4*)(ot + 64), y1 = *(const LAS f32x4*)(ot + 68);
                      const f32x4 z0 = *(const LAS f32x4*)(ot + 128), z1 = *(const LAS f32x4*)(ot + 132);
                      const f32x4 u0 = *(const LAS f32x4*)(ot + 192), u1 = *(const LAS f32x4*)(ot + 196);
                      const f32x4 v0 = *(const LAS f32x4*)(ot + 256), v1 = *(const LAS f32x4*)(ot + 260);
#pragma unroll
                      for (int j = 0; j < 4; ++j) { av[j] = x0[j]; av[4 + j] = x1[j]; qv[j] = y0[j]; qv[4 + j] = y1[j]; wv[j] = z0[j]; wv[4 + j] = z1[j]; bv[j] = u0[j]; bv[4 + j] = u1[j]; kv[j] = v0[j]; kv[4 + j] = v1[j]; } }
                    const f32x2 vv = *(const LAS f32x2*)(ot - 8 * o + 5 * 64 + irow);
                    const f32x4 bk = *(const LAS f32x4*)(sc + t * 4);
                    float pa0 = 0.f, py0 = 0.f, pa1 = 0.f, py1 = 0.f;
#pragma unroll
                    for (int j = 0; j < 8; ++j) { pa0 += s0[j] * av[j]; py0 += s0[j] * qv[j]; pa1 += s1[j] * av[j]; py1 += s1[j] * qv[j]; }
                    pa0 = oct_sum(pa0) * bk.w; py0 = oct_sum(py0); pa1 = oct_sum(pa1) * bk.w; py1 = oct_sum(py1);
                    const float y0 = py0 + pa0 * bk.x + vv.x * bk.y, y1 = py1 + pa1 * bk.x + vv.y * bk.y;
#pragma unroll
                    for (int j = 0; j < 8; ++j) { s0[j] = s0[j] * wv[j] + (pa0 * bv[j] + vv.x * kv[j]); s1[j] = s1[j] * wv[j] + (pa1 * bv[j] + vv.y * kv[j]); }
                    if (o == 0) *(LAS f32x2*)(yb + t * 64) = (f32x2){y0, y1};
                }
            } else if (wid == 4) {
                if (n >= 1) rwkv_post(lds, sq, n - 1, buf ^ 1, lane);
                if (n + 1 < NC) rwkv_prep(lds, sq, n + 1, buf ^ 1, lane);
            }
            __syncthreads();
        }
        if (wid == 4) rwkv_post(lds, sq, NC - 1, (NC - 1) & 1, lane);
        if (wid < 4) {
            GAS float* w0p = sq.wkv_out + irow * 64 + 8 * o;
            *(GAS f32x4*)w0p = (f32x4){s0[0], s0[1], s0[2], s0[3]}; *(GAS f32x4*)(w0p + 4) = (f32x4){s0[4], s0[5], s0[6], s0[7]};
            *(GAS f32x4*)(w0p + 64) = (f32x4){s1[0], s1[1], s1[2], s1[3]}; *(GAS f32x4*)(w0p + 68) = (f32x4){s1[4], s1[5], s1[6], s1[7]};
        }
    }
    __syncthreads();
}

__global__ void __launch_bounds__(512, 2) fwd_kernel(Params p) {
    extern __shared__ __attribute__((aligned(16))) unsigned char lds_raw[];
    LAS unsigned char* lds = (LAS unsigned char*)lds_raw;
    const int G = gridDim.x;
    unsigned char* ws = p.ws;
    const int lo = p.ph_lo, hi = p.ph_hi;
#define IN(k) (lo <= (k) && (k) < hi)
#define SEAM(k) do { if (IN(k) && IN((k) + 1)) { cg::this_grid().sync(); } } while (0)
    if (IN(0)) { phase0(p, lds, G); }
    SEAM(0);
    if (IN(1)) {
        pg8::Gemm g{(const bf16_t*)(ws + WS_H), (const bf16_t*)(ws + WS_WIN), MT, IN_PAD, 1024}; pg8::StaticOrder S; S.init(MT, IN_PAD, G, (int)blockIdx.x);
        EpiIn E{(GAS bf16_t*)(ws + WS_Q), (GAS bf16_t*)(ws + WS_K), (GAS bf16_t*)(ws + WS_V), (GAS bf16_t*)(ws + WS_PRW), (GAS float*)p.out, (const GAS float*)(ws + WS_ROPE), (const GAS float*)p.in[8], (const GAS float*)p.in[9]};
        pg8::gemm_phase<EpiIn, pg8::StaticOrder>(lds, g, S, E);
    }
    SEAM(1);
    if (IN(2)) { attn_phase(p, lds, G); rwkv_phase(p, lds, G); }
    SEAM(2);
    if (IN(3)) {
        pg8::Gemm g{(const bf16_t*)(ws + WS_MIX), (const bf16_t*)(ws + WS_WOUT), MT, 1024, 1024}; pg8::StaticOrder S; S.init(MT, 1024, G, (int)blockIdx.x);
        EpiOut E{(const GAS float*)p.in[0], (const GAS float*)p.in[1], (GAS float*)p.out, (GAS bf16_t*)(ws + WS_X1B), (GAS float*)(ws + WS_SSQ)};
        pg8::gemm_phase<EpiOut, pg8::StaticOrder>(lds, g, S, E);
    }
    SEAM(3);
    if (IN(4)) {
        pg8::Gemm g{(const bf16_t*)(ws + WS_X1B), (const bf16_t*)(ws + WS_WUP), MT, D_FF, 1024}; pg8::StaticOrder S; S.init(MT, D_FF, G, (int)blockIdx.x);
        EpiUp E{(const GAS float*)(ws + WS_SSQ), (GAS bf16_t*)(ws + WS_U)};
        pg8::gemm_phase<EpiUp, pg8::StaticOrder>(lds, g, S, E);
    }
    SEAM(4);
    if (IN(5)) {
        pg8::Gemm g{(const bf16_t*)(ws + WS_U), (const bf16_t*)(ws + WS_WDN), MT, 1024, D_FF}; pg8::StaticOrder S; S.init(MT, 1024, G, (int)blockIdx.x);
        EpiDown E{(GAS float*)p.out};
        pg8::gemm_phase<EpiDown, pg8::StaticOrder>(lds, g, S, E);
    }
#undef IN
#undef SEAM
}

extern "C" void kernel_launch(void* const* d_in, const int* in_sizes, int n_in, void* d_out, int out_size, void* d_ws, size_t ws_size, hipStream_t stream) {
    static int grid = 0;
    if (grid == 0) {
        if (n_in != 26 || ws_size < WS_END) { fprintf(stderr, "kernel_launch: expected 26 inputs and >= %zu bytes of workspace (got %d, %zu)\n", (size_t)WS_END, n_in, ws_size); grid = -1; return; }
        int dev = 0, cus = 0, per_cu = 0;
        hipGetDevice(&dev);
        hipDeviceGetAttribute(&cus, hipDeviceAttributeMultiprocessorCount, dev);
        if (hipFuncSetAttribute((const void*)fwd_kernel, hipFuncAttributeMaxDynamicSharedMemorySize, LDS_BYTES) != hipSuccess) { fprintf(stderr, "kernel_launch: hipFuncSetAttribute failed\n"); grid = -1; return; }
        if (hipOccupancyMaxActiveBlocksPerMultiprocessor(&per_cu, (const void*)fwd_kernel, 512, LDS_BYTES) != hipSuccess || per_cu < 1) { fprintf(stderr, "kernel_launch: occupancy query failed (%d)\n", per_cu); (void)hipGetLastError(); per_cu = 1; }
        grid = cus * per_cu;
        if (grid > 256) grid = 256;
    }
    if (grid < 0) return;
    Params a{};
    for (int i = 0; i < 26; ++i) a.in[i] = (const float*)d_in[i];
    a.out = (float*)d_out; a.ws = (unsigned char*)d_ws;
#if MK_N_LAUNCHES == 1
    a.ph_lo = 0; a.ph_hi = 6;
    void* args[] = {&a};
    hipError_t e = hipLaunchCooperativeKernel((const void*)fwd_kernel, dim3(grid), dim3(512), args, LDS_BYTES, stream);
    if (e != hipSuccess) fprintf(stderr, "cooperative launch failed: %s (grid %d)\n", hipGetErrorString(e), grid);
#else
    for (int ph = 0; ph < 6; ++ph) {
        a.ph_lo = ph; a.ph_hi = ph + 1;
        hipLaunchKernelGGL(fwd_kernel, dim3(grid), dim3(512), LDS_BYTES, stream, a);
    }
#endif
}
```

```cpp
#include <hip/hip_runtime.h>
#include <hip/hip_cooperative_groups.h>
#include <cstdio>
#include <cstdint>
namespace cg = cooperative_groups;

#ifndef MK_N_LAUNCHES
#define MK_N_LAUNCHES 1
#endif

#define GAS __attribute__((address_space(1)))
#define LAS __attribute__((address_space(3)))
typedef unsigned short bf16_t;
typedef short bf16x8 __attribute__((ext_vector_type(8)));
typedef short s16x4 __attribute__((ext_vector_type(4)));
typedef float f32x2 __attribute__((ext_vector_type(2)));
typedef float f32x4 __attribute__((ext_vector_type(4)));
typedef float f32x16 __attribute__((ext_vector_type(16)));
typedef unsigned u32x2 __attribute__((ext_vector_type(2)));
typedef unsigned u32x4 __attribute__((ext_vector_type(4)));
typedef __bf16 bf16v2 __attribute__((ext_vector_type(2)));
#define DI __device__ __forceinline__

constexpr int D_MODEL = 1024, SEQ = 2048, BATCH = 32, DEC_SEQ = 16;
constexpr int MP = BATCH * SEQ;
constexpr int MS = BATCH * DEC_SEQ;
constexpr int MT = MP + MS;
constexpr int IN_COLS = 2592, IN_PAD = 2816;
constexpr int RW_COLS = 1824, D_FF = 4096;
constexpr int NPOS = SEQ + DEC_SEQ;

constexpr size_t O_PK = 67633152, O_PV = 68157440, O_PW = 68681728, O_PS = 69730304, O_SK = 69788672, O_SV = 69854208, O_SW = 69919744, O_SS = 70968320;

constexpr size_t al256(size_t x) { return (x + 255) & ~(size_t)255; }
constexpr size_t WS_WIN = 0;
constexpr size_t WS_WOUT = WS_WIN + (size_t)IN_PAD * 1024 * 2;
constexpr size_t WS_WUP = WS_WOUT + (size_t)1024 * 1024 * 2;
constexpr size_t WS_WDN = WS_WUP + (size_t)4096 * 1024 * 2;
constexpr size_t WS_W2T = WS_WDN + (size_t)4096 * 1024 * 2;
constexpr size_t WS_A2T = WS_W2T + 512 * 64 * 2;
constexpr size_t WS_G2T = WS_A2T + 512 * 64 * 2;
constexpr size_t WS_ROPE = al256(WS_G2T + 512 * 160 * 2);
constexpr size_t WS_SSQ = al256(WS_ROPE + (size_t)NPOS * 64 * 4);
constexpr size_t WS_X1B = al256(WS_SSQ + (size_t)MT * 16 * 4);
constexpr size_t WS_H = al256(WS_X1B + (size_t)MT * 1024 * 2);
constexpr size_t WS_Q = WS_H + (size_t)MT * 1024 * 2;
constexpr size_t WS_K = WS_Q + (size_t)MT * 512 * 2;
constexpr size_t WS_V = WS_K + (size_t)MT * 128 * 2;
constexpr size_t WS_PRW = WS_V + (size_t)MT * 128 * 2;
constexpr size_t WS_MIX = WS_PRW + (size_t)MT * RW_COLS * 2;
constexpr size_t WS_AEND = WS_MIX + (size_t)MT * 1024 * 2;
constexpr size_t WS_U = WS_H;
static_assert(WS_U + (size_t)MT * 4096 * 2 <= WS_AEND, "U overlay");
constexpr size_t WS_END = WS_AEND;
static_assert(WS_END <= (size_t)1 << 30, "workspace");

constexpr int LDS_BYTES = 147456;

DI unsigned pk2(float lo, float hi) { f32x2 v = {lo, hi}; return __builtin_bit_cast(unsigned, __builtin_convertvector(v, bf16v2)); }
DI float bf2f(unsigned short b) { return __builtin_bit_cast(float, (unsigned)b << 16); }
DI float bflo(unsigned w) { return __builtin_bit_cast(float, w << 16); }
DI float bfhi(unsigned w) { return __builtin_bit_cast(float, w & 0xffff0000u); }
DI u32x4 pk8(f32x4 a, f32x4 b) { u32x4 w; w.x = pk2(a[0], a[1]); w.y = pk2(a[2], a[3]); w.z = pk2(b[0], b[1]); w.w = pk2(b[2], b[3]); return w; }
DI float wave_sum(float v) {
#pragma unroll
    for (int o = 1; o < 64; o <<= 1) v += __shfl_xor(v, o);
    return v;
}
template <int CTRL> DI float dpp_f(float x) { return __builtin_bit_cast(float, __builtin_amdgcn_mov_dpp(__builtin_bit_cast(int, x), CTRL, 0xf, 0xf, true)); }
DI float quad_sum(float x) { x += dpp_f<0xB1>(x); x += dpp_f<0x4E>(x); return x; }
DI float oct_sum(float x) { x = quad_sum(x); x += dpp_f<0x141>(x); return x; }
#define LDS_WAIT() asm volatile("s_waitcnt lgkmcnt(0)" ::: "memory")

namespace pg8 {
constexpr int BM = 256, BK = 64, HALF = 128, HTB = HALF * BK * 2, STAGE_BYTES = 8 * HTB, NXCD = 8, WGM = 8;
__host__ __device__ __forceinline__ int lds_byte(int r, int c) { const int st = (r >> 4) * 2 + (c >> 5), rr = r & 15, cc = c & 31, ob = rr * 64 + cc * 2; return st * 1024 + (ob ^ (((ob >> 9) & 1) << 5)); }
__host__ __device__ __forceinline__ void stage_rc(int b, int& R, int& C) { const int st = b / 1024, sb = b % 1024, swz = sb ^ (((sb >> 9) & 1) << 5); R = (st >> 1) * 16 + swz / 64; C = (st & 1) * 32 + (swz % 64) / 2; }
struct Unit { int pm, pn; };
struct Gemm { const bf16_t* A; const bf16_t* Bt; int M, N, K; };
struct StaticOrder {
    int nM, nN, nwg, G, c;
    __host__ __device__ void init(int M, int N, int G_, int c_) { nM = M / BM; nN = N / BM; nwg = nM * nN; G = G_; c = c_; }
    __host__ __device__ bool next(int i, Unit& u) const {
        const long L = (long)i * G + c; if (L >= nwg) return false;
        int wgid = (int)L; { const int q = nwg / NXCD, r = nwg % NXCD, xcd = wgid % NXCD, off = wgid / NXCD; wgid = (xcd < r ? xcd * (q + 1) : r * (q + 1) + (xcd - r) * q) + off; }
        const int nig = WGM * nN, gid = wgid / nig, fm = gid * WGM, gsz = (nM - fm) < WGM ? (nM - fm) : WGM;
        u.pm = fm + ((wgid % nig) % gsz); u.pn = (wgid % nig) / gsz; return true;
    }
};
template <class Epi, class Sched, bool ALIGN_EPI = true, bool SP2 = true>
__device__ __forceinline__ void gemm_phase(LAS unsigned char* lds, const Gemm g, const Sched& S, const Epi& E) {
    const int tid = threadIdx.x, wid = __builtin_amdgcn_readfirstlane(tid >> 6), lane = tid & 63, wr = wid >> 2, wc = wid & 3, fr = lane & 15, fq = lane >> 4;
    const int K = g.K, nt = K / BK;
    unsigned voffA[2];
#pragma unroll
    for (int i = 0; i < 2; ++i) { int R, C; stage_rc(tid * 16 + i * 8192, R, C); voffA[i] = (unsigned)(R * K + C) * 2u; }
    const size_t kstep = (size_t)(BK * 2);
    const size_t hstep = (size_t)HALF * K * 2;
    const size_t tstep = 2 * hstep;
    const unsigned ldsw = (unsigned)wid * 1024u;
    const int aoff = lds_byte(wr * 64 + fr, fq * 8), boff = lds_byte(wc * 32 + fr, fq * 8);
#define PG8_SA(b, h) (((b) * 2 + (h)) * HTB)
#define PG8_SB(b, h) ((4 + (b) * 2 + (h)) * HTB)
#define PG8_STAGE(bufoff, gbase, voff) do { _Pragma("unroll") for (int _i = 0; _i < 2; ++_i) \
        __builtin_amdgcn_global_load_lds((const unsigned*)((const char*)(gbase) + (voff)[_i]), (LAS unsigned*)(lds + (bufoff) + ldsw + _i * 8192), 16, 0, 0); } while (0)
#define PG8_LDA(dst, b, h) do { _Pragma("unroll") for (int m = 0; m < 4; ++m) _Pragma("unroll") for (int k = 0; k < 2; ++k) dst[m][k] = *(const LAS bf16x8*)(lds + PG8_SA(b, h) + aoff + m * 2048 + k * 1024); } while (0)
#define PG8_LDB(dst, b, h) do { _Pragma("unroll") for (int n = 0; n < 2; ++n) _Pragma("unroll") for (int k = 0; k < 2; ++k) dst[n][k] = *(const LAS bf16x8*)(lds + PG8_SB(b, h) + boff + n * 2048 + k * 1024); } while (0)
#define PG8_MMA(ai, bj, At, Bt) do { __builtin_amdgcn_s_setprio(1); _Pragma("unroll") for (int m = 0; m < 4; ++m) _Pragma("unroll") for (int n = 0; n < 2; ++n) _Pragma("unroll") for (int k = 0; k < 2; ++k) \
        acc[ai][bj][m][n] = __builtin_amdgcn_mfma_f32_16x16x32_bf16(Bt[n][k], At[m][k], acc[ai][bj][m][n], 0, 0, 0); __builtin_amdgcn_s_setprio(0); } while (0)
#define PG8_WAIT_V(n) asm volatile("s_waitcnt vmcnt(" #n ")" ::: "memory")
#define PG8_WAIT_L(n) asm volatile("s_waitcnt lgkmcnt(" #n ")" ::: "memory")
#define PG8_BAR __builtin_amdgcn_s_barrier()
#define PG8_SCHED __builtin_amdgcn_sched_barrier(0)
    Unit cur, nxt; int ui = 0;
    if (!S.next(0, cur)) return;
    f32x4 acc[2][2][4][2];
#pragma unroll
    for (int a = 0; a < 2; ++a)
#pragma unroll
        for (int b = 0; b < 2; ++b)
#pragma unroll
            for (int m = 0; m < 4; ++m)
#pragma unroll
                for (int n = 0; n < 2; ++n) acc[a][b][m][n] = (f32x4){0.f, 0.f, 0.f, 0.f};
    bf16x8 At[4][2], B0[2][2], B1[2][2];
    const char* cA = (const char*)g.A + (size_t)cur.pm * tstep; const char* cB = (const char*)g.Bt + (size_t)cur.pn * tstep;
    if constexpr (SP2) {
        PG8_STAGE(PG8_SB(0, 0), cB, voffA); PG8_STAGE(PG8_SB(0, 1), cB + hstep, voffA); PG8_STAGE(PG8_SA(0, 0), cA, voffA); PG8_STAGE(PG8_SA(0, 1), cA + hstep, voffA);
        if (wr == 1) PG8_BAR;
        PG8_WAIT_V(2); PG8_BAR;
        PG8_STAGE(PG8_SB(1, 0), cB + kstep, voffA); PG8_STAGE(PG8_SA(1, 0), cA + kstep, voffA); PG8_STAGE(PG8_SB(1, 1), cB + hstep + kstep, voffA);
        PG8_WAIT_V(6); PG8_BAR;
    } else {
        PG8_STAGE(PG8_SB(0, 0), cB, voffA); PG8_STAGE(PG8_SA(0, 0), cA, voffA); PG8_STAGE(PG8_SB(0, 1), cB + hstep, voffA); PG8_STAGE(PG8_SA(0, 1), cA + hstep, voffA);
        if (wr == 1) PG8_BAR;
        PG8_WAIT_V(4); PG8_BAR;
        PG8_STAGE(PG8_SB(1, 0), cB + kstep, voffA); PG8_STAGE(PG8_SA(1, 0), cA + kstep, voffA); PG8_STAGE(PG8_SB(1, 1), cB + hstep + kstep, voffA);
        PG8_WAIT_V(6); PG8_BAR;
    }
    for (;;) {
        const bool has_next = S.next(ui + 1, nxt);
        const char* nA = has_next ? (const char*)g.A + (size_t)nxt.pm * tstep : cA; const char* nB = has_next ? (const char*)g.Bt + (size_t)nxt.pn * tstep : cB;
        for (int t = 0; t < nt; t += 2) {
            const bool last = (t == nt - 2);
            const char* a1 = cA + (size_t)(t + 1) * kstep;
            const char* a2 = last ? nA : cA + (size_t)(t + 2) * kstep; const char* b2 = last ? nB : cB + (size_t)(t + 2) * kstep;
            const char* a3 = a2 + kstep; const char* b3 = b2 + kstep;
            if constexpr (SP2) {
            PG8_LDB(B0, 0, 0); PG8_LDB(B1, 0, 1); PG8_SCHED; PG8_LDA(At, 0, 0); PG8_STAGE(PG8_SA(1, 1), a1 + hstep, voffA);
            PG8_WAIT_V(8); PG8_WAIT_L(0); PG8_BAR; PG8_MMA(0, 0, At, B0); PG8_MMA(0, 1, At, B1); PG8_BAR; PG8_SCHED;
            PG8_LDA(At, 0, 1); PG8_STAGE(PG8_SB(0, 0), b2, voffA); PG8_STAGE(PG8_SB(0, 1), b2 + hstep, voffA); PG8_STAGE(PG8_SA(0, 0), a2, voffA);
            PG8_WAIT_V(8); PG8_WAIT_L(0); PG8_BAR; PG8_MMA(1, 0, At, B0); PG8_MMA(1, 1, At, B1); PG8_BAR; PG8_SCHED;
            PG8_LDB(B0, 1, 0); PG8_LDB(B1, 1, 1); PG8_SCHED; PG8_LDA(At, 1, 0); PG8_STAGE(PG8_SA(0, 1), a2 + hstep, voffA);
            PG8_WAIT_V(8); PG8_WAIT_L(0); PG8_BAR; PG8_MMA(0, 0, At, B0); PG8_MMA(0, 1, At, B1); PG8_BAR; PG8_SCHED;
            PG8_LDA(At, 1, 1); PG8_STAGE(PG8_SB(1, 0), b3, voffA); PG8_STAGE(PG8_SB(1, 1), b3 + hstep, voffA); PG8_STAGE(PG8_SA(1, 0), a3, voffA);
            PG8_WAIT_V(8); PG8_WAIT_L(0); PG8_BAR; PG8_MMA(1, 0, At, B0); PG8_MMA(1, 1, At, B1); PG8_BAR; PG8_SCHED;
            } else {
            PG8_LDB(B0, 0, 0); PG8_SCHED; PG8_LDA(At, 0, 0); PG8_STAGE(PG8_SA(1, 1), a1 + hstep, voffA);
            PG8_WAIT_L(8); PG8_BAR; PG8_WAIT_L(0); PG8_MMA(0, 0, At, B0); PG8_BAR; PG8_SCHED;
            PG8_LDB(B1, 0, 1); PG8_STAGE(PG8_SB(0, 0), b2, voffA);
            PG8_BAR; PG8_WAIT_L(0); PG8_MMA(0, 1, At, B1); PG8_BAR;
            PG8_LDA(At, 0, 1); PG8_STAGE(PG8_SA(0, 0), a2, voffA);
            PG8_BAR; PG8_WAIT_L(0); PG8_MMA(1, 0, At, B0); PG8_BAR; PG8_SCHED;
            PG8_STAGE(PG8_SB(0, 1), b2 + hstep, voffA);
            PG8_WAIT_V(6); PG8_BAR; PG8_MMA(1, 1, At, B1); PG8_BAR;
            PG8_LDB(B0, 1, 0); PG8_SCHED; PG8_LDA(At, 1, 0); PG8_STAGE(PG8_SA(0, 1), a2 + hstep, voffA);
            PG8_WAIT_L(8); PG8_BAR; PG8_WAIT_L(0); PG8_MMA(0, 0, At, B0); PG8_BAR; PG8_SCHED;
            PG8_LDB(B1, 1, 1); PG8_STAGE(PG8_SB(1, 0), b3, voffA);
            PG8_BAR; PG8_WAIT_L(0); PG8_MMA(0, 1, At, B1); PG8_BAR;
            PG8_LDA(At, 1, 1); PG8_STAGE(PG8_SA(1, 0), a3, voffA);
            PG8_BAR; PG8_WAIT_L(0); PG8_MMA(1, 0, At, B0); PG8_BAR; PG8_SCHED;
            PG8_STAGE(PG8_SB(1, 1), b3 + hstep, voffA);
            PG8_WAIT_V(6); PG8_BAR; PG8_MMA(1, 1, At, B1); PG8_BAR;
            }
        }
        if constexpr (ALIGN_EPI) { if (wr == 0) PG8_BAR; }
        E(acc, cur, wr, wc, fr, fq);
        if (!has_next) break;
#pragma unroll
        for (int a = 0; a < 2; ++a)
#pragma unroll
            for (int b = 0; b < 2; ++b)
#pragma unroll
                for (int m = 0; m < 4; ++m)
#pragma unroll
                    for (int n = 0; n < 2; ++n) acc[a][b][m][n] = (f32x4){0.f, 0.f, 0.f, 0.f};
        cur = nxt; cA = nA; cB = nB; ++ui;
        if constexpr (ALIGN_EPI) { if (wr == 1) PG8_BAR; }
    }
    PG8_WAIT_V(0);
    if constexpr (!ALIGN_EPI) { if (wr == 0) PG8_BAR; }
    PG8_BAR;
#undef PG8_SA
#undef PG8_SB
#undef PG8_STAGE
#undef PG8_LDA
#undef PG8_LDB
#undef PG8_MMA
#undef PG8_WAIT_V
#undef PG8_WAIT_L
#undef PG8_BAR
#undef PG8_SCHED
}
}

enum { MAP_NAT = 0, MAP_A = 1, MAP_B = 2 };
DI int rowmap(int mode, int c) {
    if (mode == MAP_NAT) return c;
    if (mode == MAP_A) { const int rem = c & 31; return (c & ~31) + 16 * ((rem >> 2) & 1) + 4 * (rem >> 3) + (rem & 3); }
    const int rem = c & 255; return (c & ~255) + 128 * ((rem >> 5) & 1) + 32 * (rem >> 6) + 16 * ((rem >> 2) & 1) + 4 * ((rem >> 3) & 3) + (rem & 3);
}

struct EpiIn {
    GAS bf16_t* Q; GAS bf16_t* Kb; GAS bf16_t* Vb; GAS bf16_t* PRW; GAS float* out; const GAS float* rope; const GAS float* qg; const GAS float* kg;
    DI void operator()(const f32x4 (&acc)[2][2][4][2], const pg8::Unit& u, int wr, int wc, int fr, int fq) const {
        const int H = u.pn * 4 + wc;
        const int row0 = u.pm * 256 + wr * 64 + fr;
        if (H < 10) {
            const bool isq = H < 8;
            const GAS float* g = isq ? qg : kg;
            f32x4 gv[2][2];
#pragma unroll
            for (int bj = 0; bj < 2; ++bj)
#pragma unroll
                for (int n = 0; n < 2; ++n) gv[bj][n] = *(const GAS f32x4*)(g + 32 * bj + 8 * fq + 4 * n);
#pragma unroll
            for (int ai = 0; ai < 2; ++ai)
#pragma unroll
                for (int m = 0; m < 4; ++m) {
                    const int row = row0 + ai * 128 + m * 16;
                    float ss = 0.f;
#pragma unroll
                    for (int bj = 0; bj < 2; ++bj)
#pragma unroll
                        for (int n = 0; n < 2; ++n) { const f32x4 x = acc[ai][bj][m][n]; ss += (x[0] * x[0] + x[1] * x[1]) + (x[2] * x[2] + x[3] * x[3]); }
                    ss += __shfl_xor(ss, 16); ss += __shfl_xor(ss, 32);
                    float rinv = __builtin_amdgcn_rsqf(ss * (1.f / 64.f) + 1e-6f);
                    if (isq) rinv *= 0.125f;
                    const bool samp = row >= MP;
                    const int rs = row - MP;
                    const int b = samp ? (rs >> 4) : (row >> 11), t = samp ? (rs & 15) : (row & 2047);
                    const int pi = samp ? (SEQ + t) : t;
                    const GAS float* rp = rope + (size_t)pi * 64 + 8 * fq;
                    f32x4 o1[2], o2[2];
#pragma unroll
                    for (int n = 0; n < 2; ++n) {
                        const f32x4 c4 = *(const GAS f32x4*)(rp + 4 * n), s4 = *(const GAS f32x4*)(rp + 32 + 4 * n);
                        const f32x4 x1 = acc[ai][0][m][n] * rinv * gv[0][n], x2 = acc[ai][1][m][n] * rinv * gv[1][n];
                        o1[n] = x1 * c4 - x2 * s4; o2[n] = x2 * c4 + x1 * s4;
                    }
                    if (isq) {
                        GAS bf16_t* qp = Q + (size_t)row * 512 + 64 * H + 8 * fq;
                        *(GAS u32x4*)qp = pk8(o1[0], o1[1]); *(GAS u32x4*)(qp + 32) = pk8(o2[0], o2[1]);
                    } else {
                        const int kvh = H - 8;
                        GAS bf16_t* kp = Kb + (size_t)row * 128 + 64 * kvh + 8 * fq;
                        *(GAS u32x4*)kp = pk8(o1[0], o1[1]); *(GAS u32x4*)(kp + 32) = pk8(o2[0], o2[1]);
                        if (samp || t >= SEQ - 128) {
                            GAS float* op = samp ? out + O_SK + ((size_t)(b * 16 + t) * 2 + kvh) * 64 + 8 * fq : out + O_PK + ((size_t)(b * 128 + (t - (SEQ - 128))) * 2 + kvh) * 64 + 8 * fq;
                            *(GAS f32x4*)op = o1[0]; *(GAS f32x4*)(op + 4) = o1[1]; *(GAS f32x4*)(op + 32) = o2[0]; *(GAS f32x4*)(op + 36) = o2[1];
                        }
                    }
                }
        } else if (H < 12) {
            const int kvh = H - 10;
#pragma unroll
            for (int ai = 0; ai < 2; ++ai)
#pragma unroll
                for (int m = 0; m < 4; ++m) {
                    const int row = row0 + ai * 128 + m * 16;
                    const bool samp = row >= MP;
                    const int rs = row - MP;
                    const int b = samp ? (rs >> 4) : (row >> 11), t = samp ? (rs & 15) : (row & 2047);
                    GAS bf16_t* vp = Vb + (size_t)row * 128 + 64 * kvh + 8 * fq;
                    *(GAS u32x4*)vp = pk8(acc[ai][0][m][0], acc[ai][0][m][1]); *(GAS u32x4*)(vp + 32) = pk8(acc[ai][1][m][0], acc[ai][1][m][1]);
                    if (samp || t >= SEQ - 128) {
                        GAS float* op = samp ? out + O_SV + ((size_t)(b * 16 + t) * 2 + kvh) * 64 + 8 * fq : out + O_PV + ((size_t)(b * 128 + (t - (SEQ - 128))) * 2 + kvh) * 64 + 8 * fq;
                        *(GAS f32x4*)op = acc[ai][0][m][0]; *(GAS f32x4*)(op + 4) = acc[ai][0][m][1]; *(GAS f32x4*)(op + 32) = acc[ai][1][m][0]; *(GAS f32x4*)(op + 36) = acc[ai][1][m][1];
                    }
                }
        } else {
            const int cr0 = (H - 12) * 64 + 8 * fq;
#pragma unroll
            for (int ai = 0; ai < 2; ++ai)
#pragma unroll
                for (int m = 0; m < 4; ++m) {
                    const int row = row0 + ai * 128 + m * 16;
                    const bool samp = row >= MP;
                    const int rs = row - MP;
                    const int b = samp ? (rs >> 4) : (row >> 11), t = samp ? (rs & 15) : (row & 2047);
                    const bool lastrow = samp ? (t == DEC_SEQ - 1) : (t == SEQ - 1);
#pragma unroll
                    for (int bj = 0; bj < 2; ++bj) {
                        const int cr = cr0 + 32 * bj;
                        if (cr < RW_COLS) {
                            *(GAS u32x4*)(PRW + (size_t)row * RW_COLS + cr) = pk8(acc[ai][bj][m][0], acc[ai][bj][m][1]);
                            if (lastrow) { GAS float* op = out + (samp ? O_SS : O_PS) + (size_t)b * RW_COLS + cr; *(GAS f32x4*)op = acc[ai][bj][m][0]; *(GAS f32x4*)(op + 4) = acc[ai][bj][m][1]; }
                        }
                    }
                }
        }
    }
};
struct EpiOut {
    const GAS float* xp; const GAS float* xs; GAS float* out; GAS bf16_t* X1B; GAS float* SSQ;
    DI void operator()(const f32x4 (&acc)[2][2][4][2], const pg8::Unit& u, int wr, int wc, int fr, int fq) const {
        const int row0 = u.pm * 256 + wr * 64 + fr, col0 = u.pn * 256 + wc * 32 + 4 * fq;
        const GAS float* xin = (u.pm < 256) ? xp : xs - (size_t)MP * 1024;
#pragma unroll
        for (int ai = 0; ai < 2; ++ai)
#pragma unroll
            for (int m = 0; m < 4; ++m) {
                const int row = row0 + ai * 128 + m * 16; const size_t off = (size_t)row * 1024 + col0;
                float ss = 0.f;
#pragma unroll
                for (int bj = 0; bj < 2; ++bj)
#pragma unroll
                    for (int n = 0; n < 2; ++n) {
                        const f32x4 o = *(const GAS f32x4*)(xin + off + bj * 128 + n * 16) + acc[ai][bj][m][n];
                        *(GAS f32x4*)(out + off + bj * 128 + n * 16) = o;
                        u32x2 w; w.x = pk2(o[0], o[1]); w.y = pk2(o[2], o[3]);
                        *(GAS u32x2*)(X1B + off + bj * 128 + n * 16) = w;
                        ss += (o[0] * o[0] + o[1] * o[1]) + (o[2] * o[2] + o[3] * o[3]);
                    }
                ss += __shfl_xor(ss, 16); ss += __shfl_xor(ss, 32);
                if (fq == 0) SSQ[(size_t)row * 16 + u.pn * 4 + wc] = ss;
            }
    }
};
struct EpiUp {
    const GAS float* SSQ; GAS bf16_t* U;
    DI void operator()(const f32x4 (&acc)[2][2][4][2], const pg8::Unit& u, int wr, int wc, int fr, int fq) const {
        const int row0 = u.pm * 256 + wr * 64 + fr, col0 = u.pn * 256 + wc * 32 + 8 * fq;
#pragma unroll
        for (int ai = 0; ai < 2; ++ai)
#pragma unroll
            for (int m = 0; m < 4; ++m) {
                const int row = row0 + ai * 128 + m * 16;
                const GAS f32x4* sp = (const GAS f32x4*)(SSQ + (size_t)row * 16);
                const f32x4 a = sp[0], b = sp[1], c = sp[2], d = sp[3];
                const f32x4 t4 = (a + b) + (c + d);
                const float tot = (t4[0] + t4[1]) + (t4[2] + t4[3]);
                const float s2 = 1.0f / (tot * (1.f / 1024.f) + 1e-6f);
#pragma unroll
                for (int bj = 0; bj < 2; ++bj) {
                    f32x4 v0 = acc[ai][bj][m][0], v1 = acc[ai][bj][m][1];
#pragma unroll
                    for (int j = 0; j < 4; ++j) { const float r0 = fmaxf(v0[j], 0.f), r1 = fmaxf(v1[j], 0.f); v0[j] = r0 * r0 * s2; v1[j] = r1 * r1 * s2; }
                    *(GAS u32x4*)(U + (size_t)row * D_FF + col0 + bj * 128) = pk8(v0, v1);
                }
            }
    }
};
struct EpiDown {
    GAS float* out;
    DI void operator()(const f32x4 (&acc)[2][2][4][2], const pg8::Unit& u, int wr, int wc, int fr, int fq) const {
        const int row0 = u.pm * 256 + wr * 64 + fr, col0 = u.pn * 256 + wc * 32 + 4 * fq;
#pragma unroll
        for (int ai = 0; ai < 2; ++ai)
#pragma unroll
            for (int m = 0; m < 4; ++m) {
                const size_t off = (size_t)(row0 + ai * 128 + m * 16) * 1024 + col0;
#pragma unroll
                for (int bj = 0; bj < 2; ++bj)
#pragma unroll
                    for (int n = 0; n < 2; ++n) { GAS float* p = out + off + bj * 128 + n * 16; *(GAS f32x4*)p = *(const GAS f32x4*)p + acc[ai][bj][m][n]; }
            }
    }
};

DI void p0_transpose_item(const GAS float* W, int K, int N, GAS bf16_t* WT, int mode, const GAS float* kscale, LAS float* scr, int item, int lane) {
    const int nblk = N / 32, kb = item / nblk, nb = item % nblk, k0 = 64 * kb, n0 = 32 * nb;
#pragma unroll 8
    for (int i = 0; i < 32; ++i) { const int kk = 2 * i + (lane >> 5); float v = W[(size_t)(k0 + kk) * N + n0 + (lane & 31)]; if (kscale) v *= kscale[k0 + kk]; scr[kk * 33 + (lane & 31)] = v; }
    LDS_WAIT();
    const int c = lane & 7;
#pragma unroll
    for (int j = 0; j < 4; ++j) { const int n = (lane >> 3) + 8 * j; const LAS float* s = scr + (8 * c) * 33 + n;
        u32x4 o; o.x = pk2(s[0 * 33], s[1 * 33]); o.y = pk2(s[2 * 33], s[3 * 33]); o.z = pk2(s[4 * 33], s[5 * 33]); o.w = pk2(s[6 * 33], s[7 * 33]);
        *(GAS u32x4*)(WT + (size_t)rowmap(mode, n0 + n) * K + k0 + 8 * c) = o; }
    LDS_WAIT();
}
DI void sincos_d(double x, double& s, double& c) {
    const double TWO_PI = 6.283185307179586476925287;
    const double n = __builtin_rint(x * (1.0 / TWO_PI));
    const double r = x - n * TWO_PI, r2 = r * r;
    double ps = 1.0, pc = 1.0;
#pragma unroll
    for (int k = 14; k >= 1; --k) { ps = 1.0 - ps * r2 / (double)((2 * k) * (2 * k + 1)); pc = 1.0 - pc * r2 / (double)((2 * k - 1) * (2 * k)); }
    s = r * ps; c = pc;
}

struct Params { const float* in[26]; float* out; unsigned char* ws; int ph_lo, ph_hi; };

DI void phase0(const Params& p, LAS unsigned char* lds, int G) {
    const int tid = threadIdx.x, lane = tid & 63, wave = tid >> 6;
    const int gw = blockIdx.x * 8 + wave, NGW = G * 8;
    LAS float* scr = (LAS float*)(lds + wave * 8704);
    unsigned char* ws = p.ws;
    const GAS float* w_in = (const GAS float*)p.in[7]; const GAS float* w_out = (const GAS float*)p.in[22]; const GAS float* w_up = (const GAS float*)p.in[24]; const GAS float* w_dn = (const GAS float*)p.in[25];
    const GAS float* ln2 = (const GAS float*)p.in[23];
    constexpr int I_IN = 16 * (IN_COLS / 32), I_OUT = 16 * 32, I_UP = 16 * 128, I_DN = 64 * 32, NITEMS = I_IN + I_OUT + I_UP + I_DN;
    for (int it = gw; it < NITEMS; it += NGW) {
        int r = it;
        if (r < I_IN) { p0_transpose_item(w_in, 1024, IN_COLS, (GAS bf16_t*)(ws + WS_WIN), MAP_B, nullptr, scr, r, lane); continue; } r -= I_IN;
        if (r < I_OUT) { p0_transpose_item(w_out, 1024, 1024, (GAS bf16_t*)(ws + WS_WOUT), MAP_NAT, nullptr, scr, r, lane); continue; } r -= I_OUT;
        if (r < I_UP) { p0_transpose_item(w_up, 1024, 4096, (GAS bf16_t*)(ws + WS_WUP), MAP_A, ln2, scr, r, lane); continue; } r -= I_UP;
        p0_transpose_item(w_dn, 4096, 1024, (GAS bf16_t*)(ws + WS_WDN), MAP_NAT, nullptr, scr, r, lane);
    }
    const int gt = blockIdx.x * 512 + tid, NGT = G * 512;
    for (int i = gt; i < (IN_PAD - IN_COLS) * 128; i += NGT) { const int c = IN_COLS + i / 128; *(GAS u32x4*)((GAS bf16_t*)(ws + WS_WIN) + (size_t)rowmap(MAP_B, c) * 1024 + (i % 128) * 8) = (u32x4){0u, 0u, 0u, 0u}; }
    { const GAS float* w2 = (const GAS float*)p.in[13]; const GAS float* a2 = (const GAS float*)p.in[15]; const GAS float* g2 = (const GAS float*)p.in[16];
      GAS bf16_t* W2T = (GAS bf16_t*)(ws + WS_W2T); GAS bf16_t* A2T = (GAS bf16_t*)(ws + WS_A2T); GAS bf16_t* G2T = (GAS bf16_t*)(ws + WS_G2T);
      for (int i = gt; i < 512 * 32; i += NGT) { const int n = i >> 5, k2 = (i & 31) * 2;
          *(GAS unsigned*)(W2T + n * 64 + k2) = pk2(w2[k2 * 512 + n], w2[(k2 + 1) * 512 + n]);
          *(GAS unsigned*)(A2T + n * 64 + k2) = pk2(a2[k2 * 512 + n], a2[(k2 + 1) * 512 + n]); }
      for (int i = gt; i < 512 * 80; i += NGT) { const int n = i / 80, k2 = (i % 80) * 2; *(GAS unsigned*)(G2T + n * 160 + k2) = pk2(g2[k2 * 512 + n], g2[(k2 + 1) * 512 + n]); } }
    { GAS float* rope = (GAS float*)(ws + WS_ROPE);
      for (int i = gt; i < NPOS * 32; i += NGT) { const int pi = i >> 5, f = i & 31; const int pos = pi < SEQ ? pi : 4096 + (pi - SEQ);
          const float inv = (float)exp(-(double)f * (9.210340371976182736 / 32.0));
          const float ang = (float)pos * inv;
          double s, c; sincos_d((double)ang, s, c);
          rope[(size_t)pi * 64 + f] = (float)c; rope[(size_t)pi * 64 + 32 + f] = (float)s; } }
    { const GAS float* g1 = (const GAS float*)p.in[6]; GAS bf16_t* Hh = (GAS bf16_t*)(ws + WS_H);
      f32x4 gv[4];
#pragma unroll
      for (int j = 0; j < 4; ++j) gv[j] = *((const GAS f32x4*)g1 + lane + 64 * j);
      for (int m = gw; m < MT; m += NGW) {
          const GAS float* xrow = (m < MP) ? (const GAS float*)p.in[0] + (size_t)m * 1024 : (const GAS float*)p.in[1] + (size_t)(m - MP) * 1024;
          const GAS f32x4* xr = (const GAS f32x4*)xrow + lane;
          f32x4 v[4]; float s = 0.f;
#pragma unroll
          for (int j = 0; j < 4; ++j) { v[j] = xr[64 * j]; s += (v[j][0] * v[j][0] + v[j][1] * v[j][1]) + (v[j][2] * v[j][2] + v[j][3] * v[j][3]); }
          const float rinv = __builtin_amdgcn_rsqf(wave_sum(s) * (1.f / 1024.f) + 1e-6f);
          GAS u32x2* o8 = (GAS u32x2*)(Hh + (size_t)m * 1024) + lane;
#pragma unroll
          for (int j = 0; j < 4; ++j) { const f32x4 y = v[j] * rinv * gv[j]; u32x2 w; w.x = pk2(y[0], y[1]); w.y = pk2(y[2], y[3]); o8[64 * j] = w; }
      } }
}

constexpr int KS_STRIDE = 144;
constexpr int VT_STRIDE = 392;
constexpr int VT_OFF = 192 * KS_STRIDE;
#define MFMA32(a, b, c) __builtin_amdgcn_mfma_f32_32x32x16_bf16((a), (b), (c), 0, 0, 0)

DI void attn_store_kv(LAS unsigned char* lds, int row, int ch, u32x4 kv, u32x4 vv) {
    *(LAS u32x4*)(lds + row * KS_STRIDE + ch * 16) = kv;
    LAS unsigned short* vt = (LAS unsigned short*)(lds + VT_OFF + (8 * ch) * VT_STRIDE + row * 2);
    const unsigned w[4] = {vv.x, vv.y, vv.z, vv.w};
#pragma unroll
    for (int i = 0; i < 4; ++i) { vt[(2 * i) * (VT_STRIDE / 2)] = (unsigned short)(w[i] & 0xffffu); vt[(2 * i + 1) * (VT_STRIDE / 2)] = (unsigned short)(w[i] >> 16); }
}
DI void attn_wave(LAS unsigned char* lds, const GAS bf16_t* qptr  , GAS bf16_t* optr, float sink, int kt0, int nkt, bool mask_last_half, bool do_store, int lane) {
    const int r = lane & 31, h = lane >> 5;
    bf16x8 qf[4];
#pragma unroll
    for (int ks = 0; ks < 4; ++ks) qf[ks] = *(const GAS bf16x8*)(qptr + 16 * ks + 8 * h);
    f32x16 st[6];
#pragma unroll
    for (int kt = 0; kt < 6; ++kt) {
#pragma unroll
        for (int i = 0; i < 16; ++i) st[kt][i] = 0.f;
        if (kt >= kt0 && kt < nkt) {
#pragma unroll
            for (int ks = 0; ks < 4; ++ks) { const bf16x8 kf = *(const LAS bf16x8*)(lds + (32 * kt + r) * KS_STRIDE + (16 * ks + 8 * h) * 2); st[kt] = MFMA32(kf, qf[ks], st[kt]); }
        }
    }
    float mx = sink;
#pragma unroll
    for (int kt = 0; kt < 6; ++kt) if (kt >= kt0 && kt < nkt) {
#pragma unroll
        for (int i = 0; i < 16; ++i) { const bool dead = mask_last_half && kt == nkt - 1 && i >= 8; if (!dead) mx = fmaxf(mx, st[kt][i]); }
    }
    mx = fmaxf(mx, __shfl_xor(mx, 32));
    float l = 0.f;
#pragma unroll
    for (int kt = 0; kt < 6; ++kt) if (kt >= kt0 && kt < nkt) {
#pragma unroll
        for (int i = 0; i < 16; ++i) { const bool dead = mask_last_half && kt == nkt - 1 && i >= 8; const float pv = dead ? 0.f : __expf(st[kt][i] - mx); st[kt][i] = pv; l += pv; }
    }
    l += __shfl_xor(l, 32);
    const float inv = 1.0f / (l + __expf(sink - mx));
    f32x16 ot[2];
#pragma unroll
    for (int dt = 0; dt < 2; ++dt)
#pragma unroll
        for (int i = 0; i < 16; ++i) ot[dt][i] = 0.f;
#pragma unroll
    for (int kt = 0; kt < 6; ++kt) if (kt >= kt0 && kt < nkt) {
#pragma unroll
        for (int s = 0; s < 2; ++s) {
            u32x4 pw; pw.x = pk2(st[kt][8 * s], st[kt][8 * s + 1]); pw.y = pk2(st[kt][8 * s + 2], st[kt][8 * s + 3]); pw.z = pk2(st[kt][8 * s + 4], st[kt][8 * s + 5]); pw.w = pk2(st[kt][8 * s + 6], st[kt][8 * s + 7]);
            const bf16x8 pf = __builtin_bit_cast(bf16x8, pw);
#pragma unroll
            for (int dt = 0; dt < 2; ++dt) {
                const LAS unsigned char* vp = lds + VT_OFF + (32 * dt + r) * VT_STRIDE + (32 * kt + 16 * s + 4 * h) * 2;
                const u32x2 v0 = *(const LAS u32x2*)vp, v1 = *(const LAS u32x2*)(vp + 16);
                u32x4 vw; vw.x = v0.x; vw.y = v0.y; vw.z = v1.x; vw.w = v1.y;
                ot[dt] = MFMA32(__builtin_bit_cast(bf16x8, vw), pf, ot[dt]);
            }
        }
    }
    if (do_store) {
#pragma unroll
        for (int dt = 0; dt < 2; ++dt)
#pragma unroll
            for (int rg = 0; rg < 4; ++rg) {
                u32x2 w; w.x = pk2(ot[dt][4 * rg] * inv, ot[dt][4 * rg + 1] * inv); w.y = pk2(ot[dt][4 * rg + 2] * inv, ot[dt][4 * rg + 3] * inv);
                *(GAS u32x2*)(optr + 32 * dt + 8 * rg + 4 * h) = w;
            }
    }
}
DI void attn_phase(const Params& p, LAS unsigned char* lds, int G) {
    const int tid = threadIdx.x, lane = tid & 63, wid = __builtin_amdgcn_readfirstlane(tid >> 6);
    unsigned char* ws = p.ws;
    const GAS bf16_t* Q = (const GAS bf16_t*)(ws + WS_Q); const GAS bf16_t* Kb = (const GAS bf16_t*)(ws + WS_K); const GAS bf16_t* Vb = (const GAS bf16_t*)(ws + WS_V);
    GAS bf16_t* MIX = (GAS bf16_t*)(ws + WS_MIX);
    const GAS float* sinks = (const GAS float*)p.in[10];
    constexpr int NPI = BATCH * 32 * 2, NSI = BATCH * 2;
    for (int it = blockIdx.x; it < NPI + NSI; it += G) {
        __syncthreads();
        if (it < NPI) {
            const int g = it & 1, n = (it >> 1) & 31, b = it >> 6;
            const int kt0 = n >= 2 ? 0 : (2 - n) * 2;
            const int krow0 = b * SEQ + 64 * (n - 2);
#pragma unroll
            for (int i = 0; i < 3; ++i) {
                const int cid = tid + 512 * i, row = cid >> 3, ch = cid & 7;
                if (row >= 32 * kt0) {
                    const size_t go = (size_t)(krow0 + row) * 128 + 64 * g + 8 * ch;
                    attn_store_kv(lds, row, ch, *(const GAS u32x4*)(Kb + go), *(const GAS u32x4*)(Vb + go));
                }
            }
            __syncthreads();
            const int hq = 4 * g + (wid >> 1);
            const int qrow = b * SEQ + 64 * n + 32 * (wid & 1) + (lane & 31);
            attn_wave(lds, Q + (size_t)qrow * 512 + 64 * hq, MIX + (size_t)qrow * 1024 + 64 * hq, sinks[hq], kt0, 6, false, true, lane);
        } else {
            const int si = it - NPI, g = si & 1, b = si >> 1;
            const GAS float* ck = (const GAS float*)p.in[2]; const GAS float* cv = (const GAS float*)p.in[3];
#pragma unroll
            for (int i = 0; i < 3; ++i) {
                const int cid = tid + 512 * i, row = cid >> 3, ch = cid & 7;
                if (row < 160) {
                    u32x4 kv = {0u, 0u, 0u, 0u}, vv = {0u, 0u, 0u, 0u};
                    if (row < 128) {
                        const size_t go = ((size_t)(b * 128 + row) * 2 + g) * 64 + 8 * ch;
                        kv = pk8(*(const GAS f32x4*)(ck + go), *(const GAS f32x4*)(ck + go + 4)); vv = pk8(*(const GAS f32x4*)(cv + go), *(const GAS f32x4*)(cv + go + 4));
                    } else if (row < 144) {
                        const size_t go = (size_t)(MP + b * 16 + (row - 128)) * 128 + 64 * g + 8 * ch;
                        kv = *(const GAS u32x4*)(Kb + go); vv = *(const GAS u32x4*)(Vb + go);
                    }
                    attn_store_kv(lds, row, ch, kv, vv);
                }
            }
            __syncthreads();
            if (wid < 4) {
                const int hq = 4 * g + wid;
                const int qrow = MP + b * 16 + (lane & 15);
                attn_wave(lds, Q + (size_t)qrow * 512 + 64 * hq, MIX + (size_t)qrow * 1024 + 64 * hq, sinks[hq], 0, 5, true, (lane & 31) < 16, lane);
            }
        }
    }
    __syncthreads();
}

constexpr int TSTR = 388;
constexpr int RW_OPB = 0;
constexpr int RW_SC = RW_OPB + 2 * 16 * TSTR * 4;
constexpr int RW_GB = RW_SC + 2 * 16 * 4 * 4;
constexpr int RW_YB = RW_GB + 2 * 16 * 64 * 4;
constexpr int RW_LW2 = RW_YB + 2 * 16 * 64 * 4;
constexpr int RW_LA2 = RW_LW2 + 64 * 144;
constexpr int RW_LG2 = RW_LA2 + 64 * 144;
constexpr int RW_CV = RW_LG2 + 64 * 336;
constexpr int RW_MUL = RW_CV + 10 * 64 * 4;
constexpr int RW_END = RW_MUL + 288 * 4;
static_assert(RW_END <= LDS_BYTES, "rwkv LDS");
enum { CV_W0 = 0, CV_A0, CV_KK, CV_KA, CV_RK, CV_LG, CV_LB, CV_MR, CV_MK, CV_MV };
#define MFMA16(a, b, c) __builtin_amdgcn_mfma_f32_16x16x32_bf16((a), (b), (c), 0, 0, 0)

struct RwSeq { const GAS bf16_t* prw; const GAS float* shift0; const GAS float* wkv0; GAS float* wkv_out; GAS bf16_t* mix; int ntok; int h; };

DI f32x4 ld4bf(const GAS bf16_t* p) { const u32x2 w = *(const GAS u32x2*)p; return (f32x4){bflo(w.x), bfhi(w.x), bflo(w.y), bfhi(w.y)}; }
DI void ld8bf(const GAS bf16_t* p, float (&o)[8]) { const u32x4 w = *(const GAS u32x4*)p; o[0] = bflo(w.x); o[1] = bfhi(w.x); o[2] = bflo(w.y); o[3] = bfhi(w.y); o[4] = bflo(w.z); o[5] = bfhi(w.z); o[6] = bflo(w.w); o[7] = bfhi(w.w); }

DI void rwkv_prep(LAS unsigned char* lds, const RwSeq& sq, int n, int buf, int lane) {
    const int tk = lane & 15, q = lane >> 4, t = 16 * n + tk;
    const GAS bf16_t* prow = sq.prw + (size_t)t * RW_COLS;
    const bool hasprev = t > 0, hass0 = sq.shift0 != nullptr;
    const LAS float* CV = (const LAS float*)(lds + RW_CV);
    const LAS float* MUL = (const LAS float*)(lds + RW_MUL);
    f32x4 aw[4], aa[4], ag[4];
#pragma unroll
    for (int ct = 0; ct < 4; ++ct) { aw[ct] = (f32x4){0.f, 0.f, 0.f, 0.f}; aa[ct] = aw[ct]; ag[ct] = aw[ct]; }
#pragma unroll
    for (int ks = 0; ks < 9; ++ks) {
        const int col = 1536 + 32 * ks + 8 * q;
        float pc[8], pp[8];
        ld8bf(prow + col, pc);
        if (hasprev) ld8bf(prow - RW_COLS + col, pp);
        else {
#pragma unroll
            for (int j = 0; j < 8; ++j) pp[j] = hass0 ? sq.shift0[col + j] : 0.f;
        }
        float xs[8];
#pragma unroll
        for (int j = 0; j < 8; ++j) {
            const float x = pc[j] + (pp[j] - pc[j]) * MUL[32 * ks + 8 * q + j];
            if (ks < 2) xs[j] = 1.0f - 2.0f / (__expf(2.0f * x) + 1.0f);
            else if (ks < 4) xs[j] = x;
            else xs[j] = 1.0f / (1.0f + __expf(-x));
        }
        u32x4 w; w.x = pk2(xs[0], xs[1]); w.y = pk2(xs[2], xs[3]); w.z = pk2(xs[4], xs[5]); w.w = pk2(xs[6], xs[7]);
        const bf16x8 f = __builtin_bit_cast(bf16x8, w);
#pragma unroll
        for (int ct = 0; ct < 4; ++ct) {
            const int wrow = 16 * ct + tk;
            if (ks < 2) aw[ct] = MFMA16(*(const LAS bf16x8*)(lds + RW_LW2 + wrow * 144 + (32 * ks + 8 * q) * 2), f, aw[ct]);
            else if (ks < 4) aa[ct] = MFMA16(*(const LAS bf16x8*)(lds + RW_LA2 + wrow * 144 + (32 * (ks - 2) + 8 * q) * 2), f, aa[ct]);
            else ag[ct] = MFMA16(*(const LAS bf16x8*)(lds + RW_LG2 + wrow * 336 + (32 * (ks - 4) + 8 * q) * 2), f, ag[ct]);
        }
        asm volatile("" ::: "memory");
    }
    float ssq = 0.f, br = 0.f, kr = 0.f, bon = 0.f;
    LAS float* ob = (LAS float*)(lds + RW_OPB) + (buf * 16 + tk) * TSTR;
#pragma unroll
    for (int ct = 0; ct < 4; ++ct) {
        const int c = 16 * ct + 4 * q;
        const int gc = 64 * sq.h + c;
        f32x4 pr = ld4bf(prow + gc), pk = ld4bf(prow + 512 + gc), pv = ld4bf(prow + 1024 + gc), qr, qk, qv;
        if (hasprev) { qr = ld4bf(prow - RW_COLS + gc); qk = ld4bf(prow - RW_COLS + 512 + gc); qv = ld4bf(prow - RW_COLS + 1024 + gc); }
        else if (hass0) { qr = *(const GAS f32x4*)(sq.shift0 + gc); qk = *(const GAS f32x4*)(sq.shift0 + 512 + gc); qv = *(const GAS f32x4*)(sq.shift0 + 1024 + gc); }
        else { qr = (f32x4){0.f, 0.f, 0.f, 0.f}; qk = qr; qv = qr; }
        const f32x4 mr = *(const LAS f32x4*)(CV + CV_MR * 64 + c), mk = *(const LAS f32x4*)(CV + CV_MK * 64 + c), mv = *(const LAS f32x4*)(CV + CV_MV * 64 + c);
        const f32x4 rr = pr + (qr - pr) * mr, kx = pk + (qk - pk) * mk, vv = pv + (qv - pv) * mv;
        const f32x4 w0 = *(const LAS f32x4*)(CV + CV_W0 * 64 + c), a0 = *(const LAS f32x4*)(CV + CV_A0 * 64 + c), kkc = *(const LAS f32x4*)(CV + CV_KK * 64 + c),
                    kac = *(const LAS f32x4*)(CV + CV_KA * 64 + c), rkc = *(const LAS f32x4*)(CV + CV_RK * 64 + c);
        f32x4 dec, asg, kp;
#pragma unroll
        for (int j = 0; j < 4; ++j) {
            const float z = -(w0[j] + aw[ct][j]);
            const float sp = fmaxf(z, 0.f) + __logf(1.0f + __expf(-fabsf(z)));
            dec[j] = __expf(-__expf(-sp - 0.5f));
            asg[j] = 1.0f / (1.0f + __expf(-(a0[j] + aa[ct][j])));
            kp[j] = kx[j] * (1.0f + (asg[j] - 1.0f) * kac[j]);
        }
        const f32x4 kkr = kx * kkc, bun = kkr * asg;
        ssq += (kkr[0] * kkr[0] + kkr[1] * kkr[1]) + (kkr[2] * kkr[2] + kkr[3] * kkr[3]);
        br += (bun[0] * rr[0] + bun[1] * rr[1]) + (bun[2] * rr[2] + bun[3] * rr[3]);
        kr += (kp[0] * rr[0] + kp[1] * rr[1]) + (kp[2] * rr[2] + kp[3] * rr[3]);
        bon += (rr[0] * kp[0] * rkc[0] + rr[1] * kp[1] * rkc[1]) + (rr[2] * kp[2] * rkc[2] + rr[3] * kp[3] * rkc[3]);
        *(LAS f32x4*)(ob + 0 * 64 + c) = -kkr;
        *(LAS f32x4*)(ob + 1 * 64 + c) = dec * rr;
        *(LAS f32x4*)(ob + 2 * 64 + c) = dec;
        *(LAS f32x4*)(ob + 3 * 64 + c) = bun;
        *(LAS f32x4*)(ob + 4 * 64 + c) = kp;
        *(LAS f32x4*)(ob + 5 * 64 + c) = vv;
        *(LAS f32x4*)((LAS float*)(lds + RW_GB) + (buf * 16 + tk) * 64 + c) = ag[ct];
    }
    ssq += __shfl_xor(ssq, 16); ssq += __shfl_xor(ssq, 32);
    br += __shfl_xor(br, 16); br += __shfl_xor(br, 32);
    kr += __shfl_xor(kr, 16); kr += __shfl_xor(kr, 32);
    bon += __shfl_xor(bon, 16); bon += __shfl_xor(bon, 32);
    const float kinv = 1.0f / fmaxf(sqrtf(ssq), 1e-12f);
    if (q == 0) *(LAS f32x4*)((LAS float*)(lds + RW_SC) + (buf * 16 + tk) * 4) = (f32x4){br, kr, bon, kinv * kinv};
}
DI void rwkv_post(LAS unsigned char* lds, const RwSeq& sq, int n, int buf, int lane) {
    const int tk = lane >> 2, cq = lane & 3, c0 = 16 * cq, t = 16 * n + tk;
    const LAS float* yb = (const LAS float*)(lds + RW_YB) + (buf * 16 + tk) * 64 + c0;
    const LAS float* CV = (const LAS float*)(lds + RW_CV);
    f32x4 y[4]; float s = 0.f;
#pragma unroll
    for (int i = 0; i < 4; ++i) { y[i] = *(const LAS f32x4*)(yb + 4 * i); s += (y[i][0] + y[i][1]) + (y[i][2] + y[i][3]); }
    const float mu = quad_sum(s) * (1.f / 64.f);
    float qv = 0.f;
#pragma unroll
    for (int i = 0; i < 4; ++i) { y[i] = y[i] - mu; qv += (y[i][0] * y[i][0] + y[i][1] * y[i][1]) + (y[i][2] * y[i][2] + y[i][3] * y[i][3]); }
    const float rs = __builtin_amdgcn_rsqf(quad_sum(qv) * (1.f / 64.f) + 64e-5f);
    const float bon = ((const LAS float*)(lds + RW_SC))[(buf * 16 + tk) * 4 + 2];
    const LAS float* vb = (const LAS float*)(lds + RW_OPB) + (buf * 16 + tk) * TSTR + 5 * 64 + c0;
    const LAS float* gb = (const LAS float*)(lds + RW_GB) + (buf * 16 + tk) * 64 + c0;
    f32x4 o[4];
#pragma unroll
    for (int i = 0; i < 4; ++i) {
        const f32x4 lg = *(const LAS f32x4*)(CV + CV_LG * 64 + c0 + 4 * i), lb = *(const LAS f32x4*)(CV + CV_LB * 64 + c0 + 4 * i);
        const f32x4 v = *(const LAS f32x4*)(vb + 4 * i), g = *(const LAS f32x4*)(gb + 4 * i);
        o[i] = ((y[i] * rs) * lg + lb + v * bon) * g;
    }
    GAS bf16_t* op = sq.mix + (size_t)t * 1024 + 512 + 64 * sq.h + c0;
    *(GAS u32x4*)op = pk8(o[0], o[1]); *(GAS u32x4*)(op + 8) = pk8(o[2], o[3]);
}
DI void rwkv_phase(const Params& p, LAS unsigned char* lds, int G) {
    const int tid = threadIdx.x, lane = tid & 63, wid = __builtin_amdgcn_readfirstlane(tid >> 6);
    unsigned char* ws = p.ws;
    for (int it = blockIdx.x; it < 2 * BATCH * 8; it += G) {
        const bool samp = it >= BATCH * 8;
        const int bh = samp ? it - BATCH * 8 : it, b = bh >> 3, h = bh & 7;
        RwSeq sq;
        const int row0 = samp ? MP + b * DEC_SEQ : b * SEQ;
        sq.prw = (const GAS bf16_t*)(ws + WS_PRW) + (size_t)row0 * RW_COLS;
        sq.mix = (GAS bf16_t*)(ws + WS_MIX) + (size_t)row0 * 1024;
        sq.shift0 = samp ? (const GAS float*)p.in[5] + (size_t)b * RW_COLS : nullptr;
        sq.wkv0 = samp ? (const GAS float*)p.in[4] + (size_t)bh * 4096 : nullptr;
        sq.wkv_out = (GAS float*)p.out + (samp ? O_SW : O_PW) + (size_t)bh * 4096;
        sq.ntok = samp ? DEC_SEQ : SEQ; sq.h = h;
        const int NC = sq.ntok / 16;
        __syncthreads();
        { const GAS bf16_t* W2T = (const GAS bf16_t*)(ws + WS_W2T) + (size_t)(64 * h) * 64; const GAS bf16_t* A2T = (const GAS bf16_t*)(ws + WS_A2T) + (size_t)(64 * h) * 64;
          const GAS bf16_t* G2T = (const GAS bf16_t*)(ws + WS_G2T) + (size_t)(64 * h) * 160;
          { const int row = tid >> 3, ch = tid & 7;
            *(LAS u32x4*)(lds + RW_LW2 + row * 144 + ch * 16) = *(const GAS u32x4*)(W2T + row * 64 + ch * 8);
            *(LAS u32x4*)(lds + RW_LA2 + row * 144 + ch * 16) = *(const GAS u32x4*)(A2T + row * 64 + ch * 8); }
          for (int i = tid; i < 64 * 20; i += 512) { const int row = i / 20, ch = i % 20; *(LAS u32x4*)(lds + RW_LG2 + row * 336 + ch * 16) = *(const GAS u32x4*)(G2T + row * 160 + ch * 8); }
          LAS float* CV = (LAS float*)(lds + RW_CV);
          if (tid < 64) {
              const int c = 64 * h + tid;
              CV[CV_W0 * 64 + tid] = ((const GAS float*)p.in[12])[c]; CV[CV_A0 * 64 + tid] = ((const GAS float*)p.in[14])[c];
              CV[CV_KK * 64 + tid] = ((const GAS float*)p.in[17])[c]; CV[CV_KA * 64 + tid] = ((const GAS float*)p.in[18])[c];
              CV[CV_RK * 64 + tid] = ((const GAS float*)p.in[19])[c]; CV[CV_LG * 64 + tid] = ((const GAS float*)p.in[20])[c];
              CV[CV_LB * 64 + tid] = ((const GAS float*)p.in[21])[c];
              const GAS float* mu = (const GAS float*)p.in[11];
              CV[CV_MR * 64 + tid] = mu[c]; CV[CV_MK * 64 + tid] = mu[512 + c]; CV[CV_MV * 64 + tid] = mu[1024 + c];
          }
          if (tid >= 64 && tid < 64 + 288) ((LAS float*)(lds + RW_MUL))[tid - 64] = ((const GAS float*)p.in[11])[1536 + tid - 64];
        }
        __syncthreads();
        if (wid == 4) rwkv_prep(lds, sq, 0, 0, lane);
        const int pp = lane >> 3, o = lane & 7, irow = 16 * wid + 2 * pp;
        float s0[8], s1[8];
#pragma unroll
        for (int j = 0; j < 8; ++j) { s0[j] = 0.f; s1[j] = 0.f; }
        if (wid < 4 && sq.wkv0) {
            const f32x4 a = *(const GAS f32x4*)(sq.wkv0 + irow * 64 + 8 * o), b2 = *(const GAS f32x4*)(sq.wkv0 + irow * 64 + 8 * o + 4);
            const f32x4 c = *(const GAS f32x4*)(sq.wkv0 + (irow + 1) * 64 + 8 * o), d = *(const GAS f32x4*)(sq.wkv0 + (irow + 1) * 64 + 8 * o + 4);
#pragma unroll
            for (int j = 0; j < 4; ++j) { s0[j] = a[j]; s0[4 + j] = b2[j]; s1[j] = c[j]; s1[4 + j] = d[j]; }
        }
        __syncthreads();
        for (int n = 0; n < NC; ++n) {
            const int buf = n & 1;
            if (wid < 4) {
                const LAS float* ob = (const LAS float*)(lds + RW_OPB) + (buf * 16) * TSTR + 8 * o;
                const LAS float* sc = (const LAS float*)(lds + RW_SC) + (buf * 16) * 4;
                LAS float* yb = (LAS float*)(lds + RW_YB) + (buf * 16) * 64 + irow;
#pragma unroll 2
                for (int t = 0; t < 16; ++t) {
                    const LAS float* ot = ob + t * TSTR;
                    float av[8], qv[8], wv[8], bv[8], kv[8];
                    { const f32x4 x0 = *(const LAS f32x4*)(ot), x1 = *(const LAS f32x4*)(ot + 4);
                      const f32x4 y0 = *(const LAS f32x4*)(ot + 64), y1 = *(const LAS f32x4*)(ot + 68);
                      const f32x4 z0 = *(const LAS f32x4*)(ot + 128), z1 = *(const LAS f32x4*)(ot + 132);
                      const f32x4 u0 = *(const LAS f32x4*)(ot + 192), u1 = *(const LAS f32x4*)(ot + 196);
                      const f32x4 v0 = *(const LAS f32x4*)(ot + 256), v1 = *(const LAS f32x4*)(ot + 260);
#pragma unroll
                      for (int j = 0; j < 4; ++j) { av[j] = x0[j]; av[4 + j] = x1[j]; qv[j] = y0[j]; qv[4 + j] = y1[j]; wv[j] = z0[j]; wv[4 + j] = z1[j]; bv[j] = u0[j]; bv[4 + j] = u1[j]; kv[j] = v0[j]; kv[4 + j] = v1[j]; } }
                    const f32x2 vv = *(const LAS f32x2*)(ot - 8 * o + 5 * 64 + irow);
                    const f32x4 bk = *(const LAS f32x4*)(sc + t * 4);
                    float pa0 = 0.f, py0 = 0.f, pa1 = 0.f, py1 = 0.f;
#pragma unroll
                    for (int j = 0; j < 8; ++j) { pa0 += s0[j] * av[j]; py0 += s0[j] * qv[j]; pa1 += s1[j] * av[j]; py1 += s1[j] * qv[j]; }
                    pa0 = oct_sum(pa0) * bk.w; py0 = oct_sum(py0); pa1 = oct_sum(pa1) * bk.w; py1 = oct_sum(py1);
                    const float y0 = py0 + pa0 * bk.x + vv.x * bk.y, y1 = py1 + pa1 * bk.x + vv.y * bk.y;
#pragma unroll
                    for (int j = 0; j < 8; ++j) { s0[j] = s0[j] * wv[j] + (pa0 * bv[j] + vv.x * kv[j]); s1[j] = s1[j] * wv[j] + (pa1 * bv[j] + vv.y * kv[j]); }
                    if (o == 0) *(LAS f32x2*)(yb + t * 64) = (f32x2){y0, y1};
                }
            } else if (wid == 4) {
                if (n >= 1) rwkv_post(lds, sq, n - 1, buf ^ 1, lane);
                if (n + 1 < NC) rwkv_prep(lds, sq, n + 1, buf ^ 1, lane);
            }
            __syncthreads();
        }
        if (wid == 4) rwkv_post(lds, sq, NC - 1, (NC - 1) & 1, lane);
        if (wid < 4) {
            GAS float* w0p = sq.wkv_out + irow * 64 + 8 * o;
            *(GAS f32x4*)w0p = (f32x4){s0[0], s0[1], s0[2], s0[3]}; *(GAS f32x4*)(w0p + 4) = (f32x4){s0[4], s0[5], s0[6], s0[7]};
            *(GAS f32x4*)(w0p + 64) = (f32x4){s1[0], s1[1], s1[2], s1[3]}; *(GAS f32x4*)(w0p + 68) = (f32x4){s1[4], s1[5], s1[6], s1[7]};
        }
    }
    __syncthreads();
}

__global__ void __launch_bounds__(512, 2) fwd_kernel(Params p) {
    extern __shared__ __attribute__((aligned(16))) unsigned char lds_raw[];
    LAS unsigned char* lds = (LAS unsigned char*)lds_raw;
    const int G = gridDim.x;
    unsigned char* ws = p.ws;
    const int lo = p.ph_lo, hi = p.ph_hi;
#define IN(k) (lo <= (k) && (k) < hi)
#define SEAM(k) do { if (IN(k) && IN((k) + 1)) { cg::this_grid().sync(); } } while (0)
    if (IN(0)) { phase0(p, lds, G); }
    SEAM(0);
    if (IN(1)) {
        pg8::Gemm g{(const bf16_t*)(ws + WS_H), (const bf16_t*)(ws + WS_WIN), MT, IN_PAD, 1024}; pg8::StaticOrder S; S.init(MT, IN_PAD, G, (int)blockIdx.x);
        EpiIn E{(GAS bf16_t*)(ws + WS_Q), (GAS bf16_t*)(ws + WS_K), (GAS bf16_t*)(ws + WS_V), (GAS bf16_t*)(ws + WS_PRW), (GAS float*)p.out, (const GAS float*)(ws + WS_ROPE), (const GAS float*)p.in[8], (const GAS float*)p.in[9]};
        pg8::gemm_phase<EpiIn, pg8::StaticOrder>(lds, g, S, E);
    }
    SEAM(1);
    if (IN(2)) { attn_phase(p, lds, G); rwkv_phase(p, lds, G); }
    SEAM(2);
    if (IN(3)) {
        pg8::Gemm g{(const bf16_t*)(ws + WS_MIX), (const bf16_t*)(ws + WS_WOUT), MT, 1024, 1024}; pg8::StaticOrder S; S.init(MT, 1024, G, (int)blockIdx.x);
        EpiOut E{(const GAS float*)p.in[0], (const GAS float*)p.in[1], (GAS float*)p.out, (GAS bf16_t*)(ws + WS_X1B), (GAS float*)(ws + WS_SSQ)};
        pg8::gemm_phase<EpiOut, pg8::StaticOrder>(lds, g, S, E);
    }
    SEAM(3);
    if (IN(4)) {
        pg8::Gemm g{(const bf16_t*)(ws + WS_X1B), (const bf16_t*)(ws + WS_WUP), MT, D_FF, 1024}; pg8::StaticOrder S; S.init(MT, D_FF, G, (int)blockIdx.x);
        EpiUp E{(const GAS float*)(ws + WS_SSQ), (GAS bf16_t*)(ws + WS_U)};
        pg8::gemm_phase<EpiUp, pg8::StaticOrder>(lds, g, S, E);
    }
    SEAM(4);
    if (IN(5)) {
        pg8::Gemm g{(const bf16_t*)(ws + WS_U), (const bf16_t*)(ws + WS_WDN), MT, 1024, D_FF}; pg8::StaticOrder S; S.init(MT, 1024, G, (int)blockIdx.x);
        EpiDown E{(GAS float*)p.out};
        pg8::gemm_phase<EpiDown, pg8::StaticOrder>(lds, g, S, E);
    }
#undef IN
#undef SEAM
}

extern "C" void kernel_launch(void* const* d_in, const int* in_sizes, int n_in, void* d_out, int out_size, void* d_ws, size_t ws_size, hipStream_t stream) {
    static int grid = 0;
    if (grid == 0) {
        if (n_in != 26 || ws_size < WS_END) { fprintf(stderr, "kernel_launch: expected 26 inputs and >= %zu bytes of workspace (got %d, %zu)\n", (size_t)WS_END, n_in, ws_size); grid = -1; return; }
        int dev = 0, cus = 0, per_cu = 0;
        hipGetDevice(&dev);
        hipDeviceGetAttribute(&cus, hipDeviceAttributeMultiprocessorCount, dev);
        if (hipFuncSetAttribute((const void*)fwd_kernel, hipFuncAttributeMaxDynamicSharedMemorySize, LDS_BYTES) != hipSuccess) { fprintf(stderr, "kernel_launch: hipFuncSetAttribute failed\n"); grid = -1; return; }
        if (hipOccupancyMaxActiveBlocksPerMultiprocessor(&per_cu, (const void*)fwd_kernel, 512, LDS_BYTES) != hipSuccess || per_cu < 1) { fprintf(stderr, "kernel_launch: occupancy query failed (%d)\n", per_cu); (void)hipGetLastError(); per_cu = 1; }
        grid = cus * per_cu;
        if (grid > 256) grid = 256;
    }
    if (grid < 0) return;
    Params a{};
    for (int i = 0; i < 26; ++i) a.in[i] = (const float*)d_in[i];
    a.out = (float*)d_out; a.ws = (unsigned char*)d_ws;
#if MK_N_LAUNCHES == 1
    a.ph_lo = 0; a.ph_hi = 6;
    void* args[] = {&a};
    hipError_t e = hipLaunchCooperativeKernel((const void*)fwd_kernel, dim3(grid), dim3(512), args, LDS_BYTES, stream);
    if (e != hipSuccess) fprintf(stderr, "cooperative launch failed: %s (grid %d)\n", hipGetErrorString(e), grid);
#else
    for (int ph = 0; ph < 6; ++ph) {
        a.ph_lo = ph; a.ph_hi = ph + 1;
        hipLaunchKernelGGL(fwd_kernel, dim3(grid), dim3(512), LDS_BYTES, stream, a);
    }
#endif
}
```

```cpp
#include <hip/hip_runtime.h>
#include <hip/hip_cooperative_groups.h>
#include <cstdio>
#include <cstdint>
namespace cg = cooperative_groups;

#ifndef MK_N_LAUNCHES
#define MK_N_LAUNCHES 1
#endif

#define GAS __attribute__((address_space(1)))
#define LAS __attribute__((address_space(3)))
typedef unsigned short bf16_t;
typedef short bf16x8 __attribute__((ext_vector_type(8)));
typedef short s16x4 __attribute__((ext_vector_type(4)));
typedef float f32x2 __attribute__((ext_vector_type(2)));
typedef float f32x4 __attribute__((ext_vector_type(4)));
typedef float f32x16 __attribute__((ext_vector_type(16)));
typedef unsigned u32x2 __attribute__((ext_vector_type(2)));
typedef unsigned u32x4 __attribute__((ext_vector_type(4)));
typedef __bf16 bf16v2 __attribute__((ext_vector_type(2)));
#define DI __device__ __forceinline__

constexpr int D_MODEL = 1024, SEQ = 2048, BATCH = 32, DEC_SEQ = 16;
constexpr int MP = BATCH * SEQ;
constexpr int MS = BATCH * DEC_SEQ;
constexpr int MT = MP + MS;
constexpr int IN_COLS = 2592, IN_PAD = 2816;
constexpr int RW_COLS = 1824, D_FF = 4096;
constexpr int NPOS = SEQ + DEC_SEQ;

constexpr size_t O_PK = 67633152, O_PV = 68157440, O_PW = 68681728, O_PS = 69730304, O_SK = 69788672, O_SV = 69854208, O_SW = 69919744, O_SS = 70968320;

constexpr size_t al256(size_t x) { return (x + 255) & ~(size_t)255; }
constexpr size_t WS_WIN = 0;
constexpr size_t WS_WOUT = WS_WIN + (size_t)IN_PAD * 1024 * 2;
constexpr size_t WS_WUP = WS_WOUT + (size_t)1024 * 1024 * 2;
constexpr size_t WS_WDN = WS_WUP + (size_t)4096 * 1024 * 2;
constexpr size_t WS_W2T = WS_WDN + (size_t)4096 * 1024 * 2;
constexpr size_t WS_A2T = WS_W2T + 512 * 64 * 2;
constexpr size_t WS_G2T = WS_A2T + 512 * 64 * 2;
constexpr size_t WS_ROPE = al256(WS_G2T + 512 * 160 * 2);
constexpr size_t WS_SSQ = al256(WS_ROPE + (size_t)NPOS * 64 * 4);
constexpr size_t WS_X1B = al256(WS_SSQ + (size_t)MT * 16 * 4);
constexpr size_t WS_H = al256(WS_X1B + (size_t)MT * 1024 * 2);
constexpr size_t WS_Q = WS_H + (size_t)MT * 1024 * 2;
constexpr size_t WS_K = WS_Q + (size_t)MT * 512 * 2;
constexpr size_t WS_V = WS_K + (size_t)MT * 128 * 2;
constexpr size_t WS_PRW = WS_V + (size_t)MT * 128 * 2;
constexpr size_t WS_MIX = WS_PRW + (size_t)MT * RW_COLS * 2;
constexpr size_t WS_AEND = WS_MIX + (size_t)MT * 1024 * 2;
constexpr size_t WS_U = WS_H;
static_assert(WS_U + (size_t)MT * 4096 * 2 <= WS_AEND, "U overlay");
constexpr size_t WS_CTL = al256(WS_AEND);
constexpr size_t CTL_BYTES = 16384;
constexpr size_t WS_END = WS_CTL + CTL_BYTES;
static_assert(WS_END <= (size_t)1 << 30, "workspace");

constexpr int LDS_BYTES = 163840;

DI unsigned pk2(float lo, float hi) { f32x2 v = {lo, hi}; return __builtin_bit_cast(unsigned, __builtin_convertvector(v, bf16v2)); }
DI float bf2f(unsigned short b) { return __builtin_bit_cast(float, (unsigned)b << 16); }
DI float bflo(unsigned w) { return __builtin_bit_cast(float, w << 16); }
DI float bfhi(unsigned w) { return __builtin_bit_cast(float, w & 0xffff0000u); }
DI u32x4 pk8(f32x4 a, f32x4 b) { u32x4 w; w.x = pk2(a[0], a[1]); w.y = pk2(a[2], a[3]); w.z = pk2(b[0], b[1]); w.w = pk2(b[2], b[3]); return w; }
DI float wave_sum(float v) {
#pragma unroll
    for (int o = 1; o < 64; o <<= 1) v += __shfl_xor(v, o);
    return v;
}
template <int CTRL> DI float dpp_f(float x) { return __builtin_bit_cast(float, __builtin_amdgcn_mov_dpp(__builtin_bit_cast(int, x), CTRL, 0xf, 0xf, true)); }
DI float quad_sum(float x) { x += dpp_f<0xB1>(x); x += dpp_f<0x4E>(x); return x; }
DI float oct_sum(float x) { x = quad_sum(x); x += dpp_f<0x141>(x); return x; }
#define LDS_WAIT() asm volatile("s_waitcnt lgkmcnt(0)" ::: "memory")

namespace pg8 {
constexpr int BM = 256, BK = 64, HALF = 128, HTB = HALF * BK * 2, STAGE_BYTES = 8 * HTB, NXCD = 8, WGM = 8;
__host__ __device__ __forceinline__ int lds_byte(int r, int c) { const int st = (r >> 4) * 2 + (c >> 5), rr = r & 15, cc = c & 31, ob = rr * 64 + cc * 2; return st * 1024 + (ob ^ (((ob >> 9) & 1) << 5)); }
__host__ __device__ __forceinline__ void stage_rc(int b, int& R, int& C) { const int st = b / 1024, sb = b % 1024, swz = sb ^ (((sb >> 9) & 1) << 5); R = (st >> 1) * 16 + swz / 64; C = (st & 1) * 32 + (swz % 64) / 2; }
struct Unit { int pm, pn; };
struct Gemm { const bf16_t* A; const bf16_t* Bt; int M, N, K; };
struct StaticOrder {
    int nM, nN, nwg, G, c;
    __host__ __device__ void init(int M, int N, int G_, int c_) { nM = M / BM; nN = N / BM; nwg = nM * nN; G = G_; c = c_; }
    __host__ __device__ bool next(int i, Unit& u) const {
        const long L = (long)i * G + c; if (L >= nwg) return false;
        int wgid = (int)L; { const int q = nwg / NXCD, r = nwg % NXCD, xcd = wgid % NXCD, off = wgid / NXCD; wgid = (xcd < r ? xcd * (q + 1) : r * (q + 1) + (xcd - r) * q) + off; }
        const int nig = WGM * nN, gid = wgid / nig, fm = gid * WGM, gsz = (nM - fm) < WGM ? (nM - fm) : WGM;
        u.pm = fm + ((wgid % nig) % gsz); u.pn = (wgid % nig) / gsz; return true;
    }
};
template <class Epi, class Sched, bool ALIGN_EPI = true, bool SP2 = true>
__device__ __forceinline__ void gemm_phase(LAS unsigned char* lds, const Gemm g, const Sched& S, const Epi& E) {
    const int tid = threadIdx.x, wid = __builtin_amdgcn_readfirstlane(tid >> 6), lane = tid & 63, wr = wid >> 2, wc = wid & 3, fr = lane & 15, fq = lane >> 4;
    const int K = g.K, nt = K / BK;
    unsigned voffA[2];
#pragma unroll
    for (int i = 0; i < 2; ++i) { int R, C; stage_rc(tid * 16 + i * 8192, R, C); voffA[i] = (unsigned)(R * K + C) * 2u; }
    const size_t kstep = (size_t)(BK * 2);
    const size_t hstep = (size_t)HALF * K * 2;
    const size_t tstep = 2 * hstep;
    const unsigned ldsw = (unsigned)wid * 1024u;
    const int aoff = lds_byte(wr * 64 + fr, fq * 8), boff = lds_byte(wc * 32 + fr, fq * 8);
#define PG8_SA(b, h) (((b) * 2 + (h)) * HTB)
#define PG8_SB(b, h) ((4 + (b) * 2 + (h)) * HTB)
#define PG8_STAGE(bufoff, gbase, voff) do { _Pragma("unroll") for (int _i = 0; _i < 2; ++_i) \
        __builtin_amdgcn_global_load_lds((const unsigned*)((const char*)(gbase) + (voff)[_i]), (LAS unsigned*)(lds + (bufoff) + ldsw + _i * 8192), 16, 0, 0); } while (0)
#define PG8_LDA(dst, b, h) do { _Pragma("unroll") for (int m = 0; m < 4; ++m) _Pragma("unroll") for (int k = 0; k < 2; ++k) dst[m][k] = *(const LAS bf16x8*)(lds + PG8_SA(b, h) + aoff + m * 2048 + k * 1024); } while (0)
#define PG8_LDB(dst, b, h) do { _Pragma("unroll") for (int n = 0; n < 2; ++n) _Pragma("unroll") for (int k = 0; k < 2; ++k) dst[n][k] = *(const LAS bf16x8*)(lds + PG8_SB(b, h) + boff + n * 2048 + k * 1024); } while (0)
#define PG8_MMA(ai, bj, At, Bt) do { __builtin_amdgcn_s_setprio(1); _Pragma("unroll") for (int m = 0; m < 4; ++m) _Pragma("unroll") for (int n = 0; n < 2; ++n) _Pragma("unroll") for (int k = 0; k < 2; ++k) \
        acc[ai][bj][m][n] = __builtin_amdgcn_mfma_f32_16x16x32_bf16(Bt[n][k], At[m][k], acc[ai][bj][m][n], 0, 0, 0); __builtin_amdgcn_s_setprio(0); } while (0)
#define PG8_WAIT_V(n) asm volatile("s_waitcnt vmcnt(" #n ")" ::: "memory")
#define PG8_WAIT_L(n) asm volatile("s_waitcnt lgkmcnt(" #n ")" ::: "memory")
#define PG8_BAR __builtin_amdgcn_s_barrier()
#define PG8_SCHED __builtin_amdgcn_sched_barrier(0)
    Unit cur, nxt; int ui = 0;
    if (!S.next(0, cur)) return;
    f32x4 acc[2][2][4][2];
#pragma unroll
    for (int a = 0; a < 2; ++a)
#pragma unroll
        for (int b = 0; b < 2; ++b)
#pragma unroll
            for (int m = 0; m < 4; ++m)
#pragma unroll
                for (int n = 0; n < 2; ++n) acc[a][b][m][n] = (f32x4){0.f, 0.f, 0.f, 0.f};
    bf16x8 At[4][2], B0[2][2], B1[2][2];
    const char* cA = (const char*)g.A + (size_t)cur.pm * tstep; const char* cB = (const char*)g.Bt + (size_t)cur.pn * tstep;
    if constexpr (SP2) {
        PG8_STAGE(PG8_SB(0, 0), cB, voffA); PG8_STAGE(PG8_SB(0, 1), cB + hstep, voffA); PG8_STAGE(PG8_SA(0, 0), cA, voffA); PG8_STAGE(PG8_SA(0, 1), cA + hstep, voffA);
        if (wr == 1) PG8_BAR;
        PG8_WAIT_V(2); PG8_BAR;
        PG8_STAGE(PG8_SB(1, 0), cB + kstep, voffA); PG8_STAGE(PG8_SA(1, 0), cA + kstep, voffA); PG8_STAGE(PG8_SB(1, 1), cB + hstep + kstep, voffA);
        PG8_WAIT_V(6); PG8_BAR;
    } else {
        PG8_STAGE(PG8_SB(0, 0), cB, voffA); PG8_STAGE(PG8_SA(0, 0), cA, voffA); PG8_STAGE(PG8_SB(0, 1), cB + hstep, voffA); PG8_STAGE(PG8_SA(0, 1), cA + hstep, voffA);
        if (wr == 1) PG8_BAR;
        PG8_WAIT_V(4); PG8_BAR;
        PG8_STAGE(PG8_SB(1, 0), cB + kstep, voffA); PG8_STAGE(PG8_SA(1, 0), cA + kstep, voffA); PG8_STAGE(PG8_SB(1, 1), cB + hstep + kstep, voffA);
        PG8_WAIT_V(6); PG8_BAR;
    }
    for (;;) {
        const bool has_next = S.next(ui + 1, nxt);
        const char* nA = has_next ? (const char*)g.A + (size_t)nxt.pm * tstep : cA; const char* nB = has_next ? (const char*)g.Bt + (size_t)nxt.pn * tstep : cB;
        for (int t = 0; t < nt; t += 2) {
            const bool last = (t == nt - 2);
            const char* a1 = cA + (size_t)(t + 1) * kstep;
            const char* a2 = last ? nA : cA + (size_t)(t + 2) * kstep; const char* b2 = last ? nB : cB + (size_t)(t + 2) * kstep;
            const char* a3 = a2 + kstep; const char* b3 = b2 + kstep;
            if constexpr (SP2) {
            PG8_LDB(B0, 0, 0); PG8_LDB(B1, 0, 1); PG8_SCHED; PG8_LDA(At, 0, 0); PG8_STAGE(PG8_SA(1, 1), a1 + hstep, voffA);
            PG8_WAIT_V(8); PG8_WAIT_L(0); PG8_BAR; PG8_MMA(0, 0, At, B0); PG8_MMA(0, 1, At, B1); PG8_BAR; PG8_SCHED;
            PG8_LDA(At, 0, 1); PG8_STAGE(PG8_SB(0, 0), b2, voffA); PG8_STAGE(PG8_SB(0, 1), b2 + hstep, voffA); PG8_STAGE(PG8_SA(0, 0), a2, voffA);
            PG8_WAIT_V(8); PG8_WAIT_L(0); PG8_BAR; PG8_MMA(1, 0, At, B0); PG8_MMA(1, 1, At, B1); PG8_BAR; PG8_SCHED;
            PG8_LDB(B0, 1, 0); PG8_LDB(B1, 1, 1); PG8_SCHED; PG8_LDA(At, 1, 0); PG8_STAGE(PG8_SA(0, 1), a2 + hstep, voffA);
            PG8_WAIT_V(8); PG8_WAIT_L(0); PG8_BAR; PG8_MMA(0, 0, At, B0); PG8_MMA(0, 1, At, B1); PG8_BAR; PG8_SCHED;
            PG8_LDA(At, 1, 1); PG8_STAGE(PG8_SB(1, 0), b3, voffA); PG8_STAGE(PG8_SB(1, 1), b3 + hstep, voffA); PG8_STAGE(PG8_SA(1, 0), a3, voffA);
            PG8_WAIT_V(8); PG8_WAIT_L(0); PG8_BAR; PG8_MMA(1, 0, At, B0); PG8_MMA(1, 1, At, B1); PG8_BAR; PG8_SCHED;
            } else {
            PG8_LDB(B0, 0, 0); PG8_SCHED; PG8_LDA(At, 0, 0); PG8_STAGE(PG8_SA(1, 1), a1 + hstep, voffA);
            PG8_WAIT_L(8); PG8_BAR; PG8_WAIT_L(0); PG8_MMA(0, 0, At, B0); PG8_BAR; PG8_SCHED;
            PG8_LDB(B1, 0, 1); PG8_STAGE(PG8_SB(0, 0), b2, voffA);
            PG8_BAR; PG8_WAIT_L(0); PG8_MMA(0, 1, At, B1); PG8_BAR;
            PG8_LDA(At, 0, 1); PG8_STAGE(PG8_SA(0, 0), a2, voffA);
            PG8_BAR; PG8_WAIT_L(0); PG8_MMA(1, 0, At, B0); PG8_BAR; PG8_SCHED;
            PG8_STAGE(PG8_SB(0, 1), b2 + hstep, voffA);
            PG8_WAIT_V(6); PG8_BAR; PG8_MMA(1, 1, At, B1); PG8_BAR;
            PG8_LDB(B0, 1, 0); PG8_SCHED; PG8_LDA(At, 1, 0); PG8_STAGE(PG8_SA(0, 1), a2 + hstep, voffA);
            PG8_WAIT_L(8); PG8_BAR; PG8_WAIT_L(0); PG8_MMA(0, 0, At, B0); PG8_BAR; PG8_SCHED;
            PG8_LDB(B1, 1, 1); PG8_STAGE(PG8_SB(1, 0), b3, voffA);
            PG8_BAR; PG8_WAIT_L(0); PG8_MMA(0, 1, At, B1); PG8_BAR;
            PG8_LDA(At, 1, 1); PG8_STAGE(PG8_SA(1, 0), a3, voffA);
            PG8_BAR; PG8_WAIT_L(0); PG8_MMA(1, 0, At, B0); PG8_BAR; PG8_SCHED;
            PG8_STAGE(PG8_SB(1, 1), b3 + hstep, voffA);
            PG8_WAIT_V(6); PG8_BAR; PG8_MMA(1, 1, At, B1); PG8_BAR;
            }
        }
        if constexpr (ALIGN_EPI) { if (wr == 0) PG8_BAR; }
        E(acc, cur, wr, wc, fr, fq);
        if (!has_next) break;
#pragma unroll
        for (int a = 0; a < 2; ++a)
#pragma unroll
            for (int b = 0; b < 2; ++b)
#pragma unroll
                for (int m = 0; m < 4; ++m)
#pragma unroll
                    for (int n = 0; n < 2; ++n) acc[a][b][m][n] = (f32x4){0.f, 0.f, 0.f, 0.f};
        cur = nxt; cA = nA; cB = nB; ++ui;
        if constexpr (ALIGN_EPI) { if (wr == 1) PG8_BAR; }
    }
    PG8_WAIT_V(0);
    if constexpr (!ALIGN_EPI) { if (wr == 0) PG8_BAR; }
    PG8_BAR;
#undef PG8_SA
#undef PG8_SB
#undef PG8_STAGE
#undef PG8_LDA
#undef PG8_LDB
#undef PG8_MMA
#undef PG8_WAIT_V
#undef PG8_WAIT_L
#undef PG8_BAR
#undef PG8_SCHED
}
}

enum { MAP_NAT = 0, MAP_A = 1, MAP_B = 2 };
DI int rowmap(int mode, int c) {
    if (mode == MAP_NAT) return c;
    if (mode == MAP_A) { const int rem = c & 31; return (c & ~31) + 16 * ((rem >> 2) & 1) + 4 * (rem >> 3) + (rem & 3); }
    const int rem = c & 255; return (c & ~255) + 128 * ((rem >> 5) & 1) + 32 * (rem >> 6) + 16 * ((rem >> 2) & 1) + 4 * ((rem >> 3) & 3) + (rem & 3);
}

struct EpiIn {
    GAS bf16_t* Q; GAS bf16_t* Kb; GAS bf16_t* Vb; GAS bf16_t* PRW; GAS float* out; const GAS float* rope; const GAS float* qg; const GAS float* kg;
    DI void operator()(const f32x4 (&acc)[2][2][4][2], const pg8::Unit& u, int wr, int wc, int fr, int fq) const {
        const int H = u.pn * 4 + wc;
        const int row0 = u.pm * 256 + wr * 64 + fr;
        if (H < 10) {
            const bool isq = H < 8;
            const GAS float* g = isq ? qg : kg;
            f32x4 gv[2][2];
#pragma unroll
            for (int bj = 0; bj < 2; ++bj)
#pragma unroll
                for (int n = 0; n < 2; ++n) gv[bj][n] = *(const GAS f32x4*)(g + 32 * bj + 8 * fq + 4 * n);
#pragma unroll
            for (int ai = 0; ai < 2; ++ai)
#pragma unroll
                for (int m = 0; m < 4; ++m) {
                    const int row = row0 + ai * 128 + m * 16;
                    float ss = 0.f;
#pragma unroll
                    for (int bj = 0; bj < 2; ++bj)
#pragma unroll
                        for (int n = 0; n < 2; ++n) { const f32x4 x = acc[ai][bj][m][n]; ss += (x[0] * x[0] + x[1] * x[1]) + (x[2] * x[2] + x[3] * x[3]); }
                    ss += __shfl_xor(ss, 16); ss += __shfl_xor(ss, 32);
                    float rinv = __builtin_amdgcn_rsqf(ss * (1.f / 64.f) + 1e-6f);
                    if (isq) rinv *= 0.125f;
                    const bool samp = row >= MP;
                    const int rs = row - MP;
                    const int b = samp ? (rs >> 4) : (row >> 11), t = samp ? (rs & 15) : (row & 2047);
                    const int pi = samp ? (SEQ + t) : t;
                    const GAS float* rp = rope + (size_t)pi * 64 + 8 * fq;
                    f32x4 o1[2], o2[2];
#pragma unroll
                    for (int n = 0; n < 2; ++n) {
                        const f32x4 c4 = *(const GAS f32x4*)(rp + 4 * n), s4 = *(const GAS f32x4*)(rp + 32 + 4 * n);
                        const f32x4 x1 = acc[ai][0][m][n] * rinv * gv[0][n], x2 = acc[ai][1][m][n] * rinv * gv[1][n];
                        o1[n] = x1 * c4 - x2 * s4; o2[n] = x2 * c4 + x1 * s4;
                    }
                    if (isq) {
                        GAS bf16_t* qp = Q + (size_t)row * 512 + 64 * H + 8 * fq;
                        *(GAS u32x4*)qp = pk8(o1[0], o1[1]); *(GAS u32x4*)(qp + 32) = pk8(o2[0], o2[1]);
                    } else {
                        const int kvh = H - 8;
                        GAS bf16_t* kp = Kb + (size_t)row * 128 + 64 * kvh + 8 * fq;
                        *(GAS u32x4*)kp = pk8(o1[0], o1[1]); *(GAS u32x4*)(kp + 32) = pk8(o2[0], o2[1]);
                        if (samp || t >= SEQ - 128) {
                            GAS float* op = samp ? out + O_SK + ((size_t)(b * 16 + t) * 2 + kvh) * 64 + 8 * fq : out + O_PK + ((size_t)(b * 128 + (t - (SEQ - 128))) * 2 + kvh) * 64 + 8 * fq;
                            *(GAS f32x4*)op = o1[0]; *(GAS f32x4*)(op + 4) = o1[1]; *(GAS f32x4*)(op + 32) = o2[0]; *(GAS f32x4*)(op + 36) = o2[1];
                        }
                    }
                }
        } else if (H < 12) {
            const int kvh = H - 10;
#pragma unroll
            for (int ai = 0; ai < 2; ++ai)
#pragma unroll
                for (int m = 0; m < 4; ++m) {
                    const int row = row0 + ai * 128 + m * 16;
                    const bool samp = row >= MP;
                    const int rs = row - MP;
                    const int b = samp ? (rs >> 4) : (row >> 11), t = samp ? (rs & 15) : (row & 2047);
                    GAS bf16_t* vp = Vb + (size_t)row * 128 + 64 * kvh + 8 * fq;
                    *(GAS u32x4*)vp = pk8(acc[ai][0][m][0], acc[ai][0][m][1]); *(GAS u32x4*)(vp + 32) = pk8(acc[ai][1][m][0], acc[ai][1][m][1]);
                    if (samp || t >= SEQ - 128) {
                        GAS float* op = samp ? out + O_SV + ((size_t)(b * 16 + t) * 2 + kvh) * 64 + 8 * fq : out + O_PV + ((size_t)(b * 128 + (t - (SEQ - 128))) * 2 + kvh) * 64 + 8 * fq;
                        *(GAS f32x4*)op = acc[ai][0][m][0]; *(GAS f32x4*)(op + 4) = acc[ai][0][m][1]; *(GAS f32x4*)(op + 32) = acc[ai][1][m][0]; *(GAS f32x4*)(op + 36) = acc[ai][1][m][1];
                    }
                }
        } else {
            const int cr0 = (H - 12) * 64 + 8 * fq;
#pragma unroll
            for (int ai = 0; ai < 2; ++ai)
#pragma unroll
                for (int m = 0; m < 4; ++m) {
                    const int row = row0 + ai * 128 + m * 16;
                    const bool samp = row >= MP;
                    const int rs = row - MP;
                    const int b = samp ? (rs >> 4) : (row >> 11), t = samp ? (rs & 15) : (row & 2047);
                    const bool lastrow = samp ? (t == DEC_SEQ - 1) : (t == SEQ - 1);
#pragma unroll
                    for (int bj = 0; bj < 2; ++bj) {
                        const int cr = cr0 + 32 * bj;
                        if (cr < RW_COLS) {
                            *(GAS u32x4*)(PRW + (size_t)row * RW_COLS + cr) = pk8(acc[ai][bj][m][0], acc[ai][bj][m][1]);
                            if (lastrow) { GAS float* op = out + (samp ? O_SS : O_PS) + (size_t)b * RW_COLS + cr; *(GAS f32x4*)op = acc[ai][bj][m][0]; *(GAS f32x4*)(op + 4) = acc[ai][bj][m][1]; }
                        }
                    }
                }
        }
    }
};
struct EpiOut {
    const GAS float* xp; const GAS float* xs; GAS float* out; GAS bf16_t* X1B; GAS float* SSQ;
    DI void operator()(const f32x4 (&acc)[2][2][4][2], const pg8::Unit& u, int wr, int wc, int fr, int fq) const {
        const int row0 = u.pm * 256 + wr * 64 + fr, col0 = u.pn * 256 + wc * 32 + 4 * fq;
        const GAS float* xin = (u.pm < 256) ? xp : xs - (size_t)MP * 1024;
#pragma unroll
        for (int ai = 0; ai < 2; ++ai)
#pragma unroll
            for (int m = 0; m < 4; ++m) {
                const int row = row0 + ai * 128 + m * 16; const size_t off = (size_t)row * 1024 + col0;
                float ss = 0.f;
#pragma unroll
                for (int bj = 0; bj < 2; ++bj)
#pragma unroll
                    for (int n = 0; n < 2; ++n) {
                        const f32x4 o = *(const GAS f32x4*)(xin + off + bj * 128 + n * 16) + acc[ai][bj][m][n];
                        *(GAS f32x4*)(out + off + bj * 128 + n * 16) = o;
                        u32x2 w; w.x = pk2(o[0], o[1]); w.y = pk2(o[2], o[3]);
                        *(GAS u32x2*)(X1B + off + bj * 128 + n * 16) = w;
                        ss += (o[0] * o[0] + o[1] * o[1]) + (o[2] * o[2] + o[3] * o[3]);
                    }
                ss += __shfl_xor(ss, 16); ss += __shfl_xor(ss, 32);
                if (fq == 0) SSQ[(size_t)row * 16 + u.pn * 4 + wc] = ss;
            }
    }
};
struct EpiUp {
    const GAS float* SSQ; GAS bf16_t* U;
    DI void operator()(const f32x4 (&acc)[2][2][4][2], const pg8::Unit& u, int wr, int wc, int fr, int fq) const {
        const int row0 = u.pm * 256 + wr * 64 + fr, col0 = u.pn * 256 + wc * 32 + 8 * fq;
#pragma unroll
        for (int ai = 0; ai < 2; ++ai)
#pragma unroll
            for (int m = 0; m < 4; ++m) {
                const int row = row0 + ai * 128 + m * 16;
                const GAS f32x4* sp = (const GAS f32x4*)(SSQ + (size_t)row * 16);
                const f32x4 a = sp[0], b = sp[1], c = sp[2], d = sp[3];
                const f32x4 t4 = (a + b) + (c + d);
                const float tot = (t4[0] + t4[1]) + (t4[2] + t4[3]);
                const float s2 = 1.0f / (tot * (1.f / 1024.f) + 1e-6f);
#pragma unroll
                for (int bj = 0; bj < 2; ++bj) {
                    f32x4 v0 = acc[ai][bj][m][0], v1 = acc[ai][bj][m][1];
#pragma unroll
                    for (int j = 0; j < 4; ++j) { const float r0 = fmaxf(v0[j], 0.f), r1 = fmaxf(v1[j], 0.f); v0[j] = r0 * r0 * s2; v1[j] = r1 * r1 * s2; }
                    *(GAS u32x4*)(U + (size_t)row * D_FF + col0 + bj * 128) = pk8(v0, v1);
                }
            }
    }
};
struct EpiDown {
    GAS float* out;
    DI void operator()(const f32x4 (&acc)[2][2][4][2], const pg8::Unit& u, int wr, int wc, int fr, int fq) const {
        const int row0 = u.pm * 256 + wr * 64 + fr, col0 = u.pn * 256 + wc * 32 + 4 * fq;
#pragma unroll
        for (int ai = 0; ai < 2; ++ai)
#pragma unroll
            for (int m = 0; m < 4; ++m) {
                const size_t off = (size_t)(row0 + ai * 128 + m * 16) * 1024 + col0;
#pragma unroll
                for (int bj = 0; bj < 2; ++bj)
#pragma unroll
                    for (int n = 0; n < 2; ++n) { GAS float* p = out + off + bj * 128 + n * 16; *(GAS f32x4*)p = *(const GAS f32x4*)p + acc[ai][bj][m][n]; }
            }
    }
};

DI void p0_transpose_item(const GAS float* W, int K, int N, GAS bf16_t* WT, int mode, const GAS float* kscale, LAS float* scr, int item, int lane) {
    const int nblk = N / 32, kb = item / nblk, nb = item % nblk, k0 = 64 * kb, n0 = 32 * nb;
#pragma unroll 8
    for (int i = 0; i < 32; ++i) { const int kk = 2 * i + (lane >> 5); float v = W[(size_t)(k0 + kk) * N + n0 + (lane & 31)]; if (kscale) v *= kscale[k0 + kk]; scr[kk * 33 + (lane & 31)] = v; }
    LDS_WAIT();
    const int c = lane & 7;
#pragma unroll
    for (int j = 0; j < 4; ++j) { const int n = (lane >> 3) + 8 * j; const LAS float* s = scr + (8 * c) * 33 + n;
        u32x4 o; o.x = pk2(s[0 * 33], s[1 * 33]); o.y = pk2(s[2 * 33], s[3 * 33]); o.z = pk2(s[4 * 33], s[5 * 33]); o.w = pk2(s[6 * 33], s[7 * 33]);
        *(GAS u32x4*)(WT + (size_t)rowmap(mode, n0 + n) * K + k0 + 8 * c) = o; }
    LDS_WAIT();
}
DI void sincos_d(double x, double& s, double& c) {
    const double TWO_PI = 6.283185307179586476925287;
    const double n = __builtin_rint(x * (1.0 / TWO_PI));
    const double r = x - n * TWO_PI, r2 = r * r;
    double ps = 1.0, pc = 1.0;
#pragma unroll
    for (int k = 14; k >= 1; --k) { ps = 1.0 - ps * r2 / (double)((2 * k) * (2 * k + 1)); pc = 1.0 - pc * r2 / (double)((2 * k - 1) * (2 * k)); }
    s = r * ps; c = pc;
}

struct Params { const float* in[26]; float* out; unsigned char* ws; int ph_lo, ph_hi; };

DI void phase0(const Params& p, LAS unsigned char* lds, int G) {
    const int tid = threadIdx.x, lane = tid & 63, wave = tid >> 6;
    const int gw = blockIdx.x * 8 + wave, NGW = G * 8;
    LAS float* scr = (LAS float*)(lds + wave * 8704);
    unsigned char* ws = p.ws;
    const GAS float* w_in = (const GAS float*)p.in[7]; const GAS float* w_out = (const GAS float*)p.in[22]; const GAS float* w_up = (const GAS float*)p.in[24]; const GAS float* w_dn = (const GAS float*)p.in[25];
    const GAS float* ln2 = (const GAS float*)p.in[23];
    constexpr int I_IN = 16 * (IN_COLS / 32), I_OUT = 16 * 32, I_UP = 16 * 128, I_DN = 64 * 32, NITEMS = I_IN + I_OUT + I_UP + I_DN;
    for (int it = gw; it < NITEMS; it += NGW) {
        int r = it;
        if (r < I_IN) { p0_transpose_item(w_in, 1024, IN_COLS, (GAS bf16_t*)(ws + WS_WIN), MAP_B, nullptr, scr, r, lane); continue; } r -= I_IN;
        if (r < I_OUT) { p0_transpose_item(w_out, 1024, 1024, (GAS bf16_t*)(ws + WS_WOUT), MAP_NAT, nullptr, scr, r, lane); continue; } r -= I_OUT;
        if (r < I_UP) { p0_transpose_item(w_up, 1024, 4096, (GAS bf16_t*)(ws + WS_WUP), MAP_A, ln2, scr, r, lane); continue; } r -= I_UP;
        p0_transpose_item(w_dn, 4096, 1024, (GAS bf16_t*)(ws + WS_WDN), MAP_NAT, nullptr, scr, r, lane);
    }
    const int gt = blockIdx.x * 512 + tid, NGT = G * 512;
    for (int i = gt; i < (IN_PAD - IN_COLS) * 128; i += NGT) { const int c = IN_COLS + i / 128; *(GAS u32x4*)((GAS bf16_t*)(ws + WS_WIN) + (size_t)rowmap(MAP_B, c) * 1024 + (i % 128) * 8) = (u32x4){0u, 0u, 0u, 0u}; }
    { const GAS float* w2 = (const GAS float*)p.in[13]; const GAS float* a2 = (const GAS float*)p.in[15]; const GAS float* g2 = (const GAS float*)p.in[16];
      GAS bf16_t* W2T = (GAS bf16_t*)(ws + WS_W2T); GAS bf16_t* A2T = (GAS bf16_t*)(ws + WS_A2T); GAS bf16_t* G2T = (GAS bf16_t*)(ws + WS_G2T);
      for (int i = gt; i < 512 * 32; i += NGT) { const int n = i >> 5, k2 = (i & 31) * 2;
          *(GAS unsigned*)(W2T + n * 64 + k2) = pk2(w2[k2 * 512 + n], w2[(k2 + 1) * 512 + n]);
          *(GAS unsigned*)(A2T + n * 64 + k2) = pk2(a2[k2 * 512 + n], a2[(k2 + 1) * 512 + n]); }
      for (int i = gt; i < 512 * 80; i += NGT) { const int n = i / 80, k2 = (i % 80) * 2; *(GAS unsigned*)(G2T + n * 160 + k2) = pk2(g2[k2 * 512 + n], g2[(k2 + 1) * 512 + n]); } }
    { GAS float* rope = (GAS float*)(ws + WS_ROPE);
      for (int i = gt; i < NPOS * 32; i += NGT) { const int pi = i >> 5, f = i & 31; const int pos = pi < SEQ ? pi : 4096 + (pi - SEQ);
          const float inv = (float)exp(-(double)f * (9.210340371976182736 / 32.0));
          const float ang = (float)pos * inv;
          double s, c; sincos_d((double)ang, s, c);
          rope[(size_t)pi * 64 + f] = (float)c; rope[(size_t)pi * 64 + 32 + f] = (float)s; } }
    { const GAS float* g1 = (const GAS float*)p.in[6]; GAS bf16_t* Hh = (GAS bf16_t*)(ws + WS_H);
      f32x4 gv[4];
#pragma unroll
      for (int j = 0; j < 4; ++j) gv[j] = *((const GAS f32x4*)g1 + lane + 64 * j);
      for (int m = gw; m < MT; m += NGW) {
          const GAS float* xrow = (m < MP) ? (const GAS float*)p.in[0] + (size_t)m * 1024 : (const GAS float*)p.in[1] + (size_t)(m - MP) * 1024;
          const GAS f32x4* xr = (const GAS f32x4*)xrow + lane;
          f32x4 v[4]; float s = 0.f;
#pragma unroll
          for (int j = 0; j < 4; ++j) { v[j] = xr[64 * j]; s += (v[j][0] * v[j][0] + v[j][1] * v[j][1]) + (v[j][2] * v[j][2] + v[j][3] * v[j][3]); }
          const float rinv = __builtin_amdgcn_rsqf(wave_sum(s) * (1.f / 1024.f) + 1e-6f);
          GAS u32x2* o8 = (GAS u32x2*)(Hh + (size_t)m * 1024) + lane;
#pragma unroll
          for (int j = 0; j < 4; ++j) { const f32x4 y = v[j] * rinv * gv[j]; u32x2 w; w.x = pk2(y[0], y[1]); w.y = pk2(y[2], y[3]); o8[64 * j] = w; }
      } }
}

constexpr int KS_STRIDE = 144;
constexpr int VT_STRIDE = 392;
constexpr int VT_OFF = 192 * KS_STRIDE;
#define MFMA32(a, b, c) __builtin_amdgcn_mfma_f32_32x32x16_bf16((a), (b), (c), 0, 0, 0)

DI void attn_store_kv(LAS unsigned char* lds, int row, int ch, u32x4 kv, u32x4 vv) {
    *(LAS u32x4*)(lds + row * KS_STRIDE + ch * 16) = kv;
    LAS unsigned short* vt = (LAS unsigned short*)(lds + VT_OFF + (8 * ch) * VT_STRIDE + row * 2);
    const unsigned w[4] = {vv.x, vv.y, vv.z, vv.w};
#pragma unroll
    for (int i = 0; i < 4; ++i) { vt[(2 * i) * (VT_STRIDE / 2)] = (unsigned short)(w[i] & 0xffffu); vt[(2 * i + 1) * (VT_STRIDE / 2)] = (unsigned short)(w[i] >> 16); }
}
DI void attn_wave(LAS unsigned char* lds, const GAS bf16_t* qptr  , GAS bf16_t* optr, float sink, int kt0, int nkt, bool mask_last_half, bool do_store, int lane) {
    const int r = lane & 31, h = lane >> 5;
    bf16x8 qf[4];
#pragma unroll
    for (int ks = 0; ks < 4; ++ks) qf[ks] = *(const GAS bf16x8*)(qptr + 16 * ks + 8 * h);
    f32x16 st[6];
#pragma unroll
    for (int kt = 0; kt < 6; ++kt) {
#pragma unroll
        for (int i = 0; i < 16; ++i) st[kt][i] = 0.f;
        if (kt >= kt0 && kt < nkt) {
#pragma unroll
            for (int ks = 0; ks < 4; ++ks) { const bf16x8 kf = *(const LAS bf16x8*)(lds + (32 * kt + r) * KS_STRIDE + (16 * ks + 8 * h) * 2); st[kt] = MFMA32(kf, qf[ks], st[kt]); }
        }
    }
    float mx = sink;
#pragma unroll
    for (int kt = 0; kt < 6; ++kt) if (kt >= kt0 && kt < nkt) {
#pragma unroll
        for (int i = 0; i < 16; ++i) { const bool dead = mask_last_half && kt == nkt - 1 && i >= 8; if (!dead) mx = fmaxf(mx, st[kt][i]); }
    }
    mx = fmaxf(mx, __shfl_xor(mx, 32));
    float l = 0.f;
#pragma unroll
    for (int kt = 0; kt < 6; ++kt) if (kt >= kt0 && kt < nkt) {
#pragma unroll
        for (int i = 0; i < 16; ++i) { const bool dead = mask_last_half && kt == nkt - 1 && i >= 8; const float pv = dead ? 0.f : __expf(st[kt][i] - mx); st[kt][i] = pv; l += pv; }
    }
    l += __shfl_xor(l, 32);
    const float inv = 1.0f / (l + __expf(sink - mx));
    f32x16 ot[2];
#pragma unroll
    for (int dt = 0; dt < 2; ++dt)
#pragma unroll
        for (int i = 0; i < 16; ++i) ot[dt][i] = 0.f;
#pragma unroll
    for (int kt = 0; kt < 6; ++kt) if (kt >= kt0 && kt < nkt) {
#pragma unroll
        for (int s = 0; s < 2; ++s) {
            u32x4 pw; pw.x = pk2(st[kt][8 * s], st[kt][8 * s + 1]); pw.y = pk2(st[kt][8 * s + 2], st[kt][8 * s + 3]); pw.z = pk2(st[kt][8 * s + 4], st[kt][8 * s + 5]); pw.w = pk2(st[kt][8 * s + 6], st[kt][8 * s + 7]);
            const bf16x8 pf = __builtin_bit_cast(bf16x8, pw);
#pragma unroll
            for (int dt = 0; dt < 2; ++dt) {
                const LAS unsigned char* vp = lds + VT_OFF + (32 * dt + r) * VT_STRIDE + (32 * kt + 16 * s + 4 * h) * 2;
                const u32x2 v0 = *(const LAS u32x2*)vp, v1 = *(const LAS u32x2*)(vp + 16);
                u32x4 vw; vw.x = v0.x; vw.y = v0.y; vw.z = v1.x; vw.w = v1.y;
                ot[dt] = MFMA32(__builtin_bit_cast(bf16x8, vw), pf, ot[dt]);
            }
        }
    }
    if (do_store) {
#pragma unroll
        for (int dt = 0; dt < 2; ++dt)
#pragma unroll
            for (int rg = 0; rg < 4; ++rg) {
                u32x2 w; w.x = pk2(ot[dt][4 * rg] * inv, ot[dt][4 * rg + 1] * inv); w.y = pk2(ot[dt][4 * rg + 2] * inv, ot[dt][4 * rg + 3] * inv);
                *(GAS u32x2*)(optr + 32 * dt + 8 * rg + 4 * h) = w;
            }
    }
}
DI void attn_phase(const Params& p, LAS unsigned char* lds, int G) {
    const int tid = threadIdx.x, lane = tid & 63, wid = __builtin_amdgcn_readfirstlane(tid >> 6);
    unsigned char* ws = p.ws;
    const GAS bf16_t* Q = (const GAS bf16_t*)(ws + WS_Q); const GAS bf16_t* Kb = (const GAS bf16_t*)(ws + WS_K); const GAS bf16_t* Vb = (const GAS bf16_t*)(ws + WS_V);
    GAS bf16_t* MIX = (GAS bf16_t*)(ws + WS_MIX);
    const GAS float* sinks = (const GAS float*)p.in[10];
    constexpr int NPI = BATCH * 32 * 2, NSI = BATCH * 2;
    for (int it = blockIdx.x; it < NPI + NSI; it += G) {
        __syncthreads();
        if (it < NPI) {
            const int g = it & 1, n = (it >> 1) & 31, b = it >> 6;
            const int kt0 = n >= 2 ? 0 : (2 - n) * 2;
            const int krow0 = b * SEQ + 64 * (n - 2);
#pragma unroll
            for (int i = 0; i < 3; ++i) {
                const int cid = tid + 512 * i, row = cid >> 3, ch = cid & 7;
                if (row >= 32 * kt0) {
                    const size_t go = (size_t)(krow0 + row) * 128 + 64 * g + 8 * ch;
                    attn_store_kv(lds, row, ch, *(const GAS u32x4*)(Kb + go), *(const GAS u32x4*)(Vb + go));
                }
            }
            __syncthreads();
            const int hq = 4 * g + (wid >> 1);
            const int qrow = b * SEQ + 64 * n + 32 * (wid & 1) + (lane & 31);
            attn_wave(lds, Q + (size_t)qrow * 512 + 64 * hq, MIX + (size_t)qrow * 1024 + 64 * hq, sinks[hq], kt0, 6, false, true, lane);
        } else {
            const int si = it - NPI, g = si & 1, b = si >> 1;
            const GAS float* ck = (const GAS float*)p.in[2]; const GAS float* cv = (const GAS float*)p.in[3];
#pragma unroll
            for (int i = 0; i < 3; ++i) {
                const int cid = tid + 512 * i, row = cid >> 3, ch = cid & 7;
                if (row < 160) {
                    u32x4 kv = {0u, 0u, 0u, 0u}, vv = {0u, 0u, 0u, 0u};
                    if (row < 128) {
                        const size_t go = ((size_t)(b * 128 + row) * 2 + g) * 64 + 8 * ch;
                        kv = pk8(*(const GAS f32x4*)(ck + go), *(const GAS f32x4*)(ck + go + 4)); vv = pk8(*(const GAS f32x4*)(cv + go), *(const GAS f32x4*)(cv + go + 4));
                    } else if (row < 144) {
                        const size_t go = (size_t)(MP + b * 16 + (row - 128)) * 128 + 64 * g + 8 * ch;
                        kv = *(const GAS u32x4*)(Kb + go); vv = *(const GAS u32x4*)(Vb + go);
                    }
                    attn_store_kv(lds, row, ch, kv, vv);
                }
            }
            __syncthreads();
            if (wid < 4) {
                const int hq = 4 * g + wid;
                const int qrow = MP + b * 16 + (lane & 15);
                attn_wave(lds, Q + (size_t)qrow * 512 + 64 * hq, MIX + (size_t)qrow * 1024 + 64 * hq, sinks[hq], 0, 5, true, (lane & 31) < 16, lane);
            }
        }
    }
    __syncthreads();
}

constexpr int TSTR = 388;
constexpr int RW_OPB = 0;
constexpr int RW_SCP = RW_OPB + 2 * 16 * TSTR * 4;
constexpr int RW_PSC = RW_SCP + 2 * 16 * 2 * 4 * 4;
constexpr int RW_PB = RW_PSC + 3 * 16 * 2 * 4;
constexpr int RW_YB = RW_PB + 3 * 16 * 128 * 2;
constexpr int RW_LW2 = RW_YB + 2 * 16 * 64 * 4;
constexpr int RW_LA2 = RW_LW2 + 64 * 144;
constexpr int RW_LG2 = RW_LA2 + 64 * 144;
constexpr int RW_CV = RW_LG2 + 64 * 336;
constexpr int RW_MUL = RW_CV + 10 * 64 * 4;
constexpr int RW_XS = RW_MUL + 288 * 4;
constexpr int ACT_STR = 592;
constexpr int RW_ACT = RW_XS + 2 * 16 * 192 * 4;
constexpr int RW_END = RW_ACT + 2 * 16 * ACT_STR;
static_assert(RW_END <= LDS_BYTES, "rwkv LDS");
enum { CV_W0 = 0, CV_A0, CV_KK, CV_KA, CV_RK, CV_LG, CV_LB, CV_MR, CV_MK, CV_MV };
#define MFMA16(a, b, c) __builtin_amdgcn_mfma_f32_16x16x32_bf16((a), (b), (c), 0, 0, 0)

struct RwSeq { const GAS bf16_t* prw; const GAS float* shift0; const GAS float* wkv0; GAS float* wkv_out; GAS bf16_t* mix; int ntok; int h; };

DI void unpk8(u32x4 w, float (&o)[8]) { o[0] = bflo(w.x); o[1] = bfhi(w.x); o[2] = bflo(w.y); o[3] = bfhi(w.y); o[4] = bflo(w.z); o[5] = bfhi(w.z); o[6] = bflo(w.w); o[7] = bfhi(w.w); }

template <int I0> DI void rwkv_stage_half(LAS unsigned char* lds, const RwSeq& sq, int m, int l128) {
    const int buf = m & 1;
    u32x4 cur[8], prv[8]; int tks[8], cols[8], dst[8]; bool val[8];
#pragma unroll
    for (int i = I0; i < I0 + 4; ++i) {
        int tk, col, d; bool v = true;
        if (i < 3) { const int pi = l128 + 128 * i; tk = pi / 24; const int pc = pi - 24 * tk, which = pc >> 3, c8 = (pc & 7) * 8; col = which * 512 + 64 * sq.h + c8; d = which * 64 + c8; }
        else if (i == 3) { tk = l128 >> 3; d = (l128 & 7) * 8; col = 1536 + d; }
        else if (i == 4) { tk = l128 >> 3; d = 64 + (l128 & 7) * 8; col = 1536 + d; }
        else { const int pi = l128 + 128 * (i - 5); v = pi < 320; tk = pi / 20; d = 128 + (pi - 20 * tk) * 8; col = 1536 + d; if (!v) { tk = 0; d = 128; col = 1664; } }
        tks[i] = tk; cols[i] = col; dst[i] = d; val[i] = v;
        const int t = 16 * m + tk;
        const GAS bf16_t* pp = sq.prw + (size_t)t * RW_COLS + col;
        cur[i] = *(const GAS u32x4*)pp;
        if (t > 0) prv[i] = *(const GAS u32x4*)(pp - RW_COLS);
        else if (sq.shift0) prv[i] = pk8(*(const GAS f32x4*)(sq.shift0 + col), *(const GAS f32x4*)(sq.shift0 + col + 4));
        else prv[i] = (u32x4){0u, 0u, 0u, 0u};
    }
    const LAS float* CV = (const LAS float*)(lds + RW_CV);
    const LAS float* MUL = (const LAS float*)(lds + RW_MUL);
#pragma unroll
    for (int i = I0; i < I0 + 4; ++i) {
        float c[8], pv[8], xs[8];
        unpk8(cur[i], c); unpk8(prv[i], pv);
        const LAS float* mu = (i < 3) ? CV + CV_MR * 64 + dst[i] : MUL + dst[i];
        const f32x4 m0 = *(const LAS f32x4*)mu, m1 = *(const LAS f32x4*)(mu + 4);
#pragma unroll
        for (int j = 0; j < 8; ++j) xs[j] = c[j] + (pv[j] - c[j]) * (j < 4 ? m0[j] : m1[j - 4]);
        if (i < 3) {
            LAS float* xp = (LAS float*)(lds + RW_XS) + (buf * 16 + tks[i]) * 192 + dst[i];
            *(LAS f32x4*)xp = (f32x4){xs[0], xs[1], xs[2], xs[3]}; *(LAS f32x4*)(xp + 4) = (f32x4){xs[4], xs[5], xs[6], xs[7]};
        } else {
#pragma unroll
            for (int j = 0; j < 8; ++j) {
                if (i == 3) xs[j] = 1.0f - 2.0f * __builtin_amdgcn_rcpf(__expf(2.0f * xs[j]) + 1.0f);
                else if (i > 4) xs[j] = __builtin_amdgcn_rcpf(1.0f + __expf(-xs[j]));
            }
            u32x4 w; w.x = pk2(xs[0], xs[1]); w.y = pk2(xs[2], xs[3]); w.z = pk2(xs[4], xs[5]); w.w = pk2(xs[6], xs[7]);
            if (val[i]) *(LAS u32x4*)(lds + RW_ACT + (buf * 16 + tks[i]) * ACT_STR + dst[i] * 2) = w;
        }
    }
}
DI void rwkv_stage(LAS unsigned char* lds, const RwSeq& sq, int m, int l128) { rwkv_stage_half<0>(lds, sq, m, l128); asm volatile("" ::: "memory"); rwkv_stage_half<4>(lds, sq, m, l128); }
DI void rwkv_prep(LAS unsigned char* lds, const RwSeq& sq, int m, int w5, int lane) {
    const int buf = m & 1, pb = m % 3, tk = lane & 15, q = lane >> 4;
    const LAS float* CV = (const LAS float*)(lds + RW_CV);
    bf16x8 f[9];
#pragma unroll
    for (int ks = 0; ks < 9; ++ks) f[ks] = *(const LAS bf16x8*)(lds + RW_ACT + (buf * 16 + tk) * ACT_STR + (32 * ks + 8 * q) * 2);
    float ssq = 0.f, br = 0.f, kr = 0.f, bon = 0.f;
    LAS float* ob = (LAS float*)(lds + RW_OPB) + (buf * 16 + tk) * TSTR;
    const LAS float* xsp = (const LAS float*)(lds + RW_XS) + (buf * 16 + tk) * 192;
    LAS bf16_t* pbp = (LAS bf16_t*)(lds + RW_PB) + (pb * 16 + tk) * 128;
#pragma unroll
    for (int cc = 0; cc < 2; ++cc) {
        const int ct = 2 * w5 + cc, wrow = 16 * ct + tk;
        f32x4 aw = {0.f, 0.f, 0.f, 0.f}, aa = aw, ag = aw;
#pragma unroll
        for (int ks = 0; ks < 2; ++ks) {
            aw = MFMA16(*(const LAS bf16x8*)(lds + RW_LW2 + wrow * 144 + (32 * ks + 8 * q) * 2), f[ks], aw);
            aa = MFMA16(*(const LAS bf16x8*)(lds + RW_LA2 + wrow * 144 + (32 * ks + 8 * q) * 2), f[2 + ks], aa);
        }
#pragma unroll
        for (int ks = 0; ks < 5; ++ks) ag = MFMA16(*(const LAS bf16x8*)(lds + RW_LG2 + wrow * 336 + (32 * ks + 8 * q) * 2), f[4 + ks], ag);
        const int c = 16 * ct + 4 * q;
        const f32x4 rr = *(const LAS f32x4*)(xsp + c), kx = *(const LAS f32x4*)(xsp + 64 + c), vv = *(const LAS f32x4*)(xsp + 128 + c);
        const f32x4 w0 = *(const LAS f32x4*)(CV + CV_W0 * 64 + c), a0 = *(const LAS f32x4*)(CV + CV_A0 * 64 + c), kkc = *(const LAS f32x4*)(CV + CV_KK * 64 + c),
                    kac = *(const LAS f32x4*)(CV + CV_KA * 64 + c), rkc = *(const LAS f32x4*)(CV + CV_RK * 64 + c);
        f32x4 dec, asg, kp;
#pragma unroll
        for (int j = 0; j < 4; ++j) {
            const float z = -(w0[j] + aw[j]);
            const float sp = fmaxf(z, 0.f) + __logf(1.0f + __expf(-fabsf(z)));
            dec[j] = __expf(-__expf(-sp - 0.5f));
            asg[j] = __builtin_amdgcn_rcpf(1.0f + __expf(-(a0[j] + aa[j])));
            kp[j] = kx[j] * (1.0f + (asg[j] - 1.0f) * kac[j]);
        }
        const f32x4 kkr = kx * kkc, bun = kkr * asg;
        ssq += (kkr[0] * kkr[0] + kkr[1] * kkr[1]) + (kkr[2] * kkr[2] + kkr[3] * kkr[3]);
        br += (bun[0] * rr[0] + bun[1] * rr[1]) + (bun[2] * rr[2] + bun[3] * rr[3]);
        kr += (kp[0] * rr[0] + kp[1] * rr[1]) + (kp[2] * rr[2] + kp[3] * rr[3]);
        bon += (rr[0] * kp[0] * rkc[0] + rr[1] * kp[1] * rkc[1]) + (rr[2] * kp[2] * rkc[2] + rr[3] * kp[3] * rkc[3]);
        *(LAS f32x4*)(ob + 0 * 64 + c) = -kkr;
        *(LAS f32x4*)(ob + 1 * 64 + c) = dec * rr;
        *(LAS f32x4*)(ob + 2 * 64 + c) = dec;
        *(LAS f32x4*)(ob + 3 * 64 + c) = bun;
        *(LAS f32x4*)(ob + 4 * 64 + c) = kp;
        *(LAS f32x4*)(ob + 5 * 64 + c) = vv;
        u32x2 gw, vw; gw.x = pk2(ag[0], ag[1]); gw.y = pk2(ag[2], ag[3]); vw.x = pk2(vv[0], vv[1]); vw.y = pk2(vv[2], vv[3]);
        *(LAS u32x2*)(pbp + c) = gw; *(LAS u32x2*)(pbp + 64 + c) = vw;
    }
    ssq += __shfl_xor(ssq, 16); ssq += __shfl_xor(ssq, 32);
    br += __shfl_xor(br, 16); br += __shfl_xor(br, 32);
    kr += __shfl_xor(kr, 16); kr += __shfl_xor(kr, 32);
    bon += __shfl_xor(bon, 16); bon += __shfl_xor(bon, 32);
    if (q == 0) {
        *(LAS f32x4*)((LAS float*)(lds + RW_SCP) + ((buf * 16 + tk) * 2 + w5) * 4) = (f32x4){br, kr, ssq, 0.f};
        ((LAS float*)(lds + RW_PSC))[(pb * 16 + tk) * 2 + w5] = bon;
    }
}
DI void rwkv_post(LAS unsigned char* lds, const RwSeq& sq, int m, int lane) {
    const int buf = m & 1, pb = m % 3, tk = lane >> 2, cq = lane & 3, c0 = 16 * cq, t = 16 * m + tk;
    const LAS float* yb = (const LAS float*)(lds + RW_YB) + (buf * 16 + tk) * 64 + c0;
    const LAS float* CV = (const LAS float*)(lds + RW_CV);
    f32x4 y[4]; float s = 0.f;
#pragma unroll
    for (int i = 0; i < 4; ++i) { y[i] = *(const LAS f32x4*)(yb + 4 * i); s += (y[i][0] + y[i][1]) + (y[i][2] + y[i][3]); }
    const float mu = quad_sum(s) * (1.f / 64.f);
    float qv = 0.f;
#pragma unroll
    for (int i = 0; i < 4; ++i) { y[i] = y[i] - mu; qv += (y[i][0] * y[i][0] + y[i][1] * y[i][1]) + (y[i][2] * y[i][2] + y[i][3] * y[i][3]); }
    const float rs = __builtin_amdgcn_rsqf(quad_sum(qv) * (1.f / 64.f) + 64e-5f);
    const f32x2 bp = *(const LAS f32x2*)((const LAS float*)(lds + RW_PSC) + (pb * 16 + tk) * 2);
    const float bon = bp.x + bp.y;
    const LAS bf16_t* pbp = (const LAS bf16_t*)(lds + RW_PB) + (pb * 16 + tk) * 128 + c0;
    float g[16], v[16];
    { float t8[8]; unpk8(*(const LAS u32x4*)pbp, t8);
#pragma unroll
      for (int j = 0; j < 8; ++j) g[j] = t8[j];
      unpk8(*(const LAS u32x4*)(pbp + 8), t8);
#pragma unroll
      for (int j = 0; j < 8; ++j) g[8 + j] = t8[j];
      unpk8(*(const LAS u32x4*)(pbp + 64), t8);
#pragma unroll
      for (int j = 0; j < 8; ++j) v[j] = t8[j];
      unpk8(*(const LAS u32x4*)(pbp + 72), t8);
#pragma unroll
      for (int j = 0; j < 8; ++j) v[8 + j] = t8[j]; }
    f32x4 o[4];
#pragma unroll
    for (int i = 0; i < 4; ++i) {
        const f32x4 lg = *(const LAS f32x4*)(CV + CV_LG * 64 + c0 + 4 * i), lb = *(const LAS f32x4*)(CV + CV_LB * 64 + c0 + 4 * i);
#pragma unroll
        for (int j = 0; j < 4; ++j) o[i][j] = ((y[i][j] * rs) * lg[j] + lb[j] + v[4 * i + j] * bon) * g[4 * i + j];
    }
    GAS bf16_t* op = sq.mix + (size_t)t * 1024 + 512 + 64 * sq.h + c0;
    *(GAS u32x4*)op = pk8(o[0], o[1]); *(GAS u32x4*)(op + 8) = pk8(o[2], o[3]);
}
DI void rwkv_phase(const Params& p, LAS unsigned char* lds, int G) {
    const int tid = threadIdx.x, lane = tid & 63, wid = __builtin_amdgcn_readfirstlane(tid >> 6);
    unsigned char* ws = p.ws;
    for (int it = blockIdx.x; it < 2 * BATCH * 8; it += G) {
        const bool samp = it >= BATCH * 8;
        const int bh = samp ? it - BATCH * 8 : it, b = bh >> 3, h = bh & 7;
        RwSeq sq;
        const int row0 = samp ? MP + b * DEC_SEQ : b * SEQ;
        sq.prw = (const GAS bf16_t*)(ws + WS_PRW) + (size_t)row0 * RW_COLS;
        sq.mix = (GAS bf16_t*)(ws + WS_MIX) + (size_t)row0 * 1024;
        sq.shift0 = samp ? (const GAS float*)p.in[5] + (size_t)b * RW_COLS : nullptr;
        sq.wkv0 = samp ? (const GAS float*)p.in[4] + (size_t)bh * 4096 : nullptr;
        sq.wkv_out = (GAS float*)p.out + (samp ? O_SW : O_PW) + (size_t)bh * 4096;
        sq.ntok = samp ? DEC_SEQ : SEQ; sq.h = h;
        const int NC = sq.ntok / 16;
        __syncthreads();
        { const GAS bf16_t* W2T = (const GAS bf16_t*)(ws + WS_W2T) + (size_t)(64 * h) * 64; const GAS bf16_t* A2T = (const GAS bf16_t*)(ws + WS_A2T) + (size_t)(64 * h) * 64;
          const GAS bf16_t* G2T = (const GAS bf16_t*)(ws + WS_G2T) + (size_t)(64 * h) * 160;
          { const int row = tid >> 3, ch = tid & 7;
            *(LAS u32x4*)(lds + RW_LW2 + row * 144 + ch * 16) = *(const GAS u32x4*)(W2T + row * 64 + ch * 8);
            *(LAS u32x4*)(lds + RW_LA2 + row * 144 + ch * 16) = *(const GAS u32x4*)(A2T + row * 64 + ch * 8); }
          for (int i = tid; i < 64 * 20; i += 512) { const int row = i / 20, ch = i % 20; *(LAS u32x4*)(lds + RW_LG2 + row * 336 + ch * 16) = *(const GAS u32x4*)(G2T + row * 160 + ch * 8); }
          LAS float* CV = (LAS float*)(lds + RW_CV);
          if (tid < 64) {
              const int c = 64 * h + tid;
              CV[CV_W0 * 64 + tid] = ((const GAS float*)p.in[12])[c]; CV[CV_A0 * 64 + tid] = ((const GAS float*)p.in[14])[c];
              CV[CV_KK * 64 + tid] = ((const GAS float*)p.in[17])[c]; CV[CV_KA * 64 + tid] = ((const GAS float*)p.in[18])[c];
              CV[CV_RK * 64 + tid] = ((const GAS float*)p.in[19])[c]; CV[CV_LG * 64 + tid] = ((const GAS float*)p.in[20])[c];
              CV[CV_LB * 64 + tid] = ((const GAS float*)p.in[21])[c];
              const GAS float* mu = (const GAS float*)p.in[11];
              CV[CV_MR * 64 + tid] = mu[c]; CV[CV_MK * 64 + tid] = mu[512 + c]; CV[CV_MV * 64 + tid] = mu[1024 + c];
          }
          if (tid >= 64 && tid < 64 + 288) ((LAS float*)(lds + RW_MUL))[tid - 64] = ((const GAS float*)p.in[11])[1536 + tid - 64];
        }
        __syncthreads();
        if (wid < 4) {
            int ln = lane; asm volatile("" : "+v"(ln));
            const int pp = ln >> 3, o = ln & 7, irow = 16 * wid + 2 * pp;
            float s0[8], s1[8];
#pragma unroll
            for (int j = 0; j < 8; ++j) { s0[j] = 0.f; s1[j] = 0.f; }
            if (sq.wkv0) {
                const f32x4 a = *(const GAS f32x4*)(sq.wkv0 + irow * 64 + 8 * o), b2 = *(const GAS f32x4*)(sq.wkv0 + irow * 64 + 8 * o + 4);
                const f32x4 c = *(const GAS f32x4*)(sq.wkv0 + (irow + 1) * 64 + 8 * o), d = *(const GAS f32x4*)(sq.wkv0 + (irow + 1) * 64 + 8 * o + 4);
#pragma unroll
                for (int j = 0; j < 4; ++j) { s0[j] = a[j]; s0[4 + j] = b2[j]; s1[j] = c[j]; s1[4 + j] = d[j]; }
            }
            __syncthreads(); __syncthreads();
            for (int n = 0; n < NC; ++n) {
                {
                    const int buf = n & 1;
                    const LAS float* ob = (const LAS float*)(lds + RW_OPB) + (buf * 16) * TSTR + 8 * o;
                    const LAS float* sc = (const LAS float*)(lds + RW_SCP) + (buf * 16) * 8;
                    LAS float* yb = (LAS float*)(lds + RW_YB) + (buf * 16) * 64 + irow;
#define RW_LOAD(X, T) do { const LAS float* ot_ = ob + (T) * TSTR; \
                        X##a0 = *(const LAS f32x4*)(ot_); X##a1 = *(const LAS f32x4*)(ot_ + 4); X##q0 = *(const LAS f32x4*)(ot_ + 64); X##q1 = *(const LAS f32x4*)(ot_ + 68); \
                        X##w0 = *(const LAS f32x4*)(ot_ + 128); X##w1 = *(const LAS f32x4*)(ot_ + 132); X##b0 = *(const LAS f32x4*)(ot_ + 192); X##b1 = *(const LAS f32x4*)(ot_ + 196); \
                        X##k0 = *(const LAS f32x4*)(ot_ + 256); X##k1 = *(const LAS f32x4*)(ot_ + 260); X##vv = *(const LAS f32x2*)(ot_ - 8 * o + 5 * 64 + irow); \
                        X##pA = *(const LAS f32x4*)(sc + (T) * 8); X##pB = *(const LAS f32x4*)(sc + (T) * 8 + 4); } while (0)
#define RW_STEP(X, T) do { \
                        const float brs = X##pA.x + X##pB.x, krs = X##pA.y + X##pB.y, k2 = __builtin_amdgcn_rcpf(fmaxf(X##pA.z + X##pB.z, 1e-24f)); \
                        const f32x4 e0 = (f32x4){s0[0], s0[1], s0[2], s0[3]}, e1 = (f32x4){s0[4], s0[5], s0[6], s0[7]}, g0 = (f32x4){s1[0], s1[1], s1[2], s1[3]}, g1 = (f32x4){s1[4], s1[5], s1[6], s1[7]}; \
                        const f32x4 ta0 = e0 * X##a0 + e1 * X##a1, ty0 = e0 * X##q0 + e1 * X##q1, ta1 = g0 * X##a0 + g1 * X##a1, ty1 = g0 * X##q0 + g1 * X##q1; \
                        float pa0 = (ta0[0] + ta0[1]) + (ta0[2] + ta0[3]), py0 = (ty0[0] + ty0[1]) + (ty0[2] + ty0[3]), pa1 = (ta1[0] + ta1[1]) + (ta1[2] + ta1[3]), py1 = (ty1[0] + ty1[1]) + (ty1[2] + ty1[3]); \
                        pa0 = oct_sum(pa0) * k2; py0 = oct_sum(py0); pa1 = oct_sum(pa1) * k2; py1 = oct_sum(py1); \
                        const float y0 = py0 + pa0 * brs + X##vv.x * krs, y1 = py1 + pa1 * brs + X##vv.y * krs; \
                        _Pragma("unroll") for (int j = 0; j < 4; ++j) { \
                            s0[j] = s0[j] * X##w0[j] + (pa0 * X##b0[j] + X##vv.x * X##k0[j]); s0[4 + j] = s0[4 + j] * X##w1[j] + (pa0 * X##b1[j] + X##vv.x * X##k1[j]); \
                            s1[j] = s1[j] * X##w0[j] + (pa1 * X##b0[j] + X##vv.y * X##k0[j]); s1[4 + j] = s1[4 + j] * X##w1[j] + (pa1 * X##b1[j] + X##vv.y * X##k1[j]); } \
                        if (o == 0) *(LAS f32x2*)(yb + (T) * 64) = (f32x2){y0, y1}; } while (0)
                    f32x4 Aa0, Aa1, Aq0, Aq1, Aw0, Aw1, Ab0, Ab1, Ak0, Ak1, ApA, ApB; f32x2 Avv;
                    f32x4 Ba0, Ba1, Bq0, Bq1, Bw0, Bw1, Bb0, Bb1, Bk0, Bk1, BpA, BpB; f32x2 Bvv;
                    RW_LOAD(A, 0);
#pragma unroll 1
                    for (int t = 0; t < 16; t += 2) {
                        RW_LOAD(B, t + 1);
                        RW_STEP(A, t);
                        if (t + 2 < 16) RW_LOAD(A, t + 2);
                        RW_STEP(B, t + 1);
                    }
#undef RW_LOAD
#undef RW_STEP
                }
                __syncthreads();
            }
            __syncthreads();
            GAS float* w0p = sq.wkv_out + irow * 64 + 8 * o;
            *(GAS f32x4*)w0p = (f32x4){s0[0], s0[1], s0[2], s0[3]}; *(GAS f32x4*)(w0p + 4) = (f32x4){s0[4], s0[5], s0[6], s0[7]};
            *(GAS f32x4*)(w0p + 64) = (f32x4){s1[0], s1[1], s1[2], s1[3]}; *(GAS f32x4*)(w0p + 68) = (f32x4){s1[4], s1[5], s1[6], s1[7]};
        } else if (wid < 6) {
            int ln = lane; asm volatile("" : "+v"(ln));
            for (int n = -2; n <= NC; ++n) {
                if (n + 1 >= 0 && n + 1 < NC) rwkv_prep(lds, sq, n + 1, wid - 4, ln);
                __syncthreads();
            }
        } else {
            int ln = lane; asm volatile("" : "+v"(ln));
            for (int n = -2; n <= NC; ++n) {
                if (n + 2 < NC) rwkv_stage(lds, sq, n + 2, (wid - 6) * 64 + ln);
                if (wid == 7 && n >= 1 && n - 1 < NC) rwkv_post(lds, sq, n - 1, ln);
                __syncthreads();
            }
        }
    }
    __syncthreads();
}

#define XB_TMO      128
#define XB_XCNT(j)  (256  + 64 * (j))
#define XB_XSUB(j)  (1280 + 64 * (j))
#define XB_XGEN(j)  (2304 + 64 * (j))
#define XB_TOP      3328
#define XB_TOPGEN   3392
#define XCD_BAR_WORDS 3456
#define XB_SPIN_CAP (1u << 18)

__device__ __forceinline__ unsigned xb_ld(unsigned* p)              { return __hip_atomic_load(p, __ATOMIC_RELAXED, __HIP_MEMORY_SCOPE_AGENT); }
__device__ __forceinline__ unsigned xb_add(unsigned* p, unsigned v) { return __hip_atomic_fetch_add(p, v, __ATOMIC_RELAXED, __HIP_MEMORY_SCOPE_AGENT); }
__device__ __forceinline__ unsigned xb_xcc_id() { return (unsigned)__builtin_amdgcn_s_getreg((3 << 11) | 20) & 0xFu; }
#define XB_SPIN(cond, bar) do { unsigned _sp = 0; while (cond) { __builtin_amdgcn_s_sleep(1); \
    if ((++_sp & 255u) == 0u) { if (xb_ld(&(bar)[XB_TMO])) break; if (_sp > XB_SPIN_CAP) { atomicAdd(&(bar)[XB_TMO], 1u); break; } } } } while (0)

struct XcdBarrier {
    unsigned* bar; unsigned x;
    volatile LAS unsigned* st;
};

__device__ __forceinline__ XcdBarrier xcd_barrier_post(unsigned* bar, volatile LAS unsigned* st) {
    XcdBarrier b; b.bar = bar; b.x = xb_xcc_id(); b.st = st;
    if (threadIdx.x == 0) (void)xb_add(&bar[XB_XCNT(b.x)], 1u);
    return b;
}
__device__ __forceinline__ void xcd_barrier_complete(unsigned* bar, unsigned x, unsigned& nloc, unsigned& nx) {
    const unsigned G = gridDim.x * gridDim.y * gridDim.z;
    unsigned sum, cnt, mine, sp = 0u;
    for (;;) {
        sum = 0u; cnt = 0u; mine = 0u;
#pragma unroll
        for (unsigned j = 0; j < 16; ++j) { const unsigned c = xb_ld(&bar[XB_XCNT(j)]); sum += c; cnt += (c > 0u) ? 1u : 0u; mine = (j == x) ? c : mine; }
        if (sum == G) break;
        __builtin_amdgcn_s_sleep(1);
        if ((++sp & 255u) == 0u) { if (xb_ld(&bar[XB_TMO])) break; if (sp > XB_SPIN_CAP) { atomicAdd(&bar[XB_TMO], 1u); break; } }
    }
    nloc = mine > 0u ? mine : 1u; nx = cnt > 0u ? cnt : 1u;
}

__device__ __forceinline__ void xcd_barrier(const XcdBarrier& b) {
    asm volatile("s_waitcnt vmcnt(0)" ::: "memory");
    __syncthreads();
    if (threadIdx.x == 0) {
        unsigned* bar = b.bar;
        __builtin_amdgcn_s_waitcnt(0);
        unsigned nloc = b.st[0], nx = b.st[1];
        if (nloc == 0u) { xcd_barrier_complete(bar, b.x, nloc, nx); b.st[0] = nloc; b.st[1] = nx; }
        const unsigned old = xb_add(&bar[XB_XSUB(b.x)], 1u);
        const unsigned gen = old / nloc;
        if (old + 1u == (gen + 1u) * nloc) {
            __builtin_amdgcn_fence(__ATOMIC_RELEASE, "agent");
            asm volatile("s_waitcnt vmcnt(0)" ::: "memory");
            const unsigned og = xb_add(&bar[XB_TOP], 1u);
            const unsigned tg = og / nx;
            if (og + 1u == (tg + 1u) * nx) xb_add(&bar[XB_TOPGEN], 1u);
            else XB_SPIN(xb_ld(&bar[XB_TOPGEN]) == tg, bar);
            __builtin_amdgcn_fence(__ATOMIC_ACQUIRE, "agent");
            xb_add(&bar[XB_XGEN(b.x)], 1u);
            asm volatile("s_waitcnt vmcnt(0)" ::: "memory");
        } else {
            XB_SPIN(xb_ld(&bar[XB_XGEN(b.x)]) == gen, bar);
            __builtin_amdgcn_fence(__ATOMIC_ACQUIRE, "agent");
            asm volatile("s_waitcnt vmcnt(0)" ::: "memory");
        }
    }
    __syncthreads();
}

__global__ void __launch_bounds__(512, 2) fwd_kernel(Params p) {
    extern __shared__ __attribute__((aligned(16))) unsigned char lds_raw[];
    LAS unsigned char* lds = (LAS unsigned char*)lds_raw;
    const int G = gridDim.x;
    unsigned char* ws = p.ws;
    const int lo = p.ph_lo, hi = p.ph_hi;
#define IN(k) (lo <= (k) && (k) < hi)
    volatile LAS unsigned* bst = (volatile LAS unsigned*)(lds + LDS_BYTES - 16);
    if (threadIdx.x < 4) bst[threadIdx.x] = 0u;
    __syncthreads();
    const XcdBarrier bar = xcd_barrier_post((unsigned*)(ws + WS_CTL), bst);
#define SEAM(k) do { if (IN(k) && IN((k) + 1)) { xcd_barrier(bar); } } while (0)
    if (IN(0)) { phase0(p, lds, G); }
    SEAM(0);
    if (IN(1)) {
        pg8::Gemm g{(const bf16_t*)(ws + WS_H), (const bf16_t*)(ws + WS_WIN), MT, IN_PAD, 1024}; pg8::StaticOrder S; S.init(MT, IN_PAD, G, (int)blockIdx.x);
        EpiIn E{(GAS bf16_t*)(ws + WS_Q), (GAS bf16_t*)(ws + WS_K), (GAS bf16_t*)(ws + WS_V), (GAS bf16_t*)(ws + WS_PRW), (GAS float*)p.out, (const GAS float*)(ws + WS_ROPE), (const GAS float*)p.in[8], (const GAS float*)p.in[9]};
        pg8::gemm_phase<EpiIn, pg8::StaticOrder>(lds, g, S, E);
    }
    SEAM(1);
    if (IN(2)) { attn_phase(p, lds, G); rwkv_phase(p, lds, G); }
    SEAM(2);
    if (IN(3)) {
        pg8::Gemm g{(const bf16_t*)(ws + WS_MIX), (const bf16_t*)(ws + WS_WOUT), MT, 1024, 1024}; pg8::StaticOrder S; S.init(MT, 1024, G, (int)blockIdx.x);
        EpiOut E{(const GAS float*)p.in[0], (const GAS float*)p.in[1], (GAS float*)p.out, (GAS bf16_t*)(ws + WS_X1B), (GAS float*)(ws + WS_SSQ)};
        pg8::gemm_phase<EpiOut, pg8::StaticOrder>(lds, g, S, E);
    }
    SEAM(3);
    if (IN(4)) {
        pg8::Gemm g{(const bf16_t*)(ws + WS_X1B), (const bf16_t*)(ws + WS_WUP), MT, D_FF, 1024}; pg8::StaticOrder S; S.init(MT, D_FF, G, (int)blockIdx.x);
        EpiUp E{(const GAS float*)(ws + WS_SSQ), (GAS bf16_t*)(ws + WS_U)};
        pg8::gemm_phase<EpiUp, pg8::StaticOrder>(lds, g, S, E);
    }
    SEAM(4);
    if (IN(5)) {
        pg8::Gemm g{(const bf16_t*)(ws + WS_U), (const bf16_t*)(ws + WS_WDN), MT, 1024, D_FF}; pg8::StaticOrder S; S.init(MT, 1024, G, (int)blockIdx.x);
        EpiDown E{(GAS float*)p.out};
        pg8::gemm_phase<EpiDown, pg8::StaticOrder>(lds, g, S, E);
    }
#undef IN
#undef SEAM
}

extern "C" void kernel_launch(void* const* d_in, const int* in_sizes, int n_in, void* d_out, int out_size, void* d_ws, size_t ws_size, hipStream_t stream) {
    static int grid = 0;
    if (grid == 0) {
        if (n_in != 26 || ws_size < WS_END) { fprintf(stderr, "kernel_launch: expected 26 inputs and >= %zu bytes of workspace (got %d, %zu)\n", (size_t)WS_END, n_in, ws_size); grid = -1; return; }
        int dev = 0, cus = 0, per_cu = 0;
        hipGetDevice(&dev);
        hipDeviceGetAttribute(&cus, hipDeviceAttributeMultiprocessorCount, dev);
        if (hipFuncSetAttribute((const void*)fwd_kernel, hipFuncAttributeMaxDynamicSharedMemorySize, LDS_BYTES) != hipSuccess) { fprintf(stderr, "kernel_launch: hipFuncSetAttribute failed\n"); grid = -1; return; }
        if (hipOccupancyMaxActiveBlocksPerMultiprocessor(&per_cu, (const void*)fwd_kernel, 512, LDS_BYTES) != hipSuccess || per_cu < 1) { fprintf(stderr, "kernel_launch: occupancy query failed (%d)\n", per_cu); (void)hipGetLastError(); per_cu = 1; }
        grid = cus * per_cu;
        if (grid > 256) grid = 256;
    }
    if (grid < 0) return;
    Params a{};
    for (int i = 0; i < 26; ++i) a.in[i] = (const float*)d_in[i];
    a.out = (float*)d_out; a.ws = (unsigned char*)d_ws;
#if MK_N_LAUNCHES == 1
    a.ph_lo = 0; a.ph_hi = 6;
    if (hipMemsetAsync((char*)d_ws + WS_CTL, 0, CTL_BYTES, stream) != hipSuccess) { fprintf(stderr, "kernel_launch: memset of the barrier words failed\n"); return; }
    hipLaunchKernelGGL(fwd_kernel, dim3(grid), dim3(512), LDS_BYTES, stream, a);
    { const hipError_t e = hipPeekAtLastError(); if (e != hipSuccess) fprintf(stderr, "launch failed: %s (grid %d)\n", hipGetErrorString(e), grid); }
#else
    for (int ph = 0; ph < 6; ++ph) {
        a.ph_lo = ph; a.ph_hi = ph + 1;
        hipLaunchKernelGGL(fwd_kernel, dim3(grid), dim3(512), LDS_BYTES, stream, a);
    }
#endif
}
```

```cpp
#include <hip/hip_runtime.h>
#include <hip/hip_cooperative_groups.h>
#include <cstdio>
#include <cstdint>
namespace cg = cooperative_groups;

#ifndef MK_N_LAUNCHES
#define MK_N_LAUNCHES 1
#endif

#define GAS __attribute__((address_space(1)))
#define LAS __attribute__((address_space(3)))
typedef unsigned short bf16_t;
typedef short bf16x8 __attribute__((ext_vector_type(8)));
typedef short s16x4 __attribute__((ext_vector_type(4)));
typedef float f32x2 __attribute__((ext_vector_type(2)));
typedef float f32x4 __attribute__((ext_vector_type(4)));
typedef float f32x16 __attribute__((ext_vector_type(16)));
typedef unsigned u32x2 __attribute__((ext_vector_type(2)));
typedef unsigned u32x4 __attribute__((ext_vector_type(4)));
typedef __bf16 bf16v2 __attribute__((ext_vector_type(2)));
#define DI __device__ __forceinline__

constexpr int D_MODEL = 1024, SEQ = 2048, BATCH = 32, DEC_SEQ = 16;
constexpr int MP = BATCH * SEQ;
constexpr int MS = BATCH * DEC_SEQ;
constexpr int MT = MP + MS;
constexpr int IN_COLS = 2592, IN_PAD = 2816;
constexpr int RW_COLS = 1824, D_FF = 4096;
constexpr int NPOS = SEQ + DEC_SEQ;

constexpr size_t O_PK = 67633152, O_PV = 68157440, O_PW = 68681728, O_PS = 69730304, O_SK = 69788672, O_SV = 69854208, O_SW = 69919744, O_SS = 70968320;

constexpr size_t al256(size_t x) { return (x + 255) & ~(size_t)255; }
constexpr size_t WS_WIN = 0;
constexpr size_t WS_WOUT = WS_WIN + (size_t)IN_PAD * 1024 * 2;
constexpr size_t WS_WUP = WS_WOUT + (size_t)1024 * 1024 * 2;
constexpr size_t WS_WDN = WS_WUP + (size_t)4096 * 1024 * 2;
constexpr size_t WS_W2T = WS_WDN + (size_t)4096 * 1024 * 2;
constexpr size_t WS_A2T = WS_W2T + 512 * 64 * 2;
constexpr size_t WS_G2T = WS_A2T + 512 * 64 * 2;
constexpr size_t WS_ROPE = al256(WS_G2T + 512 * 160 * 2);
constexpr size_t WS_SSQ = al256(WS_ROPE + (size_t)NPOS * 64 * 4);
constexpr size_t WS_X1B = al256(WS_SSQ + (size_t)MT * 16 * 4);
constexpr size_t WS_H = al256(WS_X1B + (size_t)MT * 1024 * 2);
constexpr size_t WS_Q = WS_H + (size_t)MT * 1024 * 2;
constexpr size_t WS_K = WS_Q + (size_t)MT * 512 * 2;
constexpr size_t WS_V = WS_K + (size_t)MT * 128 * 2;
constexpr size_t WS_PRW = WS_V + (size_t)MT * 128 * 2;
constexpr size_t WS_MIX = WS_PRW + (size_t)MT * RW_COLS * 2;
constexpr size_t WS_AEND = WS_MIX + (size_t)MT * 1024 * 2;
constexpr size_t WS_U = WS_H;
static_assert(WS_U + (size_t)MT * 4096 * 2 <= WS_AEND, "U overlay");
constexpr size_t WS_CTL = al256(WS_AEND);
constexpr size_t CTL_BYTES = 16384;
constexpr size_t WS_END = WS_CTL + CTL_BYTES;
static_assert(WS_END <= (size_t)1 << 30, "workspace");

constexpr int LDS_BYTES = 163840;

DI unsigned pk2(float lo, float hi) { f32x2 v = {lo, hi}; return __builtin_bit_cast(unsigned, __builtin_convertvector(v, bf16v2)); }
DI float bf2f(unsigned short b) { return __builtin_bit_cast(float, (unsigned)b << 16); }
DI float bflo(unsigned w) { return __builtin_bit_cast(float, w << 16); }
DI float bfhi(unsigned w) { return __builtin_bit_cast(float, w & 0xffff0000u); }
DI u32x4 pk8(f32x4 a, f32x4 b) { u32x4 w; w.x = pk2(a[0], a[1]); w.y = pk2(a[2], a[3]); w.z = pk2(b[0], b[1]); w.w = pk2(b[2], b[3]); return w; }
DI float wave_sum(float v) {
#pragma unroll
    for (int o = 1; o < 64; o <<= 1) v += __shfl_xor(v, o);
    return v;
}
template <int CTRL> DI float dpp_f(float x) { return __builtin_bit_cast(float, __builtin_amdgcn_mov_dpp(__builtin_bit_cast(int, x), CTRL, 0xf, 0xf, true)); }
DI float quad_sum(float x) { x += dpp_f<0xB1>(x); x += dpp_f<0x4E>(x); return x; }
DI float oct_sum(float x) { x = quad_sum(x); x += dpp_f<0x141>(x); return x; }
#define LDS_WAIT() asm volatile("s_waitcnt lgkmcnt(0)" ::: "memory")

namespace pg8 {
constexpr int BM = 256, BK = 64, HALF = 128, HTB = HALF * BK * 2, STAGE_BYTES = 8 * HTB, NXCD = 8, WGM = 8;
__host__ __device__ __forceinline__ int lds_byte(int r, int c) { const int st = (r >> 4) * 2 + (c >> 5), rr = r & 15, cc = c & 31, ob = rr * 64 + cc * 2; return st * 1024 + (ob ^ (((ob >> 9) & 1) << 5)); }
__host__ __device__ __forceinline__ void stage_rc(int b, int& R, int& C) { const int st = b / 1024, sb = b % 1024, swz = sb ^ (((sb >> 9) & 1) << 5); R = (st >> 1) * 16 + swz / 64; C = (st & 1) * 32 + (swz % 64) / 2; }
struct Unit { int pm, pn; };
struct Gemm { const bf16_t* A; const bf16_t* Bt; int M, N, K; };
struct StaticOrder {
    int nM, nN, nwg, G, c;
    __host__ __device__ void init(int M, int N, int G_, int c_) { nM = M / BM; nN = N / BM; nwg = nM * nN; G = G_; c = c_; }
    __host__ __device__ bool next(int i, Unit& u) const {
        const long L = (long)i * G + c; if (L >= nwg) return false;
        int wgid = (int)L; { const int q = nwg / NXCD, r = nwg % NXCD, xcd = wgid % NXCD, off = wgid / NXCD; wgid = (xcd < r ? xcd * (q + 1) : r * (q + 1) + (xcd - r) * q) + off; }
        const int nig = WGM * nN, gid = wgid / nig, fm = gid * WGM, gsz = (nM - fm) < WGM ? (nM - fm) : WGM;
        u.pm = fm + ((wgid % nig) % gsz); u.pn = (wgid % nig) / gsz; return true;
    }
};
template <class Epi, class Sched, bool ALIGN_EPI = true, bool SP2 = true>
__device__ __forceinline__ void gemm_phase(LAS unsigned char* lds, const Gemm g, const Sched& S, const Epi& E) {
    const int tid = threadIdx.x, wid = __builtin_amdgcn_readfirstlane(tid >> 6), lane = tid & 63, wr = wid >> 2, wc = wid & 3, fr = lane & 15, fq = lane >> 4;
    const int K = g.K, nt = K / BK;
    unsigned voffA[2];
#pragma unroll
    for (int i = 0; i < 2; ++i) { int R, C; stage_rc(tid * 16 + i * 8192, R, C); voffA[i] = (unsigned)(R * K + C) * 2u; }
    const size_t kstep = (size_t)(BK * 2);
    const size_t hstep = (size_t)HALF * K * 2;
    const size_t tstep = 2 * hstep;
    const unsigned ldsw = (unsigned)wid * 1024u;
    const int aoff = lds_byte(wr * 64 + fr, fq * 8), boff = lds_byte(wc * 32 + fr, fq * 8);
#define PG8_SA(b, h) (((b) * 2 + (h)) * HTB)
#define PG8_SB(b, h) ((4 + (b) * 2 + (h)) * HTB)
#define PG8_STAGE(bufoff, gbase, voff) do { _Pragma("unroll") for (int _i = 0; _i < 2; ++_i) \
        __builtin_amdgcn_global_load_lds((const unsigned*)((const char*)(gbase) + (voff)[_i]), (LAS unsigned*)(lds + (bufoff) + ldsw + _i * 8192), 16, 0, 0); } while (0)
#define PG8_LDA(dst, b, h) do { _Pragma("unroll") for (int m = 0; m < 4; ++m) _Pragma("unroll") for (int k = 0; k < 2; ++k) dst[m][k] = *(const LAS bf16x8*)(lds + PG8_SA(b, h) + aoff + m * 2048 + k * 1024); } while (0)
#define PG8_LDB(dst, b, h) do { _Pragma("unroll") for (int n = 0; n < 2; ++n) _Pragma("unroll") for (int k = 0; k < 2; ++k) dst[n][k] = *(const LAS bf16x8*)(lds + PG8_SB(b, h) + boff + n * 2048 + k * 1024); } while (0)
#define PG8_MMA(ai, bj, At, Bt) do { __builtin_amdgcn_s_setprio(1); _Pragma("unroll") for (int m = 0; m < 4; ++m) _Pragma("unroll") for (int n = 0; n < 2; ++n) _Pragma("unroll") for (int k = 0; k < 2; ++k) \
        acc[ai][bj][m][n] = __builtin_amdgcn_mfma_f32_16x16x32_bf16(Bt[n][k], At[m][k], acc[ai][bj][m][n], 0, 0, 0); __builtin_amdgcn_s_setprio(0); } while (0)
#define PG8_WAIT_V(n) asm volatile("s_waitcnt vmcnt(" #n ")" ::: "memory")
#define PG8_WAIT_L(n) asm volatile("s_waitcnt lgkmcnt(" #n ")" ::: "memory")
#define PG8_BAR __builtin_amdgcn_s_barrier()
#define PG8_SCHED __builtin_amdgcn_sched_barrier(0)
    Unit cur, nxt; int ui = 0;
    if (!S.next(0, cur)) return;
    f32x4 acc[2][2][4][2];
#pragma unroll
    for (int a = 0; a < 2; ++a)
#pragma unroll
        for (int b = 0; b < 2; ++b)
#pragma unroll
            for (int m = 0; m < 4; ++m)
#pragma unroll
                for (int n = 0; n < 2; ++n) acc[a][b][m][n] = (f32x4){0.f, 0.f, 0.f, 0.f};
    bf16x8 At[4][2], B0[2][2], B1[2][2];
    const char* cA = (const char*)g.A + (size_t)cur.pm * tstep; const char* cB = (const char*)g.Bt + (size_t)cur.pn * tstep;
    if constexpr (SP2) {
        PG8_STAGE(PG8_SB(0, 0), cB, voffA); PG8_STAGE(PG8_SB(0, 1), cB + hstep, voffA); PG8_STAGE(PG8_SA(0, 0), cA, voffA); PG8_STAGE(PG8_SA(0, 1), cA + hstep, voffA);
        if (wr == 1) PG8_BAR;
        PG8_WAIT_V(2); PG8_BAR;
        PG8_STAGE(PG8_SB(1, 0), cB + kstep, voffA); PG8_STAGE(PG8_SA(1, 0), cA + kstep, voffA); PG8_STAGE(PG8_SB(1, 1), cB + hstep + kstep, voffA);
        PG8_WAIT_V(6); PG8_BAR;
    } else {
        PG8_STAGE(PG8_SB(0, 0), cB, voffA); PG8_STAGE(PG8_SA(0, 0), cA, voffA); PG8_STAGE(PG8_SB(0, 1), cB + hstep, voffA); PG8_STAGE(PG8_SA(0, 1), cA + hstep, voffA);
        if (wr == 1) PG8_BAR;
        PG8_WAIT_V(4); PG8_BAR;
        PG8_STAGE(PG8_SB(1, 0), cB + kstep, voffA); PG8_STAGE(PG8_SA(1, 0), cA + kstep, voffA); PG8_STAGE(PG8_SB(1, 1), cB + hstep + kstep, voffA);
        PG8_WAIT_V(6); PG8_BAR;
    }
    for (;;) {
        const bool has_next = S.next(ui + 1, nxt);
        const char* nA = has_next ? (const char*)g.A + (size_t)nxt.pm * tstep : cA; const char* nB = has_next ? (const char*)g.Bt + (size_t)nxt.pn * tstep : cB;
        for (int t = 0; t < nt; t += 2) {
            const bool last = (t == nt - 2);
            const char* a1 = cA + (size_t)(t + 1) * kstep;
            const char* a2 = last ? nA : cA + (size_t)(t + 2) * kstep; const char* b2 = last ? nB : cB + (size_t)(t + 2) * kstep;
            const char* a3 = a2 + kstep; const char* b3 = b2 + kstep;
            if constexpr (SP2) {
            PG8_LDB(B0, 0, 0); PG8_LDB(B1, 0, 1); PG8_SCHED; PG8_LDA(At, 0, 0); PG8_STAGE(PG8_SA(1, 1), a1 + hstep, voffA);
            PG8_WAIT_V(8); PG8_WAIT_L(0); PG8_BAR; PG8_MMA(0, 0, At, B0); PG8_MMA(0, 1, At, B1); PG8_BAR; PG8_SCHED;
            PG8_LDA(At, 0, 1); PG8_STAGE(PG8_SB(0, 0), b2, voffA); PG8_STAGE(PG8_SB(0, 1), b2 + hstep, voffA); PG8_STAGE(PG8_SA(0, 0), a2, voffA);
            PG8_WAIT_V(8); PG8_WAIT_L(0); PG8_BAR; PG8_MMA(1, 0, At, B0); PG8_MMA(1, 1, At, B1); PG8_BAR; PG8_SCHED;
            PG8_LDB(B0, 1, 0); PG8_LDB(B1, 1, 1); PG8_SCHED; PG8_LDA(At, 1, 0); PG8_STAGE(PG8_SA(0, 1), a2 + hstep, voffA);
            PG8_WAIT_V(8); PG8_WAIT_L(0); PG8_BAR; PG8_MMA(0, 0, At, B0); PG8_MMA(0, 1, At, B1); PG8_BAR; PG8_SCHED;
            PG8_LDA(At, 1, 1); PG8_STAGE(PG8_SB(1, 0), b3, voffA); PG8_STAGE(PG8_SB(1, 1), b3 + hstep, voffA); PG8_STAGE(PG8_SA(1, 0), a3, voffA);
            PG8_WAIT_V(8); PG8_WAIT_L(0); PG8_BAR; PG8_MMA(1, 0, At, B0); PG8_MMA(1, 1, At, B1); PG8_BAR; PG8_SCHED;
            } else {
            PG8_LDB(B0, 0, 0); PG8_SCHED; PG8_LDA(At, 0, 0); PG8_STAGE(PG8_SA(1, 1), a1 + hstep, voffA);
            PG8_WAIT_L(8); PG8_BAR; PG8_WAIT_L(0); PG8_MMA(0, 0, At, B0); PG8_BAR; PG8_SCHED;
            PG8_LDB(B1, 0, 1); PG8_STAGE(PG8_SB(0, 0), b2, voffA);
            PG8_BAR; PG8_WAIT_L(0); PG8_MMA(0, 1, At, B1); PG8_BAR;
            PG8_LDA(At, 0, 1); PG8_STAGE(PG8_SA(0, 0), a2, voffA);
            PG8_BAR; PG8_WAIT_L(0); PG8_MMA(1, 0, At, B0); PG8_BAR; PG8_SCHED;
            PG8_STAGE(PG8_SB(0, 1), b2 + hstep, voffA);
            PG8_WAIT_V(6); PG8_BAR; PG8_MMA(1, 1, At, B1); PG8_BAR;
            PG8_LDB(B0, 1, 0); PG8_SCHED; PG8_LDA(At, 1, 0); PG8_STAGE(PG8_SA(0, 1), a2 + hstep, voffA);
            PG8_WAIT_L(8); PG8_BAR; PG8_WAIT_L(0); PG8_MMA(0, 0, At, B0); PG8_BAR; PG8_SCHED;
            PG8_LDB(B1, 1, 1); PG8_STAGE(PG8_SB(1, 0), b3, voffA);
            PG8_BAR; PG8_WAIT_L(0); PG8_MMA(0, 1, At, B1); PG8_BAR;
            PG8_LDA(At, 1, 1); PG8_STAGE(PG8_SA(1, 0), a3, voffA);
            PG8_BAR; PG8_WAIT_L(0); PG8_MMA(1, 0, At, B0); PG8_BAR; PG8_SCHED;
            PG8_STAGE(PG8_SB(1, 1), b3 + hstep, voffA);
            PG8_WAIT_V(6); PG8_BAR; PG8_MMA(1, 1, At, B1); PG8_BAR;
            }
        }
        if constexpr (ALIGN_EPI) { if (wr == 0) PG8_BAR; }
        E(acc, cur, wr, wc, fr, fq);
        if (!has_next) break;
#pragma unroll
        for (int a = 0; a < 2; ++a)
#pragma unroll
            for (int b = 0; b < 2; ++b)
#pragma unroll
                for (int m = 0; m < 4; ++m)
#pragma unroll
                    for (int n = 0; n < 2; ++n) acc[a][b][m][n] = (f32x4){0.f, 0.f, 0.f, 0.f};
        cur = nxt; cA = nA; cB = nB; ++ui;
        if constexpr (ALIGN_EPI) { if (wr == 1) PG8_BAR; }
    }
    PG8_WAIT_V(0);
    if constexpr (!ALIGN_EPI) { if (wr == 0) PG8_BAR; }
    PG8_BAR;
#undef PG8_SA
#undef PG8_SB
#undef PG8_STAGE
#undef PG8_LDA
#undef PG8_LDB
#undef PG8_MMA
#undef PG8_WAIT_V
#undef PG8_WAIT_L
#undef PG8_BAR
#undef PG8_SCHED
}
}

enum { MAP_NAT = 0, MAP_A = 1, MAP_B = 2 };
DI int rowmap(int mode, int c) {
    if (mode == MAP_NAT) return c;
    if (mode == MAP_A) { const int rem = c & 31; return (c & ~31) + 16 * ((rem >> 2) & 1) + 4 * (rem >> 3) + (rem & 3); }
    const int rem = c & 255; return (c & ~255) + 128 * ((rem >> 5) & 1) + 32 * (rem >> 6) + 16 * ((rem >> 2) & 1) + 4 * ((rem >> 3) & 3) + (rem & 3);
}

struct EpiIn {
    GAS bf16_t* Q; GAS bf16_t* Kb; GAS bf16_t* Vb; GAS bf16_t* PRW; GAS float* out; const GAS float* rope; const GAS float* qg; const GAS float* kg;
    DI void operator()(const f32x4 (&acc)[2][2][4][2], const pg8::Unit& u, int wr, int wc, int fr, int fq) const {
        const int H = u.pn * 4 + wc;
        const int row0 = u.pm * 256 + wr * 64 + fr;
        if (H < 10) {
            const bool isq = H < 8;
            const GAS float* g = isq ? qg : kg;
            f32x4 gv[2][2];
#pragma unroll
            for (int bj = 0; bj < 2; ++bj)
#pragma unroll
                for (int n = 0; n < 2; ++n) gv[bj][n] = *(const GAS f32x4*)(g + 32 * bj + 8 * fq + 4 * n);
#pragma unroll
            for (int ai = 0; ai < 2; ++ai)
#pragma unroll
                for (int m = 0; m < 4; ++m) {
                    const int row = row0 + ai * 128 + m * 16;
                    float ss = 0.f;
#pragma unroll
                    for (int bj = 0; bj < 2; ++bj)
#pragma unroll
                        for (int n = 0; n < 2; ++n) { const f32x4 x = acc[ai][bj][m][n]; ss += (x[0] * x[0] + x[1] * x[1]) + (x[2] * x[2] + x[3] * x[3]); }
                    ss += __shfl_xor(ss, 16); ss += __shfl_xor(ss, 32);
                    float rinv = __builtin_amdgcn_rsqf(ss * (1.f / 64.f) + 1e-6f);
                    if (isq) rinv *= 0.125f;
                    const bool samp = row >= MP;
                    const int rs = row - MP;
                    const int b = samp ? (rs >> 4) : (row >> 11), t = samp ? (rs & 15) : (row & 2047);
                    const int pi = samp ? (SEQ + t) : t;
                    const GAS float* rp = rope + (size_t)pi * 64 + 8 * fq;
                    f32x4 o1[2], o2[2];
#pragma unroll
                    for (int n = 0; n < 2; ++n) {
                        const f32x4 c4 = *(const GAS f32x4*)(rp + 4 * n), s4 = *(const GAS f32x4*)(rp + 32 + 4 * n);
                        const f32x4 x1 = acc[ai][0][m][n] * rinv * gv[0][n], x2 = acc[ai][1][m][n] * rinv * gv[1][n];
                        o1[n] = x1 * c4 - x2 * s4; o2[n] = x2 * c4 + x1 * s4;
                    }
                    if (isq) {
                        GAS bf16_t* qp = Q + (size_t)row * 512 + 64 * H + 8 * fq;
                        *(GAS u32x4*)qp = pk8(o1[0], o1[1]); *(GAS u32x4*)(qp + 32) = pk8(o2[0], o2[1]);
                    } else {
                        const int kvh = H - 8;
                        GAS bf16_t* kp = Kb + (size_t)row * 128 + 64 * kvh + 8 * fq;
                        *(GAS u32x4*)kp = pk8(o1[0], o1[1]); *(GAS u32x4*)(kp + 32) = pk8(o2[0], o2[1]);
                        if (samp || t >= SEQ - 128) {
                            GAS float* op = samp ? out + O_SK + ((size_t)(b * 16 + t) * 2 + kvh) * 64 + 8 * fq : out + O_PK + ((size_t)(b * 128 + (t - (SEQ - 128))) * 2 + kvh) * 64 + 8 * fq;
                            *(GAS f32x4*)op = o1[0]; *(GAS f32x4*)(op + 4) = o1[1]; *(GAS f32x4*)(op + 32) = o2[0]; *(GAS f32x4*)(op + 36) = o2[1];
                        }
                    }
                }
        } else if (H < 12) {
            const int kvh = H - 10;
#pragma unroll
            for (int ai = 0; ai < 2; ++ai)
#pragma unroll
                for (int m = 0; m < 4; ++m) {
                    const int row = row0 + ai * 128 + m * 16;
                    const bool samp = row >= MP;
                    const int rs = row - MP;
                    const int b = samp ? (rs >> 4) : (row >> 11), t = samp ? (rs & 15) : (row & 2047);
                    GAS bf16_t* vp = Vb + (size_t)row * 128 + 64 * kvh + 8 * fq;
                    *(GAS u32x4*)vp = pk8(acc[ai][0][m][0], acc[ai][0][m][1]); *(GAS u32x4*)(vp + 32) = pk8(acc[ai][1][m][0], acc[ai][1][m][1]);
                    if (samp || t >= SEQ - 128) {
                        GAS float* op = samp ? out + O_SV + ((size_t)(b * 16 + t) * 2 + kvh) * 64 + 8 * fq : out + O_PV + ((size_t)(b * 128 + (t - (SEQ - 128))) * 2 + kvh) * 64 + 8 * fq;
                        *(GAS f32x4*)op = acc[ai][0][m][0]; *(GAS f32x4*)(op + 4) = acc[ai][0][m][1]; *(GAS f32x4*)(op + 32) = acc[ai][1][m][0]; *(GAS f32x4*)(op + 36) = acc[ai][1][m][1];
                    }
                }
        } else {
            const int cr0 = (H - 12) * 64 + 8 * fq;
#pragma unroll
            for (int ai = 0; ai < 2; ++ai)
#pragma unroll
                for (int m = 0; m < 4; ++m) {
                    const int row = row0 + ai * 128 + m * 16;
                    const bool samp = row >= MP;
                    const int rs = row - MP;
                    const int b = samp ? (rs >> 4) : (row >> 11), t = samp ? (rs & 15) : (row & 2047);
                    const bool lastrow = samp ? (t == DEC_SEQ - 1) : (t == SEQ - 1);
#pragma unroll
                    for (int bj = 0; bj < 2; ++bj) {
                        const int cr = cr0 + 32 * bj;
                        if (cr < RW_COLS) {
                            *(GAS u32x4*)(PRW + (size_t)row * RW_COLS + cr) = pk8(acc[ai][bj][m][0], acc[ai][bj][m][1]);
                            if (lastrow) { GAS float* op = out + (samp ? O_SS : O_PS) + (size_t)b * RW_COLS + cr; *(GAS f32x4*)op = acc[ai][bj][m][0]; *(GAS f32x4*)(op + 4) = acc[ai][bj][m][1]; }
                        }
                    }
                }
        }
    }
};
struct EpiOut {
    const GAS float* xp; const GAS float* xs; GAS float* out; GAS bf16_t* X1B; GAS float* SSQ;
    DI void operator()(const f32x4 (&acc)[2][2][4][2], const pg8::Unit& u, int wr, int wc, int fr, int fq) const {
        const int row0 = u.pm * 256 + wr * 64 + fr, col0 = u.pn * 256 + wc * 32 + 4 * fq;
        const GAS float* xin = (u.pm < 256) ? xp : xs - (size_t)MP * 1024;
#pragma unroll
        for (int ai = 0; ai < 2; ++ai)
#pragma unroll
            for (int m = 0; m < 4; ++m) {
                const int row = row0 + ai * 128 + m * 16; const size_t off = (size_t)row * 1024 + col0;
                float ss = 0.f;
#pragma unroll
                for (int bj = 0; bj < 2; ++bj)
#pragma unroll
                    for (int n = 0; n < 2; ++n) {
                        const f32x4 o = *(const GAS f32x4*)(xin + off + bj * 128 + n * 16) + acc[ai][bj][m][n];
                        *(GAS f32x4*)(out + off + bj * 128 + n * 16) = o;
                        u32x2 w; w.x = pk2(o[0], o[1]); w.y = pk2(o[2], o[3]);
                        *(GAS u32x2*)(X1B + off + bj * 128 + n * 16) = w;
                        ss += (o[0] * o[0] + o[1] * o[1]) + (o[2] * o[2] + o[3] * o[3]);
                    }
                ss += __shfl_xor(ss, 16); ss += __shfl_xor(ss, 32);
                if (fq == 0) SSQ[(size_t)row * 16 + u.pn * 4 + wc] = ss;
            }
    }
};
struct EpiUp {
    const GAS float* SSQ; GAS bf16_t* U;
    DI void operator()(const f32x4 (&acc)[2][2][4][2], const pg8::Unit& u, int wr, int wc, int fr, int fq) const {
        const int row0 = u.pm * 256 + wr * 64 + fr, col0 = u.pn * 256 + wc * 32 + 8 * fq;
#pragma unroll
        for (int ai = 0; ai < 2; ++ai)
#pragma unroll
            for (int m = 0; m < 4; ++m) {
                const int row = row0 + ai * 128 + m * 16;
                const GAS f32x4* sp = (const GAS f32x4*)(SSQ + (size_t)row * 16);
                const f32x4 a = sp[0], b = sp[1], c = sp[2], d = sp[3];
                const f32x4 t4 = (a + b) + (c + d);
                const float tot = (t4[0] + t4[1]) + (t4[2] + t4[3]);
                const float s2 = 1.0f / (tot * (1.f / 1024.f) + 1e-6f);
#pragma unroll
                for (int bj = 0; bj < 2; ++bj) {
                    f32x4 v0 = acc[ai][bj][m][0], v1 = acc[ai][bj][m][1];
#pragma unroll
                    for (int j = 0; j < 4; ++j) { const float r0 = fmaxf(v0[j], 0.f), r1 = fmaxf(v1[j], 0.f); v0[j] = r0 * r0 * s2; v1[j] = r1 * r1 * s2; }
                    *(GAS u32x4*)(U + (size_t)row * D_FF + col0 + bj * 128) = pk8(v0, v1);
                }
            }
    }
};
struct EpiDown {
    GAS float* out;
    DI void operator()(const f32x4 (&acc)[2][2][4][2], const pg8::Unit& u, int wr, int wc, int fr, int fq) const {
        const int row0 = u.pm * 256 + wr * 64 + fr, col0 = u.pn * 256 + wc * 32 + 4 * fq;
#pragma unroll
        for (int ai = 0; ai < 2; ++ai)
#pragma unroll
            for (int m = 0; m < 4; ++m) {
                const size_t off = (size_t)(row0 + ai * 128 + m * 16) * 1024 + col0;
#pragma unroll
                for (int bj = 0; bj < 2; ++bj)
#pragma unroll
                    for (int n = 0; n < 2; ++n) { GAS float* p = out + off + bj * 128 + n * 16; *(GAS f32x4*)p = *(const GAS f32x4*)p + acc[ai][bj][m][n]; }
            }
    }
};

DI void p0_transpose_item(const GAS float* W, int K, int N, GAS bf16_t* WT, int mode, const GAS float* kscale, LAS float* scr, int item, int lane) {
    const int nblk = N / 32, kb = item / nblk, nb = item % nblk, k0 = 64 * kb, n0 = 32 * nb;
#pragma unroll 8
    for (int i = 0; i < 32; ++i) { const int kk = 2 * i + (lane >> 5); float v = W[(size_t)(k0 + kk) * N + n0 + (lane & 31)]; if (kscale) v *= kscale[k0 + kk]; scr[kk * 33 + (lane & 31)] = v; }
    LDS_WAIT();
    const int c = lane & 7;
#pragma unroll
    for (int j = 0; j < 4; ++j) { const int n = (lane >> 3) + 8 * j; const LAS float* s = scr + (8 * c) * 33 + n;
        u32x4 o; o.x = pk2(s[0 * 33], s[1 * 33]); o.y = pk2(s[2 * 33], s[3 * 33]); o.z = pk2(s[4 * 33], s[5 * 33]); o.w = pk2(s[6 * 33], s[7 * 33]);
        *(GAS u32x4*)(WT + (size_t)rowmap(mode, n0 + n) * K + k0 + 8 * c) = o; }
    LDS_WAIT();
}
DI void sincos_d(double x, double& s, double& c) {
    const double TWO_PI = 6.283185307179586476925287;
    const double n = __builtin_rint(x * (1.0 / TWO_PI));
    const double r = x - n * TWO_PI, r2 = r * r;
    double ps = 1.0, pc = 1.0;
#pragma unroll
    for (int k = 14; k >= 1; --k) { ps = 1.0 - ps * r2 / (double)((2 * k) * (2 * k + 1)); pc = 1.0 - pc * r2 / (double)((2 * k - 1) * (2 * k)); }
    s = r * ps; c = pc;
}

struct Params { const float* in[26]; float* out; unsigned char* ws; int ph_lo, ph_hi; };

DI void phase0(const Params& p, LAS unsigned char* lds, int G) {
    const int tid = threadIdx.x, lane = tid & 63, wave = tid >> 6;
    const int gw = blockIdx.x * 8 + wave, NGW = G * 8;
    LAS float* scr = (LAS float*)(lds + wave * 8704);
    unsigned char* ws = p.ws;
    const GAS float* w_in = (const GAS float*)p.in[7]; const GAS float* w_out = (const GAS float*)p.in[22]; const GAS float* w_up = (const GAS float*)p.in[24]; const GAS float* w_dn = (const GAS float*)p.in[25];
    const GAS float* ln2 = (const GAS float*)p.in[23];
    constexpr int I_IN = 16 * (IN_COLS / 32), I_OUT = 16 * 32, I_UP = 16 * 128, I_DN = 64 * 32, NITEMS = I_IN + I_OUT + I_UP + I_DN;
    for (int it = gw; it < NITEMS; it += NGW) {
        int r = it;
        if (r < I_IN) { p0_transpose_item(w_in, 1024, IN_COLS, (GAS bf16_t*)(ws + WS_WIN), MAP_B, nullptr, scr, r, lane); continue; } r -= I_IN;
        if (r < I_OUT) { p0_transpose_item(w_out, 1024, 1024, (GAS bf16_t*)(ws + WS_WOUT), MAP_NAT, nullptr, scr, r, lane); continue; } r -= I_OUT;
        if (r < I_UP) { p0_transpose_item(w_up, 1024, 4096, (GAS bf16_t*)(ws + WS_WUP), MAP_A, ln2, scr, r, lane); continue; } r -= I_UP;
        p0_transpose_item(w_dn, 4096, 1024, (GAS bf16_t*)(ws + WS_WDN), MAP_NAT, nullptr, scr, r, lane);
    }
    const int gt = blockIdx.x * 512 + tid, NGT = G * 512;
    for (int i = gt; i < (IN_PAD - IN_COLS) * 128; i += NGT) { const int c = IN_COLS + i / 128; *(GAS u32x4*)((GAS bf16_t*)(ws + WS_WIN) + (size_t)rowmap(MAP_B, c) * 1024 + (i % 128) * 8) = (u32x4){0u, 0u, 0u, 0u}; }
    { const GAS float* w2 = (const GAS float*)p.in[13]; const GAS float* a2 = (const GAS float*)p.in[15]; const GAS float* g2 = (const GAS float*)p.in[16];
      GAS bf16_t* W2T = (GAS bf16_t*)(ws + WS_W2T); GAS bf16_t* A2T = (GAS bf16_t*)(ws + WS_A2T); GAS bf16_t* G2T = (GAS bf16_t*)(ws + WS_G2T);
      for (int i = gt; i < 512 * 32; i += NGT) { const int n = i >> 5, k2 = (i & 31) * 2;
          *(GAS unsigned*)(W2T + n * 64 + k2) = pk2(w2[k2 * 512 + n], w2[(k2 + 1) * 512 + n]);
          *(GAS unsigned*)(A2T + n * 64 + k2) = pk2(a2[k2 * 512 + n], a2[(k2 + 1) * 512 + n]); }
      for (int i = gt; i < 512 * 80; i += NGT) { const int n = i / 80, k2 = (i % 80) * 2; *(GAS unsigned*)(G2T + n * 160 + k2) = pk2(g2[k2 * 512 + n], g2[(k2 + 1) * 512 + n]); } }
    { GAS float* rope = (GAS float*)(ws + WS_ROPE);
      for (int i = gt; i < NPOS * 32; i += NGT) { const int pi = i >> 5, f = i & 31; const int pos = pi < SEQ ? pi : 4096 + (pi - SEQ);
          const float inv = (float)exp(-(double)f * (9.210340371976182736 / 32.0));
          const float ang = (float)pos * inv;
          double s, c; sincos_d((double)ang, s, c);
          rope[(size_t)pi * 64 + f] = (float)c; rope[(size_t)pi * 64 + 32 + f] = (float)s; } }
    { const GAS float* g1 = (const GAS float*)p.in[6]; GAS bf16_t* Hh = (GAS bf16_t*)(ws + WS_H);
      f32x4 gv[4];
#pragma unroll
      for (int j = 0; j < 4; ++j) gv[j] = *((const GAS f32x4*)g1 + lane + 64 * j);
      for (int m = gw; m < MT; m += NGW) {
          const GAS float* xrow = (m < MP) ? (const GAS float*)p.in[0] + (size_t)m * 1024 : (const GAS float*)p.in[1] + (size_t)(m - MP) * 1024;
          const GAS f32x4* xr = (const GAS f32x4*)xrow + lane;
          f32x4 v[4]; float s = 0.f;
#pragma unroll
          for (int j = 0; j < 4; ++j) { v[j] = xr[64 * j]; s += (v[j][0] * v[j][0] + v[j][1] * v[j][1]) + (v[j][2] * v[j][2] + v[j][3] * v[j][3]); }
          const float rinv = __builtin_amdgcn_rsqf(wave_sum(s) * (1.f / 1024.f) + 1e-6f);
          GAS u32x2* o8 = (GAS u32x2*)(Hh + (size_t)m * 1024) + lane;
#pragma unroll
          for (int j = 0; j < 4; ++j) { const f32x4 y = v[j] * rinv * gv[j]; u32x2 w; w.x = pk2(y[0], y[1]); w.y = pk2(y[2], y[3]); o8[64 * j] = w; }
      } }
}

constexpr int KS_STRIDE = 144;
constexpr int VT_STRIDE = 392;
constexpr int VT_OFF = 192 * KS_STRIDE;
#define MFMA32(a, b, c) __builtin_amdgcn_mfma_f32_32x32x16_bf16((a), (b), (c), 0, 0, 0)

DI void attn_store_kv(LAS unsigned char* lds, int row, int ch, u32x4 kv, u32x4 vv) {
    *(LAS u32x4*)(lds + row * KS_STRIDE + ch * 16) = kv;
    LAS unsigned short* vt = (LAS unsigned short*)(lds + VT_OFF + (8 * ch) * VT_STRIDE + row * 2);
    const unsigned w[4] = {vv.x, vv.y, vv.z, vv.w};
#pragma unroll
    for (int i = 0; i < 4; ++i) { vt[(2 * i) * (VT_STRIDE / 2)] = (unsigned short)(w[i] & 0xffffu); vt[(2 * i + 1) * (VT_STRIDE / 2)] = (unsigned short)(w[i] >> 16); }
}
DI void attn_wave(LAS unsigned char* lds, const GAS bf16_t* qptr  , GAS bf16_t* optr, float sink, int kt0, int nkt, bool mask_last_half, bool do_store, int lane) {
    const int r = lane & 31, h = lane >> 5;
    bf16x8 qf[4];
#pragma unroll
    for (int ks = 0; ks < 4; ++ks) qf[ks] = *(const GAS bf16x8*)(qptr + 16 * ks + 8 * h);
    f32x16 st[6];
#pragma unroll
    for (int kt = 0; kt < 6; ++kt) {
#pragma unroll
        for (int i = 0; i < 16; ++i) st[kt][i] = 0.f;
        if (kt >= kt0 && kt < nkt) {
#pragma unroll
            for (int ks = 0; ks < 4; ++ks) { const bf16x8 kf = *(const LAS bf16x8*)(lds + (32 * kt + r) * KS_STRIDE + (16 * ks + 8 * h) * 2); st[kt] = MFMA32(kf, qf[ks], st[kt]); }
        }
    }
    float mx = sink;
#pragma unroll
    for (int kt = 0; kt < 6; ++kt) if (kt >= kt0 && kt < nkt) {
#pragma unroll
        for (int i = 0; i < 16; ++i) { const bool dead = mask_last_half && kt == nkt - 1 && i >= 8; if (!dead) mx = fmaxf(mx, st[kt][i]); }
    }
    mx = fmaxf(mx, __shfl_xor(mx, 32));
    float l = 0.f;
#pragma unroll
    for (int kt = 0; kt < 6; ++kt) if (kt >= kt0 && kt < nkt) {
#pragma unroll
        for (int i = 0; i < 16; ++i) { const bool dead = mask_last_half && kt == nkt - 1 && i >= 8; const float pv = dead ? 0.f : __expf(st[kt][i] - mx); st[kt][i] = pv; l += pv; }
    }
    l += __shfl_xor(l, 32);
    const float inv = 1.0f / (l + __expf(sink - mx));
    f32x16 ot[2];
#pragma unroll
    for (int dt = 0; dt < 2; ++dt)
#pragma unroll
        for (int i = 0; i < 16; ++i) ot[dt][i] = 0.f;
#pragma unroll
    for (int kt = 0; kt < 6; ++kt) if (kt >= kt0 && kt < nkt) {
#pragma unroll
        for (int s = 0; s < 2; ++s) {
            u32x4 pw; pw.x = pk2(st[kt][8 * s], st[kt][8 * s + 1]); pw.y = pk2(st[kt][8 * s + 2], st[kt][8 * s + 3]); pw.z = pk2(st[kt][8 * s + 4], st[kt][8 * s + 5]); pw.w = pk2(st[kt][8 * s + 6], st[kt][8 * s + 7]);
            const bf16x8 pf = __builtin_bit_cast(bf16x8, pw);
#pragma unroll
            for (int dt = 0; dt < 2; ++dt) {
                const LAS unsigned char* vp = lds + VT_OFF + (32 * dt + r) * VT_STRIDE + (32 * kt + 16 * s + 4 * h) * 2;
                const u32x2 v0 = *(const LAS u32x2*)vp, v1 = *(const LAS u32x2*)(vp + 16);
                u32x4 vw; vw.x = v0.x; vw.y = v0.y; vw.z = v1.x; vw.w = v1.y;
                ot[dt] = MFMA32(__builtin_bit_cast(bf16x8, vw), pf, ot[dt]);
            }
        }
    }
    if (do_store) {
#pragma unroll
        for (int dt = 0; dt < 2; ++dt)
#pragma unroll
            for (int rg = 0; rg < 4; ++rg) {
                u32x2 w; w.x = pk2(ot[dt][4 * rg] * inv, ot[dt][4 * rg + 1] * inv); w.y = pk2(ot[dt][4 * rg + 2] * inv, ot[dt][4 * rg + 3] * inv);
                *(GAS u32x2*)(optr + 32 * dt + 8 * rg + 4 * h) = w;
            }
    }
}
DI void attn_phase(const Params& p, LAS unsigned char* lds, int G) {
    const int tid = threadIdx.x, lane = tid & 63, wid = __builtin_amdgcn_readfirstlane(tid >> 6);
    unsigned char* ws = p.ws;
    const GAS bf16_t* Q = (const GAS bf16_t*)(ws + WS_Q); const GAS bf16_t* Kb = (const GAS bf16_t*)(ws + WS_K); const GAS bf16_t* Vb = (const GAS bf16_t*)(ws + WS_V);
    GAS bf16_t* MIX = (GAS bf16_t*)(ws + WS_MIX);
    const GAS float* sinks = (const GAS float*)p.in[10];
    constexpr int NPI = BATCH * 32 * 2, NSI = BATCH * 2;
    for (int it = blockIdx.x; it < NPI + NSI; it += G) {
        __syncthreads();
        if (it < NPI) {
            const int g = it & 1, n = (it >> 1) & 31, b = it >> 6;
            const int kt0 = n >= 2 ? 0 : (2 - n) * 2;
            const int krow0 = b * SEQ + 64 * (n - 2);
#pragma unroll
            for (int i = 0; i < 3; ++i) {
                const int cid = tid + 512 * i, row = cid >> 3, ch = cid & 7;
                if (row >= 32 * kt0) {
                    const size_t go = (size_t)(krow0 + row) * 128 + 64 * g + 8 * ch;
                    attn_store_kv(lds, row, ch, *(const GAS u32x4*)(Kb + go), *(const GAS u32x4*)(Vb + go));
                }
            }
            __syncthreads();
            const int hq = 4 * g + (wid >> 1);
            const int qrow = b * SEQ + 64 * n + 32 * (wid & 1) + (lane & 31);
            attn_wave(lds, Q + (size_t)qrow * 512 + 64 * hq, MIX + (size_t)qrow * 1024 + 64 * hq, sinks[hq], kt0, 6, false, true, lane);
        } else {
            const int si = it - NPI, g = si & 1, b = si >> 1;
            const GAS float* ck = (const GAS float*)p.in[2]; const GAS float* cv = (const GAS float*)p.in[3];
#pragma unroll
            for (int i = 0; i < 3; ++i) {
                const int cid = tid + 512 * i, row = cid >> 3, ch = cid & 7;
                if (row < 160) {
                    u32x4 kv = {0u, 0u, 0u, 0u}, vv = {0u, 0u, 0u, 0u};
                    if (row < 128) {
                        const size_t go = ((size_t)(b * 128 + row) * 2 + g) * 64 + 8 * ch;
                        kv = pk8(*(const GAS f32x4*)(ck + go), *(const GAS f32x4*)(ck + go + 4)); vv = pk8(*(const GAS f32x4*)(cv + go), *(const GAS f32x4*)(cv + go + 4));
                    } else if (row < 144) {
                        const size_t go = (size_t)(MP + b * 16 + (row - 128)) * 128 + 64 * g + 8 * ch;
                        kv = *(const GAS u32x4*)(Kb + go); vv = *(const GAS u32x4*)(Vb + go);
                    }
                    attn_store_kv(lds, row, ch, kv, vv);
                }
            }
            __syncthreads();
            if (wid < 4) {
                const int hq = 4 * g + wid;
                const int qrow = MP + b * 16 + (lane & 15);
                attn_wave(lds, Q + (size_t)qrow * 512 + 64 * hq, MIX + (size_t)qrow * 1024 + 64 * hq, sinks[hq], 0, 5, true, (lane & 31) < 16, lane);
            }
        }
    }
    __syncthreads();
}

constexpr int NHELP = 6;
constexpr int SL_AQ = 0, AQ_STR = 136;
constexpr int SL_GH = SL_AQ + 32 * AQ_STR, GH_STR = 48;
constexpr int SL_VT = SL_GH + 32 * GH_STR, T_STR = 48;
constexpr int SL_KT = SL_VT + 64 * T_STR;
constexpr int SL_BT = SL_KT + 64 * T_STR, BT_STR = 40;
constexpr int SL_WV = SL_BT + 64 * BT_STR;
constexpr int SL_PB = SL_WV + 256;
constexpr int SL_BON = SL_PB + 16 * 128 * 2;
constexpr int SLOT_BYTES = SL_BON + 64;
constexpr int RW_SLOTS = 0;
constexpr int RW_LW2 = RW_SLOTS + NHELP * SLOT_BYTES;
constexpr int RW_LA2 = RW_LW2 + 64 * 144;
constexpr int RW_LG2 = RW_LA2 + 64 * 144;
constexpr int RW_CV = RW_LG2 + 64 * 336;
constexpr int RW_MUL = RW_CV + 10 * 64 * 4;
constexpr int RW_FLG = RW_MUL + 288 * 4;
constexpr int RW_END = RW_FLG + 3 * 8 * 4;
static_assert(RW_END <= LDS_BYTES - 16, "rwkv LDS");
enum { CV_W0 = 0, CV_A0, CV_KK, CV_KA, CV_RK, CV_LG, CV_LB, CV_MR, CV_MK, CV_MV };
#define MFMA16(a, b, c) __builtin_amdgcn_mfma_f32_16x16x32_bf16((a), (b), (c), 0, 0, 0)

struct RwSeq { const GAS bf16_t* prw; const GAS float* shift0; const GAS float* wkv0; GAS float* wkv_out; GAS bf16_t* mix; int ntok; int h; };

DI void unpk8(u32x4 w, float (&o)[8]) { o[0] = bflo(w.x); o[1] = bfhi(w.x); o[2] = bflo(w.y); o[3] = bfhi(w.y); o[4] = bflo(w.z); o[5] = bfhi(w.z); o[6] = bflo(w.w); o[7] = bfhi(w.w); }
DI unsigned dpp_shr1_u(unsigned x) { return (unsigned)__builtin_amdgcn_update_dpp(0, (int)x, 0x111, 0xf, 0xf, true); }
template <int CTRL> DI float dpp_shr_f(float x) { return __builtin_bit_cast(float, __builtin_amdgcn_update_dpp(0, __builtin_bit_cast(int, x), CTRL, 0xf, 0xf, true)); }
DI void flag_wait(volatile LAS unsigned* f, unsigned v) { unsigned sp = 0; while (*f < v) { __builtin_amdgcn_s_sleep(1); if (++sp > (1u << 24)) break; } asm volatile("" ::: "memory"); }
DI void flag_set(volatile LAS unsigned* f, unsigned v, int ln) { asm volatile("s_waitcnt vmcnt(0) lgkmcnt(0)" ::: "memory"); if (ln == 0) *f = v; }
DI bf16x8 pack8f(const float (&x)[8]) { u32x4 w; w.x = pk2(x[0], x[1]); w.y = pk2(x[2], x[3]); w.z = pk2(x[4], x[5]); w.w = pk2(x[6], x[7]); return __builtin_bit_cast(bf16x8, w); }

DI void rw_helper_chunk(LAS unsigned char* lds, const RwSeq& sq, int m, unsigned k, int hw, int ln_) {
    int ln = ln_; asm volatile("" : "+v"(ln));
    const int tk = ln & 15, q = ln >> 4, t = 16 * m + tk;
    LAS unsigned char* sl = lds + RW_SLOTS + hw * SLOT_BYTES;
    const LAS float* CV = (const LAS float*)(lds + RW_CV);
    const LAS float* MUL = (const LAS float*)(lds + RW_MUL);
    volatile LAS unsigned* FLG = (volatile LAS unsigned*)(lds + RW_FLG);
    const GAS bf16_t* prow = sq.prw + (size_t)t * RW_COLS;
    const bool tk0 = tk == 0;
    const GAS bf16_t* pprev = prow - RW_COLS;
    const bool gprev = tk0 && t > 0, sprev = tk0 && t == 0 && sq.shift0 != nullptr;
#define RW_LOAD_L(KS, CUR, BND) do { CUR = *(const GAS u32x4*)(prow + 1536 + 32 * (KS) + 8 * q); BND = (u32x4){0u, 0u, 0u, 0u}; \
        if (gprev) BND = *(const GAS u32x4*)(pprev + 1536 + 32 * (KS) + 8 * q); \
        else if (sprev) { const GAS float* sp_ = sq.shift0 + 1536 + 32 * (KS) + 8 * q; BND = pk8(*(const GAS f32x4*)sp_, *(const GAS f32x4*)(sp_ + 4)); } } while (0)
#define RW_ACT(KS, CUR, BND, OUT) do { u32x4 pw_; pw_.x = dpp_shr1_u(CUR.x); pw_.y = dpp_shr1_u(CUR.y); pw_.z = dpp_shr1_u(CUR.z); pw_.w = dpp_shr1_u(CUR.w); \
        if (tk0) pw_ = BND; float c_[8], pv_[8], xs_[8]; unpk8(CUR, c_); unpk8(pw_, pv_); \
        const f32x4 m0_ = *(const LAS f32x4*)(MUL + 32 * (KS) + 8 * q), m1_ = *(const LAS f32x4*)(MUL + 32 * (KS) + 8 * q + 4); \
        _Pragma("unroll") for (int j = 0; j < 8; ++j) { const float x_ = c_[j] + (pv_[j] - c_[j]) * (j < 4 ? m0_[j] : m1_[j - 4]); \
            if ((KS) < 2) xs_[j] = 1.0f - 2.0f * __builtin_amdgcn_rcpf(__expf(2.0f * x_) + 1.0f); else if ((KS) < 4) xs_[j] = x_; else xs_[j] = __builtin_amdgcn_rcpf(1.0f + __expf(-x_)); } \
        OUT = pack8f(xs_); } while (0)
    f32x4 aw[4], aa[4], ag[4];
    f32x4 rr[4], kx[4];
    u32x2 vvp[4];
    float ssq = 0.f;
    {
        u32x4 lraw[4], lbnd[4]; u32x2 rraw[3][4], rbnd[3][4];
#pragma unroll
        for (int ks = 0; ks < 4; ++ks) RW_LOAD_L(ks, lraw[ks], lbnd[ks]);
#pragma unroll
        for (int w = 0; w < 3; ++w)
#pragma unroll
            for (int ct = 0; ct < 4; ++ct) {
                const int col = w * 512 + 64 * sq.h + 16 * ct + 4 * q;
                rraw[w][ct] = *(const GAS u32x2*)(prow + col); rbnd[w][ct] = (u32x2){0u, 0u};
                if (gprev) rbnd[w][ct] = *(const GAS u32x2*)(pprev + col);
                else if (sprev) { const f32x4 x = *(const GAS f32x4*)(sq.shift0 + col); u32x2 o; o.x = pk2(x[0], x[1]); o.y = pk2(x[2], x[3]); rbnd[w][ct] = o; }
            }
        bf16x8 f[4];
#pragma unroll
        for (int ks = 0; ks < 4; ++ks) RW_ACT(ks, lraw[ks], lbnd[ks], f[ks]);
#pragma unroll
        for (int ct = 0; ct < 4; ++ct) {
            const int wrow = 16 * ct + tk;
            f32x4 x = {0.f, 0.f, 0.f, 0.f}, y = x;
#pragma unroll
            for (int ks = 0; ks < 2; ++ks) {
                x = MFMA16(*(const LAS bf16x8*)(lds + RW_LW2 + wrow * 144 + (32 * ks + 8 * q) * 2), f[ks], x);
                y = MFMA16(*(const LAS bf16x8*)(lds + RW_LA2 + wrow * 144 + (32 * ks + 8 * q) * 2), f[2 + ks], y);
            }
            aw[ct] = x; aa[ct] = y;
        }
#pragma unroll
        for (int ct = 0; ct < 4; ++ct) {
            const int c = 16 * ct + 4 * q;
#pragma unroll
            for (int w = 0; w < 3; ++w) {
                u32x2 pw; pw.x = dpp_shr1_u(rraw[w][ct].x); pw.y = dpp_shr1_u(rraw[w][ct].y);
                if (tk0) pw = rbnd[w][ct];
                const f32x4 cu = (f32x4){bflo(rraw[w][ct].x), bfhi(rraw[w][ct].x), bflo(rraw[w][ct].y), bfhi(rraw[w][ct].y)};
                const f32x4 pr = (f32x4){bflo(pw.x), bfhi(pw.x), bflo(pw.y), bfhi(pw.y)};
                const f32x4 mu = *(const LAS f32x4*)(CV + (CV_MR + w) * 64 + c);
                const f32x4 xs = cu + (pr - cu) * mu;
                if (w == 0) rr[ct] = xs; else if (w == 1) kx[ct] = xs; else { u32x2 o; o.x = pk2(xs[0], xs[1]); o.y = pk2(xs[2], xs[3]); vvp[ct] = o; }
            }
            const f32x4 kkr = kx[ct] * *(const LAS f32x4*)(CV + CV_KK * 64 + c);
            ssq += (kkr[0] * kkr[0] + kkr[1] * kkr[1]) + (kkr[2] * kkr[2] + kkr[3] * kkr[3]);
        }
    }
    asm volatile("" ::: "memory");
    {
        u32x4 lraw[5], lbnd[5];
#pragma unroll
        for (int ks = 0; ks < 5; ++ks) RW_LOAD_L(4 + ks, lraw[ks], lbnd[ks]);
        bf16x8 f[5];
#pragma unroll
        for (int ks = 0; ks < 5; ++ks) RW_ACT(4 + ks, lraw[ks], lbnd[ks], f[ks]);
#pragma unroll
        for (int ct = 0; ct < 4; ++ct) {
            const int wrow = 16 * ct + tk;
            f32x4 z = {0.f, 0.f, 0.f, 0.f};
#pragma unroll
            for (int ks = 0; ks < 5; ++ks) z = MFMA16(*(const LAS bf16x8*)(lds + RW_LG2 + wrow * 336 + (32 * ks + 8 * q) * 2), f[ks], z);
            ag[ct] = z;
        }
    }
#undef RW_LOAD_L
#undef RW_ACT
    ssq += __shfl_xor(ssq, 16); ssq += __shfl_xor(ssq, 32);
    const float kinv = 1.0f / fmaxf(sqrtf(ssq), 1e-12f);
    flag_wait(FLG + 16 + hw, k);
    u32x2 fa2[4], fb2[4], fk2[4], fr2[4];
    u32x2 Bbp[4], Kbp[4];
    float bon = 0.f;
#pragma unroll
    for (int ct = 0; ct < 4; ++ct) {
        const int c = 16 * ct + 4 * q;
        const f32x4 w0 = *(const LAS f32x4*)(CV + CV_W0 * 64 + c), a0 = *(const LAS f32x4*)(CV + CV_A0 * 64 + c), kkc = *(const LAS f32x4*)(CV + CV_KK * 64 + c),
                    kac = *(const LAS f32x4*)(CV + CV_KA * 64 + c), rkc = *(const LAS f32x4*)(CV + CV_RK * 64 + c);
        f32x4 Bb, Kb, Wc, xa, xb, xk, xr;
#pragma unroll
        for (int j = 0; j < 4; ++j) {
            const float z = -(w0[j] + aw[ct][j]);
            const float sp = fmaxf(z, 0.f) + __logf(1.0f + __expf(-fabsf(z)));
            const float lw = -__expf(-sp - 0.5f);
            float cl = lw;
            cl += dpp_shr_f<0x111>(cl); cl += dpp_shr_f<0x112>(cl); cl += dpp_shr_f<0x114>(cl); cl += dpp_shr_f<0x118>(cl);
            const float clC = __shfl(cl, (ln & 48) | 15);
            const float E = __expf(cl), Einv = __builtin_amdgcn_rcpf(E), Em1 = __expf(cl - lw), WC = __expf(clC);
            const float sg = __builtin_amdgcn_rcpf(1.0f + __expf(-(a0[j] + aa[ct][j])));
            const float kp = kx[ct][j] * (1.0f + (sg - 1.0f) * kac[j]);
            const float ah = kx[ct][j] * kkc[j] * kinv;
            const float bt = ah * sg * Einv, kt = kp * Einv;
            xa[j] = -ah * Em1; xb[j] = bt; xk[j] = kt; xr[j] = rr[ct][j] * E;
            Bb[j] = bt * WC; Kb[j] = kt * WC; Wc[j] = WC;
            bon += rr[ct][j] * kp * rkc[j];
        }
        { u32x2 o; o.x = pk2(xa[0], xa[1]); o.y = pk2(xa[2], xa[3]); fa2[ct] = o; o.x = pk2(xb[0], xb[1]); o.y = pk2(xb[2], xb[3]); fb2[ct] = o;
          o.x = pk2(xk[0], xk[1]); o.y = pk2(xk[2], xk[3]); fk2[ct] = o; o.x = pk2(xr[0], xr[1]); o.y = pk2(xr[2], xr[3]); fr2[ct] = o;
          o.x = pk2(Bb[0], Bb[1]); o.y = pk2(Bb[2], Bb[3]); Bbp[ct] = o; o.x = pk2(Kb[0], Kb[1]); o.y = pk2(Kb[2], Kb[3]); Kbp[ct] = o; }
        if (tk0) *(LAS f32x4*)(sl + SL_WV + c * 4) = Wc;
        { u32x2 gw; gw.x = pk2(ag[ct][0], ag[ct][1]); gw.y = pk2(ag[ct][2], ag[ct][3]);
          *(LAS u32x2*)(sl + SL_PB + tk * 256 + c * 2) = gw; *(LAS u32x2*)(sl + SL_PB + tk * 256 + 128 + c * 2) = vvp[ct]; }
        { const unsigned aw2[2] = {fa2[ct].x, fa2[ct].y}, rw2[2] = {fr2[ct].x, fr2[ct].y};
#pragma unroll
          for (int j = 0; j < 4; ++j) { const int sh = (j & 1) * 16;
              *(LAS unsigned short*)(sl + SL_VT + (c + j) * T_STR + tk * 2) = (unsigned short)(aw2[j >> 1] >> sh);
              *(LAS unsigned short*)(sl + SL_KT + (c + j) * T_STR + tk * 2) = (unsigned short)(rw2[j >> 1] >> sh); } }
    }
    bon += __shfl_xor(bon, 16); bon += __shfl_xor(bon, 32);
    if (q == 0) *(LAS float*)(sl + SL_BON + tk * 4) = bon;
    f32x4 Mab, Mak, Mbr, Mkr;
    { u32x4 w_;
#define RW_FR(P, KS) (w_.x = P[2 * (KS)].x, w_.y = P[2 * (KS)].y, w_.z = P[2 * (KS) + 1].x, w_.w = P[2 * (KS) + 1].y, __builtin_bit_cast(bf16x8, w_))
      const bf16x8 fa0 = RW_FR(fa2, 0), fa1 = RW_FR(fa2, 1), fb0 = RW_FR(fb2, 0), fb1 = RW_FR(fb2, 1), fk0 = RW_FR(fk2, 0), fk1 = RW_FR(fk2, 1), fr0 = RW_FR(fr2, 0), fr1 = RW_FR(fr2, 1);
#undef RW_FR
      const f32x4 z = {0.f, 0.f, 0.f, 0.f};
      Mab = MFMA16(fb1, fa1, MFMA16(fb0, fa0, z)); Mak = MFMA16(fk1, fa1, MFMA16(fk0, fa0, z));
      Mbr = MFMA16(fb1, fr1, MFMA16(fb0, fr0, z)); Mkr = MFMA16(fk1, fr1, MFMA16(fk0, fr0, z)); }
#pragma unroll
    for (int j = 0; j < 4; ++j) { const int s_ = 4 * q + j; if (s_ >= tk) { Mab[j] = 0.f; Mak[j] = 0.f; } if (s_ > tk) { Mbr[j] = 0.f; Mkr[j] = 0.f; } }
    LAS float* MabL = (LAS float*)(sl + SL_AQ); LAS float* MakL = MabL + 256; LAS float* MbrL = MabL + 512; LAS float* TNL = MabL + 768;
#pragma unroll
    for (int j = 0; j < 4; ++j) { const int o_ = (4 * q + j) * 16 + tk; MabL[o_] = Mab[j]; MakL[o_] = Mak[j]; MbrL[o_] = Mbr[j]; }
    LDS_WAIT();
    float Y[16];
#pragma unroll
    for (int s_ = 15; s_ >= 0; --s_) {
        float acc = (s_ == tk) ? 1.0f : 0.0f;
        if (s_ < 15) {
            const LAS float* row = MabL + s_ * 16;
            float mrow[16];
#pragma unroll
            for (int g4 = (s_ + 1) / 4; g4 < 4; ++g4) { const f32x4 x = *(const LAS f32x4*)(row + 4 * g4); mrow[4 * g4] = x[0]; mrow[4 * g4 + 1] = x[1]; mrow[4 * g4 + 2] = x[2]; mrow[4 * g4 + 3] = x[3]; }
#pragma unroll
            for (int u = s_ + 1; u < 16; ++u) acc += Y[u] * mrow[u];
        }
        Y[s_] = acc;
    }
    if (q == 0) {
#pragma unroll
        for (int s_ = 0; s_ < 16; ++s_) TNL[s_ * 16 + tk] = Y[s_];
    }
    LDS_WAIT();
    float mbc[16];
#pragma unroll
    for (int u = 0; u < 16; ++u) mbc[u] = MbrL[u * 16 + tk];
    f32x4 Nq;
#pragma unroll
    for (int j = 0; j < 4; ++j) {
        const LAS float* row = TNL + (4 * q + j) * 16; float acc = 0.f;
#pragma unroll
        for (int g4 = 0; g4 < 4; ++g4) { const f32x4 x = *(const LAS f32x4*)(row + 4 * g4); acc += (x[0] * mbc[4 * g4] + x[1] * mbc[4 * g4 + 1]) + (x[2] * mbc[4 * g4 + 2] + x[3] * mbc[4 * g4 + 3]); }
        Nq[j] = acc;
    }
    LDS_WAIT();
#pragma unroll
    for (int j = 0; j < 4; ++j) TNL[(4 * q + j) * 16 + tk] = Nq[j];
    LDS_WAIT();
    float Nc[16];
#pragma unroll
    for (int u = 0; u < 16; ++u) Nc[u] = TNL[u * 16 + tk];
    f32x4 Gq, Hq;
#pragma unroll
    for (int j = 0; j < 4; ++j) {
        const LAS float* row = MakL + (4 * q + j) * 16; float ag_ = 0.f, ah_ = 0.f;
#pragma unroll
        for (int g4 = 0; g4 < 4; ++g4) { const f32x4 x = *(const LAS f32x4*)(row + 4 * g4);
            ag_ += (x[0] * Y[4 * g4] + x[1] * Y[4 * g4 + 1]) + (x[2] * Y[4 * g4 + 2] + x[3] * Y[4 * g4 + 3]);
            ah_ += (x[0] * Nc[4 * g4] + x[1] * Nc[4 * g4 + 1]) + (x[2] * Nc[4 * g4 + 2] + x[3] * Nc[4 * g4 + 3]); }
        Gq[j] = ag_; Hq[j] = ah_ + Mkr[j];
    }
    bf16x8 bA, bQ;
    { float xa[8], xq[8];
#pragma unroll
      for (int e = 0; e < 8; ++e) {
          xa[e] = (q == 2) ? Y[e] : ((q == 3) ? Y[8 + e] : 0.f);
          xq[e] = (q == 2) ? Nc[e] : ((q == 3) ? Nc[8 + e] : (((q << 3) + e == tk) ? 1.0f : 0.f));
      }
      bA = pack8f(xa); bQ = pack8f(xq); }
    f32x4 dA[4], dQ[4];
#pragma unroll
    for (int ct = 0; ct < 4; ++ct) {
        const int crow = 16 * ct + tk;
        const bf16x8 af = *(const LAS bf16x8*)(sl + ((q < 2) ? SL_KT : SL_VT) + crow * T_STR + (q & 1) * 16);
        const f32x4 z = {0.f, 0.f, 0.f, 0.f};
        dA[ct] = MFMA16(af, bA, z); dQ[ct] = MFMA16(af, bQ, z);
    }
    LDS_WAIT();
#pragma unroll
    for (int ct = 0; ct < 4; ++ct) {
        u32x2 o; o.x = pk2(dA[ct][0], dA[ct][1]); o.y = pk2(dA[ct][2], dA[ct][3]); *(LAS u32x2*)(sl + SL_AQ + tk * AQ_STR + (16 * ct + 4 * q) * 2) = o;
        o.x = pk2(dQ[ct][0], dQ[ct][1]); o.y = pk2(dQ[ct][2], dQ[ct][3]); *(LAS u32x2*)(sl + SL_AQ + (16 + tk) * AQ_STR + (16 * ct + 4 * q) * 2) = o;
    }
    { u32x2 o; o.x = pk2(Gq[0], Gq[1]); o.y = pk2(Gq[2], Gq[3]); *(LAS u32x2*)(sl + SL_GH + tk * GH_STR + (4 * q) * 2) = o;
      o.x = pk2(Hq[0], Hq[1]); o.y = pk2(Hq[2], Hq[3]); *(LAS u32x2*)(sl + SL_GH + (16 + tk) * GH_STR + (4 * q) * 2) = o; }
#pragma unroll
    for (int ct = 0; ct < 4; ++ct) {
        const unsigned bw[2] = {Bbp[ct].x, Bbp[ct].y}, kw[2] = {Kbp[ct].x, Kbp[ct].y};
        const unsigned vw[2] = {vvp[ct].x, vvp[ct].y};
#pragma unroll
        for (int j = 0; j < 4; ++j) {
            const int c = 16 * ct + 4 * q + j; const int sh = (j & 1) * 16;
            *(LAS unsigned short*)(sl + SL_BT + c * BT_STR + tk * 2) = (unsigned short)(bw[j >> 1] >> sh);
            *(LAS unsigned short*)(sl + SL_KT + c * T_STR + tk * 2) = (unsigned short)(kw[j >> 1] >> sh);
            *(LAS unsigned short*)(sl + SL_VT + c * T_STR + tk * 2) = (unsigned short)(vw[j >> 1] >> sh);
        }
    }
    flag_set(FLG + hw, k + 1, ln);
}
DI void rw_post_chunk(LAS unsigned char* lds, const RwSeq& sq, int m, int hw, int lane_) {
    int lane = lane_; asm volatile("" : "+v"(lane));
    LAS unsigned char* sl = lds + RW_SLOTS + hw * SLOT_BYTES;
    const int tk = lane >> 2, cq = lane & 3, c0 = 16 * cq, t = 16 * m + tk;
    const LAS float* yb = (const LAS float*)(sl + SL_AQ) + tk * 64 + c0;
    const LAS float* CV = (const LAS float*)(lds + RW_CV);
    f32x4 y[4]; float s = 0.f;
#pragma unroll
    for (int i = 0; i < 4; ++i) { y[i] = *(const LAS f32x4*)(yb + 4 * i); s += (y[i][0] + y[i][1]) + (y[i][2] + y[i][3]); }
    const float mu = quad_sum(s) * (1.f / 64.f);
    float qv = 0.f;
#pragma unroll
    for (int i = 0; i < 4; ++i) { y[i] = y[i] - mu; qv += (y[i][0] * y[i][0] + y[i][1] * y[i][1]) + (y[i][2] * y[i][2] + y[i][3] * y[i][3]); }
    const float rs = __builtin_amdgcn_rsqf(quad_sum(qv) * (1.f / 64.f) + 64e-5f);
    const float bon = *(const LAS float*)(sl + SL_BON + tk * 4);
    const LAS bf16_t* pbp = (const LAS bf16_t*)(sl + SL_PB) + tk * 128 + c0;
    float g[16], v[16];
    { float t8[8]; unpk8(*(const LAS u32x4*)pbp, t8);
#pragma unroll
      for (int j = 0; j < 8; ++j) g[j] = t8[j];
      unpk8(*(const LAS u32x4*)(pbp + 8), t8);
#pragma unroll
      for (int j = 0; j < 8; ++j) g[8 + j] = t8[j];
      unpk8(*(const LAS u32x4*)(pbp + 64), t8);
#pragma unroll
      for (int j = 0; j < 8; ++j) v[j] = t8[j];
      unpk8(*(const LAS u32x4*)(pbp + 72), t8);
#pragma unroll
      for (int j = 0; j < 8; ++j) v[8 + j] = t8[j]; }
    f32x4 o[4];
#pragma unroll
    for (int i = 0; i < 4; ++i) {
        const f32x4 lg = *(const LAS f32x4*)(CV + CV_LG * 64 + c0 + 4 * i), lb = *(const LAS f32x4*)(CV + CV_LB * 64 + c0 + 4 * i);
#pragma unroll
        for (int j = 0; j < 4; ++j) o[i][j] = ((y[i][j] * rs) * lg[j] + lb[j] + v[4 * i + j] * bon) * g[4 * i + j];
    }
    GAS bf16_t* op = sq.mix + (size_t)t * 1024 + 512 + 64 * sq.h + c0;
    *(GAS u32x4*)op = pk8(o[0], o[1]); *(GAS u32x4*)(op + 8) = pk8(o[2], o[3]);
}
DI bf16x8 pack_acc8(const f32x16& x, int s2) {
    u32x4 w;
    if (s2 == 0) { w.x = pk2(x[0], x[1]); w.y = pk2(x[2], x[3]); w.z = pk2(x[4], x[5]); w.w = pk2(x[6], x[7]); }
    else { w.x = pk2(x[8], x[9]); w.y = pk2(x[10], x[11]); w.z = pk2(x[12], x[13]); w.w = pk2(x[14], x[15]); }
    return __builtin_bit_cast(bf16x8, w);
}
DI void rwkv_phase(const Params& p, LAS unsigned char* lds, int G) {
    const int tid_ = threadIdx.x, lane = tid_ & 63, wid = __builtin_amdgcn_readfirstlane(tid_ >> 6);
    unsigned char* ws = p.ws;
    volatile LAS unsigned* FLG = (volatile LAS unsigned*)(lds + RW_FLG);
    for (int it = blockIdx.x; it < 2 * BATCH * 8; it += G) {
        const bool samp = it >= BATCH * 8;
        const int bh = samp ? it - BATCH * 8 : it, b = bh >> 3, h = bh & 7;
        RwSeq sq;
        const int row0 = samp ? MP + b * DEC_SEQ : b * SEQ;
        sq.prw = (const GAS bf16_t*)(ws + WS_PRW) + (size_t)row0 * RW_COLS;
        sq.mix = (GAS bf16_t*)(ws + WS_MIX) + (size_t)row0 * 1024;
        sq.shift0 = samp ? (const GAS float*)p.in[5] + (size_t)b * RW_COLS : nullptr;
        sq.wkv0 = samp ? (const GAS float*)p.in[4] + (size_t)bh * 4096 : nullptr;
        sq.wkv_out = (GAS float*)p.out + (samp ? O_SW : O_PW) + (size_t)bh * 4096;
        sq.ntok = samp ? DEC_SEQ : SEQ; sq.h = h;
        const int NC = sq.ntok / 16;
        __syncthreads();
        int td = tid_; asm volatile("" : "+v"(td));
        { const GAS bf16_t* W2T = (const GAS bf16_t*)(ws + WS_W2T) + (size_t)(64 * h) * 64; const GAS bf16_t* A2T = (const GAS bf16_t*)(ws + WS_A2T) + (size_t)(64 * h) * 64;
          const GAS bf16_t* G2T = (const GAS bf16_t*)(ws + WS_G2T) + (size_t)(64 * h) * 160;
          { const int row = td >> 3, ch = td & 7;
            *(LAS u32x4*)(lds + RW_LW2 + row * 144 + ch * 16) = *(const GAS u32x4*)(W2T + row * 64 + ch * 8);
            *(LAS u32x4*)(lds + RW_LA2 + row * 144 + ch * 16) = *(const GAS u32x4*)(A2T + row * 64 + ch * 8); }
          for (int i = td; i < 64 * 20; i += 512) { const int row = i / 20, ch = i % 20; *(LAS u32x4*)(lds + RW_LG2 + row * 336 + ch * 16) = *(const GAS u32x4*)(G2T + row * 160 + ch * 8); }
          LAS float* CV = (LAS float*)(lds + RW_CV);
          if (td < 64) {
              const int c = 64 * h + td;
              CV[CV_W0 * 64 + td] = ((const GAS float*)p.in[12])[c]; CV[CV_A0 * 64 + td] = ((const GAS float*)p.in[14])[c];
              CV[CV_KK * 64 + td] = ((const GAS float*)p.in[17])[c]; CV[CV_KA * 64 + td] = ((const GAS float*)p.in[18])[c];
              CV[CV_RK * 64 + td] = ((const GAS float*)p.in[19])[c]; CV[CV_LG * 64 + td] = ((const GAS float*)p.in[20])[c];
              CV[CV_LB * 64 + td] = ((const GAS float*)p.in[21])[c];
              const GAS float* mu = (const GAS float*)p.in[11];
              CV[CV_MR * 64 + td] = mu[c]; CV[CV_MK * 64 + td] = mu[512 + c]; CV[CV_MV * 64 + td] = mu[1024 + c];
          }
          if (td >= 64 && td < 64 + 288) ((LAS float*)(lds + RW_MUL))[td - 64] = ((const GAS float*)p.in[11])[1536 + td - 64];
          if (td >= 384 && td < 384 + 24) FLG[td - 384] = 0u;
        }
        __syncthreads();
        if (wid == 0) {
            int ln = lane; asm volatile("" : "+v"(ln));
            const int r = ln & 31, hh = ln >> 5;
            f32x16 St[2][2];
#pragma unroll
            for (int jt = 0; jt < 2; ++jt)
#pragma unroll
                for (int nt = 0; nt < 2; ++nt)
#pragma unroll
                    for (int g4 = 0; g4 < 4; ++g4) {
                        f32x4 x = {0.f, 0.f, 0.f, 0.f};
                        if (sq.wkv0) x = *(const GAS f32x4*)(sq.wkv0 + (size_t)(32 * nt + r) * 64 + 32 * jt + 8 * g4 + 4 * hh);
                        St[jt][nt][4 * g4] = x[0]; St[jt][nt][4 * g4 + 1] = x[1]; St[jt][nt][4 * g4 + 2] = x[2]; St[jt][nt][4 * g4 + 3] = x[3];
                    }
            for (int m = 0; m < NC; ++m) {
                const int hw = m % NHELP; const unsigned k = (unsigned)(m / NHELP);
                LAS unsigned char* sl = lds + RW_SLOTS + hw * SLOT_BYTES;
                flag_wait(FLG + hw, k + 1);
                f32x16 P1[2];
#pragma unroll
                for (int nt = 0; nt < 2; ++nt)
#pragma unroll
                    for (int i = 0; i < 16; ++i) P1[nt][i] = 0.f;
#pragma unroll
                for (int jt = 0; jt < 2; ++jt)
#pragma unroll
                    for (int s2 = 0; s2 < 2; ++s2) {
                        const LAS unsigned char* ap = sl + SL_AQ + r * AQ_STR + (32 * jt + 16 * s2 + 4 * hh) * 2;
                        const u32x2 a0 = *(const LAS u32x2*)ap, a1 = *(const LAS u32x2*)(ap + 16);
                        u32x4 aw_; aw_.x = a0.x; aw_.y = a0.y; aw_.z = a1.x; aw_.w = a1.y;
                        const bf16x8 af = __builtin_bit_cast(bf16x8, aw_);
#pragma unroll
                        for (int nt = 0; nt < 2; ++nt) P1[nt] = MFMA32(af, pack_acc8(St[jt][nt], s2), P1[nt]);
                    }
                bf16x8 vf[2];
                { const bf16x8 gf = *(const LAS bf16x8*)(sl + SL_GH + r * GH_STR + hh * 16);
#pragma unroll
                  for (int nt = 0; nt < 2; ++nt) { vf[nt] = *(const LAS bf16x8*)(sl + SL_VT + (32 * nt + r) * T_STR + hh * 16); P1[nt] = MFMA32(gf, vf[nt], P1[nt]); } }
#pragma unroll
                for (int jt = 0; jt < 2; ++jt) {
                    const LAS unsigned char* bp = sl + SL_BT + (32 * jt + r) * BT_STR + (4 * hh) * 2;
                    const u32x2 b0 = *(const LAS u32x2*)bp, b1 = *(const LAS u32x2*)(bp + 16);
                    u32x4 bw_; bw_.x = b0.x; bw_.y = b0.y; bw_.z = b1.x; bw_.w = b1.y;
                    const bf16x8 bf_ = __builtin_bit_cast(bf16x8, bw_);
                    const bf16x8 kf_ = *(const LAS bf16x8*)(sl + SL_KT + (32 * jt + r) * T_STR + hh * 16);
                    f32x4 wv[4];
#pragma unroll
                    for (int g4 = 0; g4 < 4; ++g4) wv[g4] = *(const LAS f32x4*)(sl + SL_WV + (32 * jt + 8 * g4 + 4 * hh) * 4);
#pragma unroll
                    for (int nt = 0; nt < 2; ++nt) {
                        f32x16 c_;
#pragma unroll
                        for (int i = 0; i < 16; ++i) c_[i] = St[jt][nt][i] * wv[i >> 2][i & 3];
                        c_ = MFMA32(bf_, pack_acc8(P1[nt], 0), c_);
                        St[jt][nt] = MFMA32(kf_, vf[nt], c_);
                    }
                }
                asm volatile("s_waitcnt lgkmcnt(0)" ::: "memory");
#pragma unroll
                for (int nt = 0; nt < 2; ++nt)
#pragma unroll
                    for (int i = 8; i < 16; ++i) { const int t_ = (i & 3) + 8 * ((i >> 2) & 1) + 4 * hh; *(LAS float*)(sl + SL_AQ + (t_ * 64 + 32 * nt + r) * 4) = P1[nt][i]; }
                flag_set(FLG + 8 + hw, k + 1, ln);
            }
#pragma unroll
            for (int jt = 0; jt < 2; ++jt)
#pragma unroll
                for (int nt = 0; nt < 2; ++nt)
#pragma unroll
                    for (int g4 = 0; g4 < 4; ++g4)
                        *(GAS f32x4*)(sq.wkv_out + (size_t)(32 * nt + r) * 64 + 32 * jt + 8 * g4 + 4 * hh) = (f32x4){St[jt][nt][4 * g4], St[jt][nt][4 * g4 + 1], St[jt][nt][4 * g4 + 2], St[jt][nt][4 * g4 + 3]};
        } else if (wid < 7) {
            int ln = lane; asm volatile("" : "+v"(ln));
            const int hw = wid - 1;
            unsigned k = 0;
            for (int m = hw; m < NC; m += NHELP, ++k) rw_helper_chunk(lds, sq, m, k, hw, ln);
        } else {
            int ln = lane; asm volatile("" : "+v"(ln));
            for (int m = 0; m < NC; ++m) {
                const int hw = m % NHELP; const unsigned k = (unsigned)(m / NHELP);
                flag_wait(FLG + 8 + hw, k + 1);
                rw_post_chunk(lds, sq, m, hw, ln);
                flag_set(FLG + 16 + hw, k + 1, ln);
            }
        }
    }
    __syncthreads();
}

#define XB_TMO      128
#define XB_XCNT(j)  (256  + 64 * (j))
#define XB_XSUB(j)  (1280 + 64 * (j))
#define XB_XGEN(j)  (2304 + 64 * (j))
#define XB_TOP      3328
#define XB_TOPGEN   3392
#define XCD_BAR_WORDS 3456
#define XB_SPIN_CAP (1u << 18)

__device__ __forceinline__ unsigned xb_ld(unsigned* p)              { return __hip_atomic_load(p, __ATOMIC_RELAXED, __HIP_MEMORY_SCOPE_AGENT); }
__device__ __forceinline__ unsigned xb_add(unsigned* p, unsigned v) { return __hip_atomic_fetch_add(p, v, __ATOMIC_RELAXED, __HIP_MEMORY_SCOPE_AGENT); }
__device__ __forceinline__ unsigned xb_xcc_id() { return (unsigned)__builtin_amdgcn_s_getreg((3 << 11) | 20) & 0xFu; }
#define XB_SPIN(cond, bar) do { unsigned _sp = 0; while (cond) { __builtin_amdgcn_s_sleep(1); \
    if ((++_sp & 255u) == 0u) { if (xb_ld(&(bar)[XB_TMO])) break; if (_sp > XB_SPIN_CAP) { atomicAdd(&(bar)[XB_TMO], 1u); break; } } } } while (0)

struct XcdBarrier {
    unsigned* bar; unsigned x;
    volatile LAS unsigned* st;
};

__device__ __forceinline__ XcdBarrier xcd_barrier_post(unsigned* bar, volatile LAS unsigned* st) {
    XcdBarrier b; b.bar = bar; b.x = xb_xcc_id(); b.st = st;
    if (threadIdx.x == 0) (void)xb_add(&bar[XB_XCNT(b.x)], 1u);
    return b;
}
__device__ __forceinline__ void xcd_barrier_complete(unsigned* bar, unsigned x, unsigned& nloc, unsigned& nx) {
    const unsigned G = gridDim.x * gridDim.y * gridDim.z;
    unsigned sum, cnt, mine, sp = 0u;
    for (;;) {
        sum = 0u; cnt = 0u; mine = 0u;
#pragma unroll
        for (unsigned j = 0; j < 16; ++j) { const unsigned c = xb_ld(&bar[XB_XCNT(j)]); sum += c; cnt += (c > 0u) ? 1u : 0u; mine = (j == x) ? c : mine; }
        if (sum == G) break;
        __builtin_amdgcn_s_sleep(1);
        if ((++sp & 255u) == 0u) { if (xb_ld(&bar[XB_TMO])) break; if (sp > XB_SPIN_CAP) { atomicAdd(&bar[XB_TMO], 1u); break; } }
    }
    nloc = mine > 0u ? mine : 1u; nx = cnt > 0u ? cnt : 1u;
}

__device__ __forceinline__ void xcd_barrier(const XcdBarrier& b) {
    asm volatile("s_waitcnt vmcnt(0)" ::: "memory");
    __syncthreads();
    if (threadIdx.x == 0) {
        unsigned* bar = b.bar;
        __builtin_amdgcn_s_waitcnt(0);
        unsigned nloc = b.st[0], nx = b.st[1];
        if (nloc == 0u) { xcd_barrier_complete(bar, b.x, nloc, nx); b.st[0] = nloc; b.st[1] = nx; }
        const unsigned old = xb_add(&bar[XB_XSUB(b.x)], 1u);
        const unsigned gen = old / nloc;
        if (old + 1u == (gen + 1u) * nloc) {
            __builtin_amdgcn_fence(__ATOMIC_RELEASE, "agent");
            asm volatile("s_waitcnt vmcnt(0)" ::: "memory");
            const unsigned og = xb_add(&bar[XB_TOP], 1u);
            const unsigned tg = og / nx;
            if (og + 1u == (tg + 1u) * nx) xb_add(&bar[XB_TOPGEN], 1u);
            else XB_SPIN(xb_ld(&bar[XB_TOPGEN]) == tg, bar);
            __builtin_amdgcn_fence(__ATOMIC_ACQUIRE, "agent");
            xb_add(&bar[XB_XGEN(b.x)], 1u);
            asm volatile("s_waitcnt vmcnt(0)" ::: "memory");
        } else {
            XB_SPIN(xb_ld(&bar[XB_XGEN(b.x)]) == gen, bar);
            __builtin_amdgcn_fence(__ATOMIC_ACQUIRE, "agent");
            asm volatile("s_waitcnt vmcnt(0)" ::: "memory");
        }
    }
    __syncthreads();
}

__global__ void __launch_bounds__(512, 2) fwd_kernel(Params p) {
    extern __shared__ __attribute__((aligned(16))) unsigned char lds_raw[];
    LAS unsigned char* lds = (LAS unsigned char*)lds_raw;
    const int G = gridDim.x;
    unsigned char* ws = p.ws;
    const int lo = p.ph_lo, hi = p.ph_hi;
#define IN(k) (lo <= (k) && (k) < hi)
    volatile LAS unsigned* bst = (volatile LAS unsigned*)(lds + LDS_BYTES - 16);
    if (threadIdx.x < 4) bst[threadIdx.x] = 0u;
    __syncthreads();
    const XcdBarrier bar = xcd_barrier_post((unsigned*)(ws + WS_CTL), bst);
#define SEAM(k) do { if (IN(k) && IN((k) + 1)) { xcd_barrier(bar); } } while (0)
    if (IN(0)) { phase0(p, lds, G); }
    SEAM(0);
    if (IN(1)) {
        pg8::Gemm g{(const bf16_t*)(ws + WS_H), (const bf16_t*)(ws + WS_WIN), MT, IN_PAD, 1024}; pg8::StaticOrder S; S.init(MT, IN_PAD, G, (int)blockIdx.x);
        EpiIn E{(GAS bf16_t*)(ws + WS_Q), (GAS bf16_t*)(ws + WS_K), (GAS bf16_t*)(ws + WS_V), (GAS bf16_t*)(ws + WS_PRW), (GAS float*)p.out, (const GAS float*)(ws + WS_ROPE), (const GAS float*)p.in[8], (const GAS float*)p.in[9]};
        pg8::gemm_phase<EpiIn, pg8::StaticOrder>(lds, g, S, E);
    }
    SEAM(1);
    if (IN(2)) { attn_phase(p, lds, G); rwkv_phase(p, lds, G); }
    SEAM(2);
    if (IN(3)) {
        pg8::Gemm g{(const bf16_t*)(ws + WS_MIX), (const bf16_t*)(ws + WS_WOUT), MT, 1024, 1024}; pg8::StaticOrder S; S.init(MT, 1024, G, (int)blockIdx.x);
        EpiOut E{(const GAS float*)p.in[0], (const GAS float*)p.in[1], (GAS float*)p.out, (GAS bf16_t*)(ws + WS_X1B), (GAS float*)(ws + WS_SSQ)};
        pg8::gemm_phase<EpiOut, pg8::StaticOrder>(lds, g, S, E);
    }
    SEAM(3);
    if (IN(4)) {
        pg8::Gemm g{(const bf16_t*)(ws + WS_X1B), (const bf16_t*)(ws + WS_WUP), MT, D_FF, 1024}; pg8::StaticOrder S; S.init(MT, D_FF, G, (int)blockIdx.x);
        EpiUp E{(const GAS float*)(ws + WS_SSQ), (GAS bf16_t*)(ws + WS_U)};
        pg8::gemm_phase<EpiUp, pg8::StaticOrder>(lds, g, S, E);
    }
    SEAM(4);
    if (IN(5)) {
        pg8::Gemm g{(const bf16_t*)(ws + WS_U), (const bf16_t*)(ws + WS_WDN), MT, 1024, D_FF}; pg8::StaticOrder S; S.init(MT, 1024, G, (int)blockIdx.x);
        EpiDown E{(GAS float*)p.out};
        pg8::gemm_phase<EpiDown, pg8::StaticOrder>(lds, g, S, E);
    }
#undef IN
#undef SEAM
}

extern "C" void kernel_launch(void* const* d_in, const int* in_sizes, int n_in, void* d_out, int out_size, void* d_ws, size_t ws_size, hipStream_t stream) {
    static int grid = 0;
    if (grid == 0) {
        if (n_in != 26 || ws_size < WS_END) { fprintf(stderr, "kernel_launch: expected 26 inputs and >= %zu bytes of workspace (got %d, %zu)\n", (size_t)WS_END, n_in, ws_size); grid = -1; return; }
        int dev = 0, cus = 0, per_cu = 0;
        hipGetDevice(&dev);
        hipDeviceGetAttribute(&cus, hipDeviceAttributeMultiprocessorCount, dev);
        if (hipFuncSetAttribute((const void*)fwd_kernel, hipFuncAttributeMaxDynamicSharedMemorySize, LDS_BYTES) != hipSuccess) { fprintf(stderr, "kernel_launch: hipFuncSetAttribute failed\n"); grid = -1; return; }
        if (hipOccupancyMaxActiveBlocksPerMultiprocessor(&per_cu, (const void*)fwd_kernel, 512, LDS_BYTES) != hipSuccess || per_cu < 1) { fprintf(stderr, "kernel_launch: occupancy query failed (%d)\n", per_cu); (void)hipGetLastError(); per_cu = 1; }
        grid = cus * per_cu;
        if (grid > 256) grid = 256;
    }
    if (grid < 0) return;
    Params a{};
    for (int i = 0; i < 26; ++i) a.in[i] = (const float*)d_in[i];
    a.out = (float*)d_out; a.ws = (unsigned char*)d_ws;
#if MK_N_LAUNCHES == 1
    a.ph_lo = 0; a.ph_hi = 6;
    if (hipMemsetAsync((char*)d_ws + WS_CTL, 0, CTL_BYTES, stream) != hipSuccess) { fprintf(stderr, "kernel_launch: memset of the barrier words failed\n"); return; }
    hipLaunchKernelGGL(fwd_kernel, dim3(grid), dim3(512), LDS_BYTES, stream, a);
    { const hipError_t e = hipPeekAtLastError(); if (e != hipSuccess) fprintf(stderr, "launch failed: %s (grid %d)\n", hipGetErrorString(e), grid); }
#else
    for (int ph = 0; ph < 6; ++ph) {
        a.ph_lo = ph; a.ph_hi = ph + 1;
        hipLaunchKernelGGL(fwd_kernel, dim3(grid), dim3(512), LDS_BYTES, stream, a);
    }
#endif
}
```

```cpp
#include <hip/hip_runtime.h>
#include <hip/hip_cooperative_groups.h>
#include <cstdio>
#include <cstdint>
namespace cg = cooperative_groups;

#ifndef MK_N_LAUNCHES
#define MK_N_LAUNCHES 1
#endif

#define GAS __attribute__((address_space(1)))
#define LAS __attribute__((address_space(3)))
typedef unsigned short bf16_t;
typedef short bf16x8 __attribute__((ext_vector_type(8)));
typedef short s16x4 __attribute__((ext_vector_type(4)));
typedef float f32x2 __attribute__((ext_vector_type(2)));
typedef float f32x4 __attribute__((ext_vector_type(4)));
typedef float f32x16 __attribute__((ext_vector_type(16)));
typedef unsigned u32x2 __attribute__((ext_vector_type(2)));
typedef unsigned u32x4 __attribute__((ext_vector_type(4)));
typedef __bf16 bf16v2 __attribute__((ext_vector_type(2)));
#define DI __device__ __forceinline__

constexpr int D_MODEL = 1024, SEQ = 2048, BATCH = 32, DEC_SEQ = 16;
constexpr int MP = BATCH * SEQ;
constexpr int MS = BATCH * DEC_SEQ;
constexpr int MT = MP + MS;
constexpr int IN_COLS = 2592, IN_PAD = 2816;
constexpr int RW_COLS = 1824, D_FF = 4096;
constexpr int NPOS = SEQ + DEC_SEQ;

constexpr size_t O_PK = 67633152, O_PV = 68157440, O_PW = 68681728, O_PS = 69730304, O_SK = 69788672, O_SV = 69854208, O_SW = 69919744, O_SS = 70968320;

constexpr size_t al256(size_t x) { return (x + 255) & ~(size_t)255; }
constexpr size_t WS_WIN = 0;
constexpr size_t WS_WOUT = WS_WIN + (size_t)IN_PAD * 1024 * 2;
constexpr size_t WS_WUP = WS_WOUT + (size_t)1024 * 1024 * 2;
constexpr size_t WS_WDN = WS_WUP + (size_t)4096 * 1024 * 2;
constexpr size_t WS_W2T = WS_WDN + (size_t)4096 * 1024 * 2;
constexpr size_t WS_A2T = WS_W2T + 512 * 64 * 2;
constexpr size_t WS_G2T = WS_A2T + 512 * 64 * 2;
constexpr size_t WS_ROPE = al256(WS_G2T + 512 * 160 * 2);
constexpr size_t WS_SSQ = al256(WS_ROPE + (size_t)NPOS * 64 * 4);
constexpr size_t WS_X1B = al256(WS_SSQ + (size_t)MT * 16 * 4);
constexpr size_t WS_H = al256(WS_X1B + (size_t)MT * 1024 * 2);
constexpr size_t WS_Q = WS_H + (size_t)MT * 1024 * 2;
constexpr size_t WS_K = WS_Q + (size_t)MT * 512 * 2;
constexpr size_t WS_V = WS_K + (size_t)MT * 128 * 2;
constexpr size_t WS_PRW = WS_V + (size_t)MT * 128 * 2;
constexpr size_t WS_MIX = WS_PRW + (size_t)MT * RW_COLS * 2;
constexpr size_t WS_AEND = WS_MIX + (size_t)MT * 1024 * 2;
constexpr size_t WS_U = WS_H;
static_assert(WS_U + (size_t)MT * 4096 * 2 <= WS_AEND, "U overlay");
constexpr size_t WS_CTL = al256(WS_AEND);
constexpr size_t CTL_BYTES = 16384;
constexpr int SPLIT_OUT = 4, SPLIT_DN = 16;
constexpr size_t WS_SLAB = WS_CTL + CTL_BYTES;
constexpr size_t WS_END = WS_SLAB + (size_t)SPLIT_DN * MS * 1024 * 4;
static_assert(WS_END <= (size_t)1 << 30, "workspace");

constexpr int LDS_BYTES = 163840;

DI unsigned pk2(float lo, float hi) { f32x2 v = {lo, hi}; return __builtin_bit_cast(unsigned, __builtin_convertvector(v, bf16v2)); }
DI float bf2f(unsigned short b) { return __builtin_bit_cast(float, (unsigned)b << 16); }
DI float bflo(unsigned w) { return __builtin_bit_cast(float, w << 16); }
DI float bfhi(unsigned w) { return __builtin_bit_cast(float, w & 0xffff0000u); }
DI u32x4 pk8(f32x4 a, f32x4 b) { u32x4 w; w.x = pk2(a[0], a[1]); w.y = pk2(a[2], a[3]); w.z = pk2(b[0], b[1]); w.w = pk2(b[2], b[3]); return w; }
DI float wave_sum(float v) {
#pragma unroll
    for (int o = 1; o < 64; o <<= 1) v += __shfl_xor(v, o);
    return v;
}
template <int CTRL> DI float dpp_f(float x) { return __builtin_bit_cast(float, __builtin_amdgcn_mov_dpp(__builtin_bit_cast(int, x), CTRL, 0xf, 0xf, true)); }
DI float quad_sum(float x) { x += dpp_f<0xB1>(x); x += dpp_f<0x4E>(x); return x; }
DI float oct_sum(float x) { x = quad_sum(x); x += dpp_f<0x141>(x); return x; }
#define LDS_WAIT() asm volatile("s_waitcnt lgkmcnt(0)" ::: "memory")
DI int lane_id() { int x; asm volatile("v_mbcnt_lo_u32_b32 %0, -1, 0\n\tv_mbcnt_hi_u32_b32 %0, -1, %0" : "=v"(x)); return x; }

namespace pg8 {
constexpr int BM = 256, BK = 64, HALF = 128, HTB = HALF * BK * 2, STAGE_BYTES = 8 * HTB, NXCD = 8, WGM = 8;
__host__ __device__ __forceinline__ int lds_byte(int r, int c) { const int st = (r >> 4) * 2 + (c >> 5), rr = r & 15, cc = c & 31, ob = rr * 64 + cc * 2; return st * 1024 + (ob ^ (((ob >> 9) & 1) << 5)); }
__host__ __device__ __forceinline__ void stage_rc(int b, int& R, int& C) { const int st = b / 1024, sb = b % 1024, swz = sb ^ (((sb >> 9) & 1) << 5); R = (st >> 1) * 16 + swz / 64; C = (st & 1) * 32 + (swz % 64) / 2; }
struct Unit { int pm, pn, k0, nk, slab; };
struct Gemm { const bf16_t* A; const bf16_t* Bt; int M, N, K; };
struct StaticOrder {
    int nM, nMm, nN, nwg, ntail, S, nkt, G, c;
    __host__ __device__ void init(int M, int N, int K, int G_, int c_, int Mmain = 0, int S_ = 1) {
        nM = M / BM; nN = N / BM; nkt = K / BK; G = G_; c = c_;
        nMm = Mmain ? Mmain / BM : nM; S = S_; nwg = nMm * nN; ntail = (nM - nMm) * nN * S;
    }
    __host__ __device__ bool next(int i, Unit& u) const {
        const long L = (long)i * G + c; if (L >= nwg + ntail) return false;
        const bool tail = L >= nwg;
        const int e = tail ? (int)(L - nwg) : 0;
        int wgid = tail ? 0 : (int)L; { const int q = nwg / NXCD, r = nwg % NXCD, xcd = wgid % NXCD, off = wgid / NXCD; wgid = (xcd < r ? xcd * (q + 1) : r * (q + 1) + (xcd - r) * q) + off; }
        const int nig = WGM * nN, gid = wgid / nig, fm = gid * WGM, gsz = (nMm - fm) < WGM ? (nMm - fm) : WGM;
        const int mpm = fm + ((wgid % nig) % gsz), mpn = (wgid % nig) / gsz;
        const int tsl = e % S, tnk = nkt / S;
        u.pm = tail ? nMm + e / (nN * S) : mpm; u.pn = tail ? (e / S) % nN : mpn;
        u.slab = tail ? tsl : -1; u.nk = tail ? tnk : nkt; u.k0 = tail ? tsl * tnk : 0;
        return true;
    }
};
template <class Epi, class Sched, bool ALIGN_EPI = true, bool SP2 = true>
__device__ __forceinline__ void gemm_phase(LAS unsigned char* lds, const Gemm g, const Sched& S, const Epi& E, int kwid) {
    const int lane = lane_id(), wid = kwid, tid = wid * 64 + lane, wr = wid >> 2, wc = wid & 3, fr = lane & 15, fq = lane >> 4;
    const int K = g.K;
    unsigned voffA[2];
#pragma unroll
    for (int i = 0; i < 2; ++i) { int R, C; stage_rc(tid * 16 + i * 8192, R, C); voffA[i] = (unsigned)(R * K + C) * 2u; }
    const size_t kstep = (size_t)(BK * 2);
    const size_t hstep = (size_t)HALF * K * 2;
    const size_t tstep = 2 * hstep;
    const unsigned ldsw = (unsigned)wid * 1024u;
    const int aoff = lds_byte(wr * 64 + fr, fq * 8), boff = lds_byte(wc * 32 + fr, fq * 8);
#define PG8_SA(b, h) (((b) * 2 + (h)) * HTB)
#define PG8_SB(b, h) ((4 + (b) * 2 + (h)) * HTB)
#define PG8_STAGE(bufoff, gbase, voff) do { _Pragma("unroll") for (int _i = 0; _i < 2; ++_i) \
        __builtin_amdgcn_global_load_lds((const unsigned*)((const char*)(gbase) + (voff)[_i]), (LAS unsigned*)(lds + (bufoff) + ldsw + _i * 8192), 16, 0, 0); } while (0)
#define PG8_LDA(dst, b, h) do { _Pragma("unroll") for (int m = 0; m < 4; ++m) _Pragma("unroll") for (int k = 0; k < 2; ++k) dst[m][k] = *(const LAS bf16x8*)(lds + PG8_SA(b, h) + aoff + m * 2048 + k * 1024); } while (0)
#define PG8_LDB(dst, b, h) do { _Pragma("unroll") for (int n = 0; n < 2; ++n) _Pragma("unroll") for (int k = 0; k < 2; ++k) dst[n][k] = *(const LAS bf16x8*)(lds + PG8_SB(b, h) + boff + n * 2048 + k * 1024); } while (0)
#define PG8_MMA(ai, bj, At, Bt) do { __builtin_amdgcn_s_setprio(1); _Pragma("unroll") for (int m = 0; m < 4; ++m) _Pragma("unroll") for (int n = 0; n < 2; ++n) _Pragma("unroll") for (int k = 0; k < 2; ++k) \
        acc[ai][bj][m][n] = __builtin_amdgcn_mfma_f32_16x16x32_bf16(Bt[n][k], At[m][k], acc[ai][bj][m][n], 0, 0, 0); __builtin_amdgcn_s_setprio(0); } while (0)
#define PG8_WAIT_V(n) asm volatile("s_waitcnt vmcnt(" #n ")" ::: "memory")
#define PG8_WAIT_L(n) asm volatile("s_waitcnt lgkmcnt(" #n ")" ::: "memory")
#define PG8_BAR __builtin_amdgcn_s_barrier()
#define PG8_SCHED __builtin_amdgcn_sched_barrier(0)
    Unit cur, nxt; int ui = 0;
    if (!S.next(0, cur)) return;
    f32x4 acc[2][2][4][2];
#pragma unroll
    for (int a = 0; a < 2; ++a)
#pragma unroll
        for (int b = 0; b < 2; ++b)
#pragma unroll
            for (int m = 0; m < 4; ++m)
#pragma unroll
                for (int n = 0; n < 2; ++n) acc[a][b][m][n] = (f32x4){0.f, 0.f, 0.f, 0.f};
    bf16x8 At[4][2], B0[2][2], B1[2][2];
    const char* cA = (const char*)g.A + (size_t)cur.pm * tstep + (size_t)cur.k0 * kstep; const char* cB = (const char*)g.Bt + (size_t)cur.pn * tstep + (size_t)cur.k0 * kstep;
    if constexpr (SP2) {
        PG8_STAGE(PG8_SB(0, 0), cB, voffA); PG8_STAGE(PG8_SB(0, 1), cB + hstep, voffA); PG8_STAGE(PG8_SA(0, 0), cA, voffA); PG8_STAGE(PG8_SA(0, 1), cA + hstep, voffA);
        if (wr == 1) PG8_BAR;
        PG8_WAIT_V(2); PG8_BAR;
        PG8_STAGE(PG8_SB(1, 0), cB + kstep, voffA); PG8_STAGE(PG8_SA(1, 0), cA + kstep, voffA); PG8_STAGE(PG8_SB(1, 1), cB + hstep + kstep, voffA);
        PG8_WAIT_V(6); PG8_BAR;
    } else {
        PG8_STAGE(PG8_SB(0, 0), cB, voffA); PG8_STAGE(PG8_SA(0, 0), cA, voffA); PG8_STAGE(PG8_SB(0, 1), cB + hstep, voffA); PG8_STAGE(PG8_SA(0, 1), cA + hstep, voffA);
        if (wr == 1) PG8_BAR;
        PG8_WAIT_V(4); PG8_BAR;
        PG8_STAGE(PG8_SB(1, 0), cB + kstep, voffA); PG8_STAGE(PG8_SA(1, 0), cA + kstep, voffA); PG8_STAGE(PG8_SB(1, 1), cB + hstep + kstep, voffA);
        PG8_WAIT_V(6); PG8_BAR;
    }
    for (;;) {
        const bool has_next = S.next(ui + 1, nxt);
        const char* nA = has_next ? (const char*)g.A + (size_t)nxt.pm * tstep + (size_t)nxt.k0 * kstep : cA; const char* nB = has_next ? (const char*)g.Bt + (size_t)nxt.pn * tstep + (size_t)nxt.k0 * kstep : cB;
        const int nt = cur.nk;
        for (int t = 0; t < nt; t += 2) {
            const bool last = (t == nt - 2);
            const char* a1 = cA + (size_t)(t + 1) * kstep;
            const char* a2 = last ? nA : cA + (size_t)(t + 2) * kstep; const char* b2 = last ? nB : cB + (size_t)(t + 2) * kstep;
            const char* a3 = a2 + kstep; const char* b3 = b2 + kstep;
            if constexpr (SP2) {
            PG8_LDB(B0, 0, 0); PG8_LDB(B1, 0, 1); PG8_SCHED; PG8_LDA(At, 0, 0); PG8_STAGE(PG8_SA(1, 1), a1 + hstep, voffA);
            PG8_WAIT_V(8); PG8_WAIT_L(0); PG8_BAR; PG8_MMA(0, 0, At, B0); PG8_MMA(0, 1, At, B1); PG8_BAR; PG8_SCHED;
            PG8_LDA(At, 0, 1); PG8_STAGE(PG8_SB(0, 0), b2, voffA); PG8_STAGE(PG8_SB(0, 1), b2 + hstep, voffA); PG8_STAGE(PG8_SA(0, 0), a2, voffA);
            PG8_WAIT_V(8); PG8_WAIT_L(0); PG8_BAR; PG8_MMA(1, 0, At, B0); PG8_MMA(1, 1, At, B1); PG8_BAR; PG8_SCHED;
            PG8_LDB(B0, 1, 0); PG8_LDB(B1, 1, 1); PG8_SCHED; PG8_LDA(At, 1, 0); PG8_STAGE(PG8_SA(0, 1), a2 + hstep, voffA);
            PG8_WAIT_V(8); PG8_WAIT_L(0); PG8_BAR; PG8_MMA(0, 0, At, B0); PG8_MMA(0, 1, At, B1); PG8_BAR; PG8_SCHED;
            PG8_LDA(At, 1, 1); PG8_STAGE(PG8_SB(1, 0), b3, voffA); PG8_STAGE(PG8_SB(1, 1), b3 + hstep, voffA); PG8_STAGE(PG8_SA(1, 0), a3, voffA);
            PG8_WAIT_V(8); PG8_WAIT_L(0); PG8_BAR; PG8_MMA(1, 0, At, B0); PG8_MMA(1, 1, At, B1); PG8_BAR; PG8_SCHED;
            } else {
            PG8_LDB(B0, 0, 0); PG8_SCHED; PG8_LDA(At, 0, 0); PG8_STAGE(PG8_SA(1, 1), a1 + hstep, voffA);
            PG8_WAIT_L(8); PG8_BAR; PG8_WAIT_L(0); PG8_MMA(0, 0, At, B0); PG8_BAR; PG8_SCHED;
            PG8_LDB(B1, 0, 1); PG8_STAGE(PG8_SB(0, 0), b2, voffA);
            PG8_BAR; PG8_WAIT_L(0); PG8_MMA(0, 1, At, B1); PG8_BAR;
            PG8_LDA(At, 0, 1); PG8_STAGE(PG8_SA(0, 0), a2, voffA);
            PG8_BAR; PG8_WAIT_L(0); PG8_MMA(1, 0, At, B0); PG8_BAR; PG8_SCHED;
            PG8_STAGE(PG8_SB(0, 1), b2 + hstep, voffA);
            PG8_WAIT_V(6); PG8_BAR; PG8_MMA(1, 1, At, B1); PG8_BAR;
            PG8_LDB(B0, 1, 0); PG8_SCHED; PG8_LDA(At, 1, 0); PG8_STAGE(PG8_SA(0, 1), a2 + hstep, voffA);
            PG8_WAIT_L(8); PG8_BAR; PG8_WAIT_L(0); PG8_MMA(0, 0, At, B0); PG8_BAR; PG8_SCHED;
            PG8_LDB(B1, 1, 1); PG8_STAGE(PG8_SB(1, 0), b3, voffA);
            PG8_BAR; PG8_WAIT_L(0); PG8_MMA(0, 1, At, B1); PG8_BAR;
            PG8_LDA(At, 1, 1); PG8_STAGE(PG8_SA(1, 0), a3, voffA);
            PG8_BAR; PG8_WAIT_L(0); PG8_MMA(1, 0, At, B0); PG8_BAR; PG8_SCHED;
            PG8_STAGE(PG8_SB(1, 1), b3 + hstep, voffA);
            PG8_WAIT_V(6); PG8_BAR; PG8_MMA(1, 1, At, B1); PG8_BAR;
            }
        }
        if constexpr (ALIGN_EPI) { if (wr == 0) PG8_BAR; }
        E(acc, cur, wr, wc, fr, fq);
        if (!has_next) break;
#pragma unroll
        for (int a = 0; a < 2; ++a)
#pragma unroll
            for (int b = 0; b < 2; ++b)
#pragma unroll
                for (int m = 0; m < 4; ++m)
#pragma unroll
                    for (int n = 0; n < 2; ++n) acc[a][b][m][n] = (f32x4){0.f, 0.f, 0.f, 0.f};
        cur = nxt; cA = nA; cB = nB; ++ui;
        if constexpr (ALIGN_EPI) { if (wr == 1) PG8_BAR; }
    }
    PG8_WAIT_V(0);
    if constexpr (!ALIGN_EPI) { if (wr == 0) PG8_BAR; }
    PG8_BAR;
#undef PG8_SA
#undef PG8_SB
#undef PG8_STAGE
#undef PG8_LDA
#undef PG8_LDB
#undef PG8_MMA
#undef PG8_WAIT_V
#undef PG8_WAIT_L
#undef PG8_BAR
#undef PG8_SCHED
}
}

enum { MAP_NAT = 0, MAP_A = 1, MAP_B = 2 };
DI int rowmap(int mode, int c) {
    if (mode == MAP_NAT) return c;
    if (mode == MAP_A) { const int rem = c & 31; return (c & ~31) + 16 * ((rem >> 2) & 1) + 4 * (rem >> 3) + (rem & 3); }
    const int rem = c & 255; return (c & ~255) + 128 * ((rem >> 5) & 1) + 32 * (rem >> 6) + 16 * ((rem >> 2) & 1) + 4 * ((rem >> 3) & 3) + (rem & 3);
}

struct EpiIn {
    GAS bf16_t* Q; GAS bf16_t* Kb; GAS bf16_t* Vb; GAS bf16_t* PRW; GAS float* out; const GAS float* rope; const GAS float* qg; const GAS float* kg;
    DI void operator()(const f32x4 (&acc)[2][2][4][2], const pg8::Unit& u, int wr, int wc, int fr, int fq) const {
        const int H = u.pn * 4 + wc;
        const int row0 = u.pm * 256 + wr * 64 + fr;
        if (H < 10) {
            const bool isq = H < 8;
            const GAS float* g = isq ? qg : kg;
            f32x4 gv[2][2];
#pragma unroll
            for (int bj = 0; bj < 2; ++bj)
#pragma unroll
                for (int n = 0; n < 2; ++n) gv[bj][n] = *(const GAS f32x4*)(g + 32 * bj + 8 * fq + 4 * n);
#pragma unroll
            for (int ai = 0; ai < 2; ++ai)
#pragma unroll
                for (int m = 0; m < 4; ++m) {
                    const int row = row0 + ai * 128 + m * 16;
                    float ss = 0.f;
#pragma unroll
                    for (int bj = 0; bj < 2; ++bj)
#pragma unroll
                        for (int n = 0; n < 2; ++n) { const f32x4 x = acc[ai][bj][m][n]; ss += (x[0] * x[0] + x[1] * x[1]) + (x[2] * x[2] + x[3] * x[3]); }
                    ss += __shfl_xor(ss, 16); ss += __shfl_xor(ss, 32);
                    float rinv = __builtin_amdgcn_rsqf(ss * (1.f / 64.f) + 1e-6f);
                    if (isq) rinv *= 0.125f;
                    const bool samp = row >= MP;
                    const int rs = row - MP;
                    const int b = samp ? (rs >> 4) : (row >> 11), t = samp ? (rs & 15) : (row & 2047);
                    const int pi = samp ? (SEQ + t) : t;
                    const GAS float* rp = rope + (size_t)pi * 64 + 8 * fq;
                    f32x4 o1[2], o2[2];
#pragma unroll
                    for (int n = 0; n < 2; ++n) {
                        const f32x4 c4 = *(const GAS f32x4*)(rp + 4 * n), s4 = *(const GAS f32x4*)(rp + 32 + 4 * n);
                        const f32x4 x1 = acc[ai][0][m][n] * rinv * gv[0][n], x2 = acc[ai][1][m][n] * rinv * gv[1][n];
                        o1[n] = x1 * c4 - x2 * s4; o2[n] = x2 * c4 + x1 * s4;
                    }
                    if (isq) {
                        GAS bf16_t* qp = Q + (size_t)row * 512 + 64 * H + 8 * fq;
                        *(GAS u32x4*)qp = pk8(o1[0], o1[1]); *(GAS u32x4*)(qp + 32) = pk8(o2[0], o2[1]);
                    } else {
                        const int kvh = H - 8;
                        GAS bf16_t* kp = Kb + (size_t)row * 128 + 64 * kvh + 8 * fq;
                        *(GAS u32x4*)kp = pk8(o1[0], o1[1]); *(GAS u32x4*)(kp + 32) = pk8(o2[0], o2[1]);
                        if (samp || t >= SEQ - 128) {
                            GAS float* op = samp ? out + O_SK + ((size_t)(b * 16 + t) * 2 + kvh) * 64 + 8 * fq : out + O_PK + ((size_t)(b * 128 + (t - (SEQ - 128))) * 2 + kvh) * 64 + 8 * fq;
                            *(GAS f32x4*)op = o1[0]; *(GAS f32x4*)(op + 4) = o1[1]; *(GAS f32x4*)(op + 32) = o2[0]; *(GAS f32x4*)(op + 36) = o2[1];
                        }
                    }
                }
        } else if (H < 12) {
            const int kvh = H - 10;
#pragma unroll
            for (int ai = 0; ai < 2; ++ai)
#pragma unroll
                for (int m = 0; m < 4; ++m) {
                    const int row = row0 + ai * 128 + m * 16;
                    const bool samp = row >= MP;
                    const int rs = row - MP;
                    const int b = samp ? (rs >> 4) : (row >> 11), t = samp ? (rs & 15) : (row & 2047);
                    GAS bf16_t* vp = Vb + (size_t)row * 128 + 64 * kvh + 8 * fq;
                    *(GAS u32x4*)vp = pk8(acc[ai][0][m][0], acc[ai][0][m][1]); *(GAS u32x4*)(vp + 32) = pk8(acc[ai][1][m][0], acc[ai][1][m][1]);
                    if (samp || t >= SEQ - 128) {
                        GAS float* op = samp ? out + O_SV + ((size_t)(b * 16 + t) * 2 + kvh) * 64 + 8 * fq : out + O_PV + ((size_t)(b * 128 + (t - (SEQ - 128))) * 2 + kvh) * 64 + 8 * fq;
                        *(GAS f32x4*)op = acc[ai][0][m][0]; *(GAS f32x4*)(op + 4) = acc[ai][0][m][1]; *(GAS f32x4*)(op + 32) = acc[ai][1][m][0]; *(GAS f32x4*)(op + 36) = acc[ai][1][m][1];
                    }
                }
        } else {
            const int cr0 = (H - 12) * 64 + 8 * fq;
#pragma unroll
            for (int ai = 0; ai < 2; ++ai)
#pragma unroll
                for (int m = 0; m < 4; ++m) {
                    const int row = row0 + ai * 128 + m * 16;
                    const bool samp = row >= MP;
                    const int rs = row - MP;
                    const int b = samp ? (rs >> 4) : (row >> 11), t = samp ? (rs & 15) : (row & 2047);
                    const bool lastrow = samp ? (t == DEC_SEQ - 1) : (t == SEQ - 1);
#pragma unroll
                    for (int bj = 0; bj < 2; ++bj) {
                        const int cr = cr0 + 32 * bj;
                        if (cr < RW_COLS) {
                            *(GAS u32x4*)(PRW + (size_t)row * RW_COLS + cr) = pk8(acc[ai][bj][m][0], acc[ai][bj][m][1]);
                            if (lastrow) { GAS float* op = out + (samp ? O_SS : O_PS) + (size_t)b * RW_COLS + cr; *(GAS f32x4*)op = acc[ai][bj][m][0]; *(GAS f32x4*)(op + 4) = acc[ai][bj][m][1]; }
                        }
                    }
                }
        }
    }
};
DI void store_slab(GAS float* slab, const f32x4 (&acc)[2][2][4][2], const pg8::Unit& u, int wr, int wc, int fr, int fq) {
    const int row0 = (u.pm * 256 - MP) + wr * 64 + fr, col0 = u.pn * 256 + wc * 32 + 4 * fq;
    GAS float* base = slab + (size_t)u.slab * MS * 1024;
#pragma unroll
    for (int ai = 0; ai < 2; ++ai)
#pragma unroll
        for (int m = 0; m < 4; ++m) {
            const size_t off = (size_t)(row0 + ai * 128 + m * 16) * 1024 + col0;
#pragma unroll
            for (int bj = 0; bj < 2; ++bj)
#pragma unroll
                for (int n = 0; n < 2; ++n) *(GAS f32x4*)(base + off + bj * 128 + n * 16) = acc[ai][bj][m][n];
        }
}
struct EpiOut {
    const GAS float* xp; const GAS float* xs; GAS float* out; GAS bf16_t* X1B; GAS float* SSQ; GAS float* slab;
    DI void operator()(const f32x4 (&acc)[2][2][4][2], const pg8::Unit& u, int wr, int wc, int fr, int fq) const {
        if (u.slab >= 0) { store_slab(slab, acc, u, wr, wc, fr, fq); return; }
        const int row0 = u.pm * 256 + wr * 64 + fr, col0 = u.pn * 256 + wc * 32 + 4 * fq;
        const GAS float* xin = (u.pm < 256) ? xp : xs - (size_t)MP * 1024;
#pragma unroll
        for (int ai = 0; ai < 2; ++ai)
#pragma unroll
            for (int m = 0; m < 4; ++m) {
                const int row = row0 + ai * 128 + m * 16; const size_t off = (size_t)row * 1024 + col0;
                float ss = 0.f;
#pragma unroll
                for (int bj = 0; bj < 2; ++bj)
#pragma unroll
                    for (int n = 0; n < 2; ++n) {
                        const f32x4 o = *(const GAS f32x4*)(xin + off + bj * 128 + n * 16) + acc[ai][bj][m][n];
                        *(GAS f32x4*)(out + off + bj * 128 + n * 16) = o;
                        u32x2 w; w.x = pk2(o[0], o[1]); w.y = pk2(o[2], o[3]);
                        *(GAS u32x2*)(X1B + off + bj * 128 + n * 16) = w;
                        ss += (o[0] * o[0] + o[1] * o[1]) + (o[2] * o[2] + o[3] * o[3]);
                    }
                ss += __shfl_xor(ss, 16); ss += __shfl_xor(ss, 32);
                if (fq == 0) SSQ[(size_t)row * 16 + u.pn * 4 + wc] = ss;
            }
    }
};
struct EpiUp {
    const GAS float* SSQ; GAS bf16_t* U;
    DI void operator()(const f32x4 (&acc)[2][2][4][2], const pg8::Unit& u, int wr, int wc, int fr, int fq) const {
        const int row0 = u.pm * 256 + wr * 64 + fr, col0 = u.pn * 256 + wc * 32 + 8 * fq;
#pragma unroll
        for (int ai = 0; ai < 2; ++ai)
#pragma unroll
            for (int m = 0; m < 4; ++m) {
                const int row = row0 + ai * 128 + m * 16;
                const GAS f32x4* sp = (const GAS f32x4*)(SSQ + (size_t)row * 16);
                const f32x4 a = sp[0], b = sp[1], c = sp[2], d = sp[3];
                const f32x4 t4 = (a + b) + (c + d);
                const float tot = (t4[0] + t4[1]) + (t4[2] + t4[3]);
                const float s2 = 1.0f / (tot * (1.f / 1024.f) + 1e-6f);
#pragma unroll
                for (int bj = 0; bj < 2; ++bj) {
                    f32x4 v0 = acc[ai][bj][m][0], v1 = acc[ai][bj][m][1];
#pragma unroll
                    for (int j = 0; j < 4; ++j) { const float r0 = fmaxf(v0[j], 0.f), r1 = fmaxf(v1[j], 0.f); v0[j] = r0 * r0 * s2; v1[j] = r1 * r1 * s2; }
                    *(GAS u32x4*)(U + (size_t)row * D_FF + col0 + bj * 128) = pk8(v0, v1);
                }
            }
    }
};
struct EpiDown {
    GAS float* out; GAS float* slab;
    DI void operator()(const f32x4 (&acc)[2][2][4][2], const pg8::Unit& u, int wr, int wc, int fr, int fq) const {
        if (u.slab >= 0) { store_slab(slab, acc, u, wr, wc, fr, fq); return; }
        const int row0 = u.pm * 256 + wr * 64 + fr, col0 = u.pn * 256 + wc * 32 + 4 * fq;
#pragma unroll
        for (int ai = 0; ai < 2; ++ai)
#pragma unroll
            for (int m = 0; m < 4; ++m) {
                const size_t off = (size_t)(row0 + ai * 128 + m * 16) * 1024 + col0;
#pragma unroll
                for (int bj = 0; bj < 2; ++bj)
#pragma unroll
                    for (int n = 0; n < 2; ++n) { GAS float* p = out + off + bj * 128 + n * 16; *(GAS f32x4*)p = *(const GAS f32x4*)p + acc[ai][bj][m][n]; }
            }
    }
};

DI void p0_transpose_item(const GAS float* W, int K, int N, GAS bf16_t* WT, int mode, const GAS float* kscale, LAS float* scr, int item, int lane) {
    const int nblk = N / 32, kb = item / nblk, nb = item % nblk, k0 = 64 * kb, n0 = 32 * nb;
#pragma unroll 8
    for (int i = 0; i < 32; ++i) { const int kk = 2 * i + (lane >> 5); float v = W[(size_t)(k0 + kk) * N + n0 + (lane & 31)]; if (kscale) v *= kscale[k0 + kk]; scr[kk * 33 + (lane & 31)] = v; }
    LDS_WAIT();
    const int c = lane & 7;
#pragma unroll
    for (int j = 0; j < 4; ++j) { const int n = (lane >> 3) + 8 * j; const LAS float* s = scr + (8 * c) * 33 + n;
        u32x4 o; o.x = pk2(s[0 * 33], s[1 * 33]); o.y = pk2(s[2 * 33], s[3 * 33]); o.z = pk2(s[4 * 33], s[5 * 33]); o.w = pk2(s[6 * 33], s[7 * 33]);
        *(GAS u32x4*)(WT + (size_t)rowmap(mode, n0 + n) * K + k0 + 8 * c) = o; }
    LDS_WAIT();
}
DI void sincos_d(double x, double& s, double& c) {
    const double TWO_PI = 6.283185307179586476925287;
    const double n = __builtin_rint(x * (1.0 / TWO_PI));
    const double r = x - n * TWO_PI, r2 = r * r;
    double ps = 1.0, pc = 1.0;
#pragma unroll
    for (int k = 14; k >= 1; --k) { ps = 1.0 - ps * r2 / (double)((2 * k) * (2 * k + 1)); pc = 1.0 - pc * r2 / (double)((2 * k - 1) * (2 * k)); }
    s = r * ps; c = pc;
}

struct Params { const float* in[26]; float* out; unsigned char* ws; int ph_lo, ph_hi; };

DI void phase0(const Params& p, LAS unsigned char* lds, int G, int kwid) {
    const int lane = lane_id(), wave = kwid, tid = wave * 64 + lane;
    const int gw = blockIdx.x * 8 + wave, NGW = G * 8;
    LAS float* scr = (LAS float*)(lds + wave * 8704);
    unsigned char* ws = p.ws;
    const GAS float* w_in = (const GAS float*)p.in[7]; const GAS float* w_out = (const GAS float*)p.in[22]; const GAS float* w_up = (const GAS float*)p.in[24]; const GAS float* w_dn = (const GAS float*)p.in[25];
    const GAS float* ln2 = (const GAS float*)p.in[23];
    constexpr int I_IN = 16 * (IN_COLS / 32), I_OUT = 16 * 32, I_UP = 16 * 128, I_DN = 64 * 32, NITEMS = I_IN + I_OUT + I_UP + I_DN;
    for (int it = gw; it < NITEMS; it += NGW) {
        int r = it;
        if (r < I_IN) { p0_transpose_item(w_in, 1024, IN_COLS, (GAS bf16_t*)(ws + WS_WIN), MAP_B, nullptr, scr, r, lane); continue; } r -= I_IN;
        if (r < I_OUT) { p0_transpose_item(w_out, 1024, 1024, (GAS bf16_t*)(ws + WS_WOUT), MAP_NAT, nullptr, scr, r, lane); continue; } r -= I_OUT;
        if (r < I_UP) { p0_transpose_item(w_up, 1024, 4096, (GAS bf16_t*)(ws + WS_WUP), MAP_A, ln2, scr, r, lane); continue; } r -= I_UP;
        p0_transpose_item(w_dn, 4096, 1024, (GAS bf16_t*)(ws + WS_WDN), MAP_NAT, nullptr, scr, r, lane);
    }
    const int gt = blockIdx.x * 512 + tid, NGT = G * 512;
    for (int i = gt; i < (IN_PAD - IN_COLS) * 128; i += NGT) { const int c = IN_COLS + i / 128; *(GAS u32x4*)((GAS bf16_t*)(ws + WS_WIN) + (size_t)rowmap(MAP_B, c) * 1024 + (i % 128) * 8) = (u32x4){0u, 0u, 0u, 0u}; }
    { const GAS float* w2 = (const GAS float*)p.in[13]; const GAS float* a2 = (const GAS float*)p.in[15]; const GAS float* g2 = (const GAS float*)p.in[16];
      GAS bf16_t* W2T = (GAS bf16_t*)(ws + WS_W2T); GAS bf16_t* A2T = (GAS bf16_t*)(ws + WS_A2T); GAS bf16_t* G2T = (GAS bf16_t*)(ws + WS_G2T);
      for (int i = gt; i < 512 * 32; i += NGT) { const int n = i >> 5, k2 = (i & 31) * 2;
          *(GAS unsigned*)(W2T + n * 64 + k2) = pk2(w2[k2 * 512 + n], w2[(k2 + 1) * 512 + n]);
          *(GAS unsigned*)(A2T + n * 64 + k2) = pk2(a2[k2 * 512 + n], a2[(k2 + 1) * 512 + n]); }
      for (int i = gt; i < 512 * 80; i += NGT) { const int n = i / 80, k2 = (i % 80) * 2; *(GAS unsigned*)(G2T + n * 160 + k2) = pk2(g2[k2 * 512 + n], g2[(k2 + 1) * 512 + n]); } }
    { GAS float* rope = (GAS float*)(ws + WS_ROPE);
      for (int i = gt; i < NPOS * 32; i += NGT) { const int pi = i >> 5, f = i & 31; const int pos = pi < SEQ ? pi : 4096 + (pi - SEQ);
          const float inv = (float)exp(-(double)f * (9.210340371976182736 / 32.0));
          const float ang = (float)pos * inv;
          double s, c; sincos_d((double)ang, s, c);
          rope[(size_t)pi * 64 + f] = (float)c; rope[(size_t)pi * 64 + 32 + f] = (float)s; } }
    { const GAS float* g1 = (const GAS float*)p.in[6]; GAS bf16_t* Hh = (GAS bf16_t*)(ws + WS_H);
      f32x4 gv[4];
#pragma unroll
      for (int j = 0; j < 4; ++j) gv[j] = *((const GAS f32x4*)g1 + lane + 64 * j);
      for (int m = gw; m < MT; m += NGW) {
          const GAS float* xrow = (m < MP) ? (const GAS float*)p.in[0] + (size_t)m * 1024 : (const GAS float*)p.in[1] + (size_t)(m - MP) * 1024;
          const GAS f32x4* xr = (const GAS f32x4*)xrow + lane;
          f32x4 v[4]; float s = 0.f;
#pragma unroll
          for (int j = 0; j < 4; ++j) { v[j] = xr[64 * j]; s += (v[j][0] * v[j][0] + v[j][1] * v[j][1]) + (v[j][2] * v[j][2] + v[j][3] * v[j][3]); }
          const float rinv = __builtin_amdgcn_rsqf(wave_sum(s) * (1.f / 1024.f) + 1e-6f);
          GAS u32x2* o8 = (GAS u32x2*)(Hh + (size_t)m * 1024) + lane;
#pragma unroll
          for (int j = 0; j < 4; ++j) { const f32x4 y = v[j] * rinv * gv[j]; u32x2 w; w.x = pk2(y[0], y[1]); w.y = pk2(y[2], y[3]); o8[64 * j] = w; }
      } }
}

constexpr int KS_STRIDE = 144;
constexpr int VT_STRIDE = 392;
constexpr int VT_OFF = 192 * KS_STRIDE;
#define MFMA32(a, b, c) __builtin_amdgcn_mfma_f32_32x32x16_bf16((a), (b), (c), 0, 0, 0)

DI void attn_store_kv(LAS unsigned char* lds, int row, int ch, u32x4 kv, u32x4 vv) {
    *(LAS u32x4*)(lds + row * KS_STRIDE + ch * 16) = kv;
    LAS unsigned short* vt = (LAS unsigned short*)(lds + VT_OFF + (8 * ch) * VT_STRIDE + row * 2);
    const unsigned w[4] = {vv.x, vv.y, vv.z, vv.w};
#pragma unroll
    for (int i = 0; i < 4; ++i) { vt[(2 * i) * (VT_STRIDE / 2)] = (unsigned short)(w[i] & 0xffffu); vt[(2 * i + 1) * (VT_STRIDE / 2)] = (unsigned short)(w[i] >> 16); }
}
DI void attn_wave(LAS unsigned char* lds, const GAS bf16_t* qptr  , GAS bf16_t* optr, float sink, int kt0, int nkt, bool mask_last_half, bool do_store, int lane) {
    const int r = lane & 31, h = lane >> 5;
    bf16x8 qf[4];
#pragma unroll
    for (int ks = 0; ks < 4; ++ks) qf[ks] = *(const GAS bf16x8*)(qptr + 16 * ks + 8 * h);
    f32x16 st[6];
#pragma unroll
    for (int kt = 0; kt < 6; ++kt) {
#pragma unroll
        for (int i = 0; i < 16; ++i) st[kt][i] = 0.f;
        if (kt >= kt0 && kt < nkt) {
#pragma unroll
            for (int ks = 0; ks < 4; ++ks) { const bf16x8 kf = *(const LAS bf16x8*)(lds + (32 * kt + r) * KS_STRIDE + (16 * ks + 8 * h) * 2); st[kt] = MFMA32(kf, qf[ks], st[kt]); }
        }
    }
    float mx = sink;
#pragma unroll
    for (int kt = 0; kt < 6; ++kt) if (kt >= kt0 && kt < nkt) {
#pragma unroll
        for (int i = 0; i < 16; ++i) { const bool dead = mask_last_half && kt == nkt - 1 && i >= 8; if (!dead) mx = fmaxf(mx, st[kt][i]); }
    }
    mx = fmaxf(mx, __shfl_xor(mx, 32));
    float l = 0.f;
#pragma unroll
    for (int kt = 0; kt < 6; ++kt) if (kt >= kt0 && kt < nkt) {
#pragma unroll
        for (int i = 0; i < 16; ++i) { const bool dead = mask_last_half && kt == nkt - 1 && i >= 8; const float pv = dead ? 0.f : __expf(st[kt][i] - mx); st[kt][i] = pv; l += pv; }
    }
    l += __shfl_xor(l, 32);
    const float inv = 1.0f / (l + __expf(sink - mx));
    f32x16 ot[2];
#pragma unroll
    for (int dt = 0; dt < 2; ++dt)
#pragma unroll
        for (int i = 0; i < 16; ++i) ot[dt][i] = 0.f;
#pragma unroll
    for (int kt = 0; kt < 6; ++kt) if (kt >= kt0 && kt < nkt) {
#pragma unroll
        for (int s = 0; s < 2; ++s) {
            u32x4 pw; pw.x = pk2(st[kt][8 * s], st[kt][8 * s + 1]); pw.y = pk2(st[kt][8 * s + 2], st[kt][8 * s + 3]); pw.z = pk2(st[kt][8 * s + 4], st[kt][8 * s + 5]); pw.w = pk2(st[kt][8 * s + 6], st[kt][8 * s + 7]);
            const bf16x8 pf = __builtin_bit_cast(bf16x8, pw);
#pragma unroll
            for (int dt = 0; dt < 2; ++dt) {
                const LAS unsigned char* vp = lds + VT_OFF + (32 * dt + r) * VT_STRIDE + (32 * kt + 16 * s + 4 * h) * 2;
                const u32x2 v0 = *(const LAS u32x2*)vp, v1 = *(const LAS u32x2*)(vp + 16);
                u32x4 vw; vw.x = v0.x; vw.y = v0.y; vw.z = v1.x; vw.w = v1.y;
                ot[dt] = MFMA32(__builtin_bit_cast(bf16x8, vw), pf, ot[dt]);
            }
        }
    }
    if (do_store) {
#pragma unroll
        for (int dt = 0; dt < 2; ++dt)
#pragma unroll
            for (int rg = 0; rg < 4; ++rg) {
                u32x2 w; w.x = pk2(ot[dt][4 * rg] * inv, ot[dt][4 * rg + 1] * inv); w.y = pk2(ot[dt][4 * rg + 2] * inv, ot[dt][4 * rg + 3] * inv);
                *(GAS u32x2*)(optr + 32 * dt + 8 * rg + 4 * h) = w;
            }
    }
}
DI void attn_phase(const Params& p, LAS unsigned char* lds, int G, int kwid) {
    const int lane = lane_id(), wid = kwid, tid = wid * 64 + lane;
    unsigned char* ws = p.ws;
    const GAS bf16_t* Q = (const GAS bf16_t*)(ws + WS_Q); const GAS bf16_t* Kb = (const GAS bf16_t*)(ws + WS_K); const GAS bf16_t* Vb = (const GAS bf16_t*)(ws + WS_V);
    GAS bf16_t* MIX = (GAS bf16_t*)(ws + WS_MIX);
    const GAS float* sinks = (const GAS float*)p.in[10];
    constexpr int NPI = BATCH * 32 * 2, NSI = BATCH * 2;
    for (int it = blockIdx.x; it < NPI + NSI; it += G) {
        __syncthreads();
        if (it < NPI) {
            const int g = it & 1, n = (it >> 1) & 31, b = it >> 6;
            const int kt0 = n >= 2 ? 0 : (2 - n) * 2;
            const int krow0 = b * SEQ + 64 * (n - 2);
#pragma unroll
            for (int i = 0; i < 3; ++i) {
                const int cid = tid + 512 * i, row = cid >> 3, ch = cid & 7;
                if (row >= 32 * kt0) {
                    const size_t go = (size_t)(krow0 + row) * 128 + 64 * g + 8 * ch;
                    attn_store_kv(lds, row, ch, *(const GAS u32x4*)(Kb + go), *(const GAS u32x4*)(Vb + go));
                }
            }
            __syncthreads();
            const int hq = 4 * g + (wid >> 1);
            const int qrow = b * SEQ + 64 * n + 32 * (wid & 1) + (lane & 31);
            attn_wave(lds, Q + (size_t)qrow * 512 + 64 * hq, MIX + (size_t)qrow * 1024 + 64 * hq, sinks[hq], kt0, 6, false, true, lane);
        } else {
            const int si = it - NPI, g = si & 1, b = si >> 1;
            const GAS float* ck = (const GAS float*)p.in[2]; const GAS float* cv = (const GAS float*)p.in[3];
#pragma unroll
            for (int i = 0; i < 3; ++i) {
                const int cid = tid + 512 * i, row = cid >> 3, ch = cid & 7;
                if (row < 160) {
                    u32x4 kv = {0u, 0u, 0u, 0u}, vv = {0u, 0u, 0u, 0u};
                    if (row < 128) {
                        const size_t go = ((size_t)(b * 128 + row) * 2 + g) * 64 + 8 * ch;
                        kv = pk8(*(const GAS f32x4*)(ck + go), *(const GAS f32x4*)(ck + go + 4)); vv = pk8(*(const GAS f32x4*)(cv + go), *(const GAS f32x4*)(cv + go + 4));
                    } else if (row < 144) {
                        const size_t go = (size_t)(MP + b * 16 + (row - 128)) * 128 + 64 * g + 8 * ch;
                        kv = *(const GAS u32x4*)(Kb + go); vv = *(const GAS u32x4*)(Vb + go);
                    }
                    attn_store_kv(lds, row, ch, kv, vv);
                }
            }
            __syncthreads();
            if (wid < 4) {
                const int hq = 4 * g + wid;
                const int qrow = MP + b * 16 + (lane & 15);
                attn_wave(lds, Q + (size_t)qrow * 512 + 64 * hq, MIX + (size_t)qrow * 1024 + 64 * hq, sinks[hq], 0, 5, true, (lane & 31) < 16, lane);
            }
        }
    }
    __syncthreads();
}

constexpr int NHELP = 6;
constexpr int SL_AQ = 0, AQ_STR = 136;
constexpr int SL_GH = SL_AQ + 32 * AQ_STR, GH_STR = 48;
constexpr int SL_VT = SL_GH + 32 * GH_STR, T_STR = 48;
constexpr int SL_KT = SL_VT + 64 * T_STR;
constexpr int SL_BT = SL_KT + 64 * T_STR, BT_STR = 40;
constexpr int SL_WV = SL_BT + 64 * BT_STR;
constexpr int SL_PB = SL_WV + 256;
constexpr int SL_BON = SL_PB + 16 * 128 * 2;
constexpr int SLOT_BYTES = SL_BON + 64;
constexpr int RW_SLOTS = 0;
constexpr int RW_LW2 = RW_SLOTS + NHELP * SLOT_BYTES;
constexpr int RW_LA2 = RW_LW2 + 64 * 144;
constexpr int RW_LG2 = RW_LA2 + 64 * 144;
constexpr int RW_CV = RW_LG2 + 64 * 336;
constexpr int RW_MUL = RW_CV + 10 * 64 * 4;
constexpr int RW_FLG = RW_MUL + 288 * 4;
constexpr int RW_END = RW_FLG + 3 * 8 * 4;
static_assert(RW_END <= LDS_BYTES - 16, "rwkv LDS");
enum { CV_W0 = 0, CV_A0, CV_KK, CV_KA, CV_RK, CV_LG, CV_LB, CV_MR, CV_MK, CV_MV };
#define MFMA16(a, b, c) __builtin_amdgcn_mfma_f32_16x16x32_bf16((a), (b), (c), 0, 0, 0)

struct RwSeq { const GAS bf16_t* prw; const GAS float* shift0; const GAS float* wkv0; GAS float* wkv_out; GAS bf16_t* mix; int ntok; int h; };

DI void unpk8(u32x4 w, float (&o)[8]) { o[0] = bflo(w.x); o[1] = bfhi(w.x); o[2] = bflo(w.y); o[3] = bfhi(w.y); o[4] = bflo(w.z); o[5] = bfhi(w.z); o[6] = bflo(w.w); o[7] = bfhi(w.w); }
DI unsigned dpp_shr1_u(unsigned x) { return (unsigned)__builtin_amdgcn_update_dpp(0, (int)x, 0x111, 0xf, 0xf, true); }
template <int CTRL> DI float dpp_shr_f(float x) { return __builtin_bit_cast(float, __builtin_amdgcn_update_dpp(0, __builtin_bit_cast(int, x), CTRL, 0xf, 0xf, true)); }
DI void flag_wait(volatile LAS unsigned* f, unsigned v) { unsigned sp = 0; while (*f < v) { __builtin_amdgcn_s_sleep(1); if (++sp > (1u << 24)) break; } asm volatile("" ::: "memory"); }
DI void flag_set(volatile LAS unsigned* f, unsigned v, int ln) { asm volatile("s_waitcnt vmcnt(0) lgkmcnt(0)" ::: "memory"); if (ln == 0) *f = v; }
DI bf16x8 pack8f(const float (&x)[8]) { u32x4 w; w.x = pk2(x[0], x[1]); w.y = pk2(x[2], x[3]); w.z = pk2(x[4], x[5]); w.w = pk2(x[6], x[7]); return __builtin_bit_cast(bf16x8, w); }

DI void rw_helper_chunk(LAS unsigned char* lds, const RwSeq& sq, int m, unsigned k, int hw, int ln_) {
    int ln = ln_; asm volatile("" : "+v"(ln));
    const int tk = ln & 15, q = ln >> 4, t = 16 * m + tk;
    LAS unsigned char* sl = lds + RW_SLOTS + hw * SLOT_BYTES;
    const LAS float* CV = (const LAS float*)(lds + RW_CV);
    const LAS float* MUL = (const LAS float*)(lds + RW_MUL);
    volatile LAS unsigned* FLG = (volatile LAS unsigned*)(lds + RW_FLG);
    const GAS bf16_t* prow = sq.prw + (size_t)t * RW_COLS;
    const bool tk0 = tk == 0;
    const GAS bf16_t* pprev = prow - RW_COLS;
    const bool gprev = tk0 && t > 0, sprev = tk0 && t == 0 && sq.shift0 != nullptr;
#define RW_LOAD_L(KS, CUR, BND) do { CUR = *(const GAS u32x4*)(prow + 1536 + 32 * (KS) + 8 * q); BND = (u32x4){0u, 0u, 0u, 0u}; \
        if (gprev) BND = *(const GAS u32x4*)(pprev + 1536 + 32 * (KS) + 8 * q); \
        else if (sprev) { const GAS float* sp_ = sq.shift0 + 1536 + 32 * (KS) + 8 * q; BND = pk8(*(const GAS f32x4*)sp_, *(const GAS f32x4*)(sp_ + 4)); } } while (0)
#define RW_ACT(KS, CUR, BND, OUT) do { u32x4 pw_; pw_.x = dpp_shr1_u(CUR.x); pw_.y = dpp_shr1_u(CUR.y); pw_.z = dpp_shr1_u(CUR.z); pw_.w = dpp_shr1_u(CUR.w); \
        if (tk0) pw_ = BND; float c_[8], pv_[8], xs_[8]; unpk8(CUR, c_); unpk8(pw_, pv_); \
        const f32x4 m0_ = *(const LAS f32x4*)(MUL + 32 * (KS) + 8 * q), m1_ = *(const LAS f32x4*)(MUL + 32 * (KS) + 8 * q + 4); \
        _Pragma("unroll") for (int j = 0; j < 8; ++j) { const float x_ = c_[j] + (pv_[j] - c_[j]) * (j < 4 ? m0_[j] : m1_[j - 4]); \
            if ((KS) < 2) xs_[j] = 1.0f - 2.0f * __builtin_amdgcn_rcpf(__expf(2.0f * x_) + 1.0f); else if ((KS) < 4) xs_[j] = x_; else xs_[j] = __builtin_amdgcn_rcpf(1.0f + __expf(-x_)); } \
        OUT = pack8f(xs_); } while (0)
    f32x4 aw[4], aa[4], ag[4];
    f32x4 rr[4], kx[4];
    u32x2 vvp[4];
    float ssq = 0.f;
    {
        u32x4 lraw[4], lbnd[4]; u32x2 rraw[3][4], rbnd[3][4];
#pragma unroll
        for (int ks = 0; ks < 4; ++ks) RW_LOAD_L(ks, lraw[ks], lbnd[ks]);
#pragma unroll
        for (int w = 0; w < 3; ++w)
#pragma unroll
            for (int ct = 0; ct < 4; ++ct) {
                const int col = w * 512 + 64 * sq.h + 16 * ct + 4 * q;
                rraw[w][ct] = *(const GAS u32x2*)(prow + col); rbnd[w][ct] = (u32x2){0u, 0u};
                if (gprev) rbnd[w][ct] = *(const GAS u32x2*)(pprev + col);
                else if (sprev) { const f32x4 x = *(const GAS f32x4*)(sq.shift0 + col); u32x2 o; o.x = pk2(x[0], x[1]); o.y = pk2(x[2], x[3]); rbnd[w][ct] = o; }
            }
        bf16x8 f[4];
#pragma unroll
        for (int ks = 0; ks < 4; ++ks) RW_ACT(ks, lraw[ks], lbnd[ks], f[ks]);
#pragma unroll
        for (int ct = 0; ct < 4; ++ct) {
            const int wrow = 16 * ct + tk;
            f32x4 x = {0.f, 0.f, 0.f, 0.f}, y = x;
#pragma unroll
            for (int ks = 0; ks < 2; ++ks) {
                x = MFMA16(*(const LAS bf16x8*)(lds + RW_LW2 + wrow * 144 + (32 * ks + 8 * q) * 2), f[ks], x);
                y = MFMA16(*(const LAS bf16x8*)(lds + RW_LA2 + wrow * 144 + (32 * ks + 8 * q) * 2), f[2 + ks], y);
            }
            aw[ct] = x; aa[ct] = y;
        }
#pragma unroll
        for (int ct = 0; ct < 4; ++ct) {
            const int c = 16 * ct + 4 * q;
#pragma unroll
            for (int w = 0; w < 3; ++w) {
                u32x2 pw; pw.x = dpp_shr1_u(rraw[w][ct].x); pw.y = dpp_shr1_u(rraw[w][ct].y);
                if (tk0) pw = rbnd[w][ct];
                const f32x4 cu = (f32x4){bflo(rraw[w][ct].x), bfhi(rraw[w][ct].x), bflo(rraw[w][ct].y), bfhi(rraw[w][ct].y)};
                const f32x4 pr = (f32x4){bflo(pw.x), bfhi(pw.x), bflo(pw.y), bfhi(pw.y)};
                const f32x4 mu = *(const LAS f32x4*)(CV + (CV_MR + w) * 64 + c);
                const f32x4 xs = cu + (pr - cu) * mu;
                if (w == 0) rr[ct] = xs; else if (w == 1) kx[ct] = xs; else { u32x2 o; o.x = pk2(xs[0], xs[1]); o.y = pk2(xs[2], xs[3]); vvp[ct] = o; }
            }
            const f32x4 kkr = kx[ct] * *(const LAS f32x4*)(CV + CV_KK * 64 + c);
            ssq += (kkr[0] * kkr[0] + kkr[1] * kkr[1]) + (kkr[2] * kkr[2] + kkr[3] * kkr[3]);
        }
    }
    asm volatile("" ::: "memory");
    {
        u32x4 lraw[5], lbnd[5];
#pragma unroll
        for (int ks = 0; ks < 5; ++ks) RW_LOAD_L(4 + ks, lraw[ks], lbnd[ks]);
        bf16x8 f[5];
#pragma unroll
        for (int ks = 0; ks < 5; ++ks) RW_ACT(4 + ks, lraw[ks], lbnd[ks], f[ks]);
#pragma unroll
        for (int ct = 0; ct < 4; ++ct) {
            const int wrow = 16 * ct + tk;
            f32x4 z = {0.f, 0.f, 0.f, 0.f};
#pragma unroll
            for (int ks = 0; ks < 5; ++ks) z = MFMA16(*(const LAS bf16x8*)(lds + RW_LG2 + wrow * 336 + (32 * ks + 8 * q) * 2), f[ks], z);
            ag[ct] = z;
        }
    }
#undef RW_LOAD_L
#undef RW_ACT
    ssq += __shfl_xor(ssq, 16); ssq += __shfl_xor(ssq, 32);
    const float kinv = 1.0f / fmaxf(sqrtf(ssq), 1e-12f);
    flag_wait(FLG + 16 + hw, k);
    u32x2 fa2[4], fb2[4], fk2[4], fr2[4];
    u32x2 Bbp[4], Kbp[4];
    float bon = 0.f;
#pragma unroll
    for (int ct = 0; ct < 4; ++ct) {
        const int c = 16 * ct + 4 * q;
        const f32x4 w0 = *(const LAS f32x4*)(CV + CV_W0 * 64 + c), a0 = *(const LAS f32x4*)(CV + CV_A0 * 64 + c), kkc = *(const LAS f32x4*)(CV + CV_KK * 64 + c),
                    kac = *(const LAS f32x4*)(CV + CV_KA * 64 + c), rkc = *(const LAS f32x4*)(CV + CV_RK * 64 + c);
        f32x4 Bb, Kb, Wc, xa, xb, xk, xr;
#pragma unroll
        for (int j = 0; j < 4; ++j) {
            const float z = -(w0[j] + aw[ct][j]);
            const float sp = fmaxf(z, 0.f) + __logf(1.0f + __expf(-fabsf(z)));
            const float lw = -__expf(-sp - 0.5f);
            float cl = lw;
            cl += dpp_shr_f<0x111>(cl); cl += dpp_shr_f<0x112>(cl); cl += dpp_shr_f<0x114>(cl); cl += dpp_shr_f<0x118>(cl);
            const float clC = __shfl(cl, (ln & 48) | 15);
            const float E = __expf(cl), Einv = __builtin_amdgcn_rcpf(E), Em1 = __expf(cl - lw), WC = __expf(clC);
            const float sg = __builtin_amdgcn_rcpf(1.0f + __expf(-(a0[j] + aa[ct][j])));
            const float kp = kx[ct][j] * (1.0f + (sg - 1.0f) * kac[j]);
            const float ah = kx[ct][j] * kkc[j] * kinv;
            const float bt = ah * sg * Einv, kt = kp * Einv;
            xa[j] = -ah * Em1; xb[j] = bt; xk[j] = kt; xr[j] = rr[ct][j] * E;
            Bb[j] = bt * WC; Kb[j] = kt * WC; Wc[j] = WC;
            bon += rr[ct][j] * kp * rkc[j];
        }
        { u32x2 o; o.x = pk2(xa[0], xa[1]); o.y = pk2(xa[2], xa[3]); fa2[ct] = o; o.x = pk2(xb[0], xb[1]); o.y = pk2(xb[2], xb[3]); fb2[ct] = o;
          o.x = pk2(xk[0], xk[1]); o.y = pk2(xk[2], xk[3]); fk2[ct] = o; o.x = pk2(xr[0], xr[1]); o.y = pk2(xr[2], xr[3]); fr2[ct] = o;
          o.x = pk2(Bb[0], Bb[1]); o.y = pk2(Bb[2], Bb[3]); Bbp[ct] = o; o.x = pk2(Kb[0], Kb[1]); o.y = pk2(Kb[2], Kb[3]); Kbp[ct] = o; }
        if (tk0) *(LAS f32x4*)(sl + SL_WV + c * 4) = Wc;
        { u32x2 gw; gw.x = pk2(ag[ct][0], ag[ct][1]); gw.y = pk2(ag[ct][2], ag[ct][3]);
          *(LAS u32x2*)(sl + SL_PB + tk * 256 + c * 2) = gw; *(LAS u32x2*)(sl + SL_PB + tk * 256 + 128 + c * 2) = vvp[ct]; }
        { const unsigned aw2[2] = {fa2[ct].x, fa2[ct].y}, rw2[2] = {fr2[ct].x, fr2[ct].y};
#pragma unroll
          for (int j = 0; j < 4; ++j) { const int sh = (j & 1) * 16;
              *(LAS unsigned short*)(sl + SL_VT + (c + j) * T_STR + tk * 2) = (unsigned short)(aw2[j >> 1] >> sh);
              *(LAS unsigned short*)(sl + SL_KT + (c + j) * T_STR + tk * 2) = (unsigned short)(rw2[j >> 1] >> sh); } }
    }
    bon += __shfl_xor(bon, 16); bon += __shfl_xor(bon, 32);
    if (q == 0) *(LAS float*)(sl + SL_BON + tk * 4) = bon;
    f32x4 Mab, Mak, Mbr, Mkr;
    { u32x4 w_;
#define RW_FR(P, KS) (w_.x = P[2 * (KS)].x, w_.y = P[2 * (KS)].y, w_.z = P[2 * (KS) + 1].x, w_.w = P[2 * (KS) + 1].y, __builtin_bit_cast(bf16x8, w_))
      const bf16x8 fa0 = RW_FR(fa2, 0), fa1 = RW_FR(fa2, 1), fb0 = RW_FR(fb2, 0), fb1 = RW_FR(fb2, 1), fk0 = RW_FR(fk2, 0), fk1 = RW_FR(fk2, 1), fr0 = RW_FR(fr2, 0), fr1 = RW_FR(fr2, 1);
#undef RW_FR
      const f32x4 z = {0.f, 0.f, 0.f, 0.f};
      Mab = MFMA16(fb1, fa1, MFMA16(fb0, fa0, z)); Mak = MFMA16(fk1, fa1, MFMA16(fk0, fa0, z));
      Mbr = MFMA16(fb1, fr1, MFMA16(fb0, fr0, z)); Mkr = MFMA16(fk1, fr1, MFMA16(fk0, fr0, z)); }
#pragma unroll
    for (int j = 0; j < 4; ++j) { const int s_ = 4 * q + j; if (s_ >= tk) { Mab[j] = 0.f; Mak[j] = 0.f; } if (s_ > tk) { Mbr[j] = 0.f; Mkr[j] = 0.f; } }
    LAS float* MabL = (LAS float*)(sl + SL_AQ); LAS float* MakL = MabL + 256; LAS float* MbrL = MabL + 512; LAS float* TNL = MabL + 768;
#pragma unroll
    for (int j = 0; j < 4; ++j) { const int o_ = (4 * q + j) * 16 + tk; MabL[o_] = Mab[j]; MakL[o_] = Mak[j]; MbrL[o_] = Mbr[j]; }
    LDS_WAIT();
    float Y[16];
#pragma unroll
    for (int s_ = 15; s_ >= 0; --s_) {
        float acc = (s_ == tk) ? 1.0f : 0.0f;
        if (s_ < 15) {
            const LAS float* row = MabL + s_ * 16;
            float mrow[16];
#pragma unroll
            for (int g4 = (s_ + 1) / 4; g4 < 4; ++g4) { const f32x4 x = *(const LAS f32x4*)(row + 4 * g4); mrow[4 * g4] = x[0]; mrow[4 * g4 + 1] = x[1]; mrow[4 * g4 + 2] = x[2]; mrow[4 * g4 + 3] = x[3]; }
#pragma unroll
            for (int u = s_ + 1; u < 16; ++u) acc += Y[u] * mrow[u];
        }
        Y[s_] = acc;
    }
    if (q == 0) {
#pragma unroll
        for (int s_ = 0; s_ < 16; ++s_) TNL[s_ * 16 + tk] = Y[s_];
    }
    LDS_WAIT();
    float mbc[16];
#pragma unroll
    for (int u = 0; u < 16; ++u) mbc[u] = MbrL[u * 16 + tk];
    f32x4 Nq;
#pragma unroll
    for (int j = 0; j < 4; ++j) {
        const LAS float* row = TNL + (4 * q + j) * 16; float acc = 0.f;
#pragma unroll
        for (int g4 = 0; g4 < 4; ++g4) { const f32x4 x = *(const LAS f32x4*)(row + 4 * g4); acc += (x[0] * mbc[4 * g4] + x[1] * mbc[4 * g4 + 1]) + (x[2] * mbc[4 * g4 + 2] + x[3] * mbc[4 * g4 + 3]); }
        Nq[j] = acc;
    }
    LDS_WAIT();
#pragma unroll
    for (int j = 0; j < 4; ++j) TNL[(4 * q + j) * 16 + tk] = Nq[j];
    LDS_WAIT();
    float Nc[16];
#pragma unroll
    for (int u = 0; u < 16; ++u) Nc[u] = TNL[u * 16 + tk];
    f32x4 Gq, Hq;
#pragma unroll
    for (int j = 0; j < 4; ++j) {
        const LAS float* row = MakL + (4 * q + j) * 16; float ag_ = 0.f, ah_ = 0.f;
#pragma unroll
        for (int g4 = 0; g4 < 4; ++g4) { const f32x4 x = *(const LAS f32x4*)(row + 4 * g4);
            ag_ += (x[0] * Y[4 * g4] + x[1] * Y[4 * g4 + 1]) + (x[2] * Y[4 * g4 + 2] + x[3] * Y[4 * g4 + 3]);
            ah_ += (x[0] * Nc[4 * g4] + x[1] * Nc[4 * g4 + 1]) + (x[2] * Nc[4 * g4 + 2] + x[3] * Nc[4 * g4 + 3]); }
        Gq[j] = ag_; Hq[j] = ah_ + Mkr[j];
    }
    bf16x8 bA, bQ;
    { float xa[8], xq[8];
#pragma unroll
      for (int e = 0; e < 8; ++e) {
          xa[e] = (q == 2) ? Y[e] : ((q == 3) ? Y[8 + e] : 0.f);
          xq[e] = (q == 2) ? Nc[e] : ((q == 3) ? Nc[8 + e] : (((q << 3) + e == tk) ? 1.0f : 0.f));
      }
      bA = pack8f(xa); bQ = pack8f(xq); }
    f32x4 dA[4], dQ[4];
#pragma unroll
    for (int ct = 0; ct < 4; ++ct) {
        const int crow = 16 * ct + tk;
        const bf16x8 af = *(const LAS bf16x8*)(sl + ((q < 2) ? SL_KT : SL_VT) + crow * T_STR + (q & 1) * 16);
        const f32x4 z = {0.f, 0.f, 0.f, 0.f};
        dA[ct] = MFMA16(af, bA, z); dQ[ct] = MFMA16(af, bQ, z);
    }
    LDS_WAIT();
#pragma unroll
    for (int ct = 0; ct < 4; ++ct) {
        u32x2 o; o.x = pk2(dA[ct][0], dA[ct][1]); o.y = pk2(dA[ct][2], dA[ct][3]); *(LAS u32x2*)(sl + SL_AQ + tk * AQ_STR + (16 * ct + 4 * q) * 2) = o;
        o.x = pk2(dQ[ct][0], dQ[ct][1]); o.y = pk2(dQ[ct][2], dQ[ct][3]); *(LAS u32x2*)(sl + SL_AQ + (16 + tk) * AQ_STR + (16 * ct + 4 * q) * 2) = o;
    }
    { u32x2 o; o.x = pk2(Gq[0], Gq[1]); o.y = pk2(Gq[2], Gq[3]); *(LAS u32x2*)(sl + SL_GH + tk * GH_STR + (4 * q) * 2) = o;
      o.x = pk2(Hq[0], Hq[1]); o.y = pk2(Hq[2], Hq[3]); *(LAS u32x2*)(sl + SL_GH + (16 + tk) * GH_STR + (4 * q) * 2) = o; }
#pragma unroll
    for (int ct = 0; ct < 4; ++ct) {
        const unsigned bw[2] = {Bbp[ct].x, Bbp[ct].y}, kw[2] = {Kbp[ct].x, Kbp[ct].y};
        const unsigned vw[2] = {vvp[ct].x, vvp[ct].y};
#pragma unroll
        for (int j = 0; j < 4; ++j) {
            const int c = 16 * ct + 4 * q + j; const int sh = (j & 1) * 16;
            *(LAS unsigned short*)(sl + SL_BT + c * BT_STR + tk * 2) = (unsigned short)(bw[j >> 1] >> sh);
            *(LAS unsigned short*)(sl + SL_KT + c * T_STR + tk * 2) = (unsigned short)(kw[j >> 1] >> sh);
            *(LAS unsigned short*)(sl + SL_VT + c * T_STR + tk * 2) = (unsigned short)(vw[j >> 1] >> sh);
        }
    }
    flag_set(FLG + hw, k + 1, ln);
}
DI void rw_post_chunk(LAS unsigned char* lds, const RwSeq& sq, int m, int hw, int lane_) {
    int lane = lane_; asm volatile("" : "+v"(lane));
    LAS unsigned char* sl = lds + RW_SLOTS + hw * SLOT_BYTES;
    const int tk = lane >> 2, cq = lane & 3, c0 = 16 * cq, t = 16 * m + tk;
    const LAS float* yb = (const LAS float*)(sl + SL_AQ) + tk * 64 + c0;
    const LAS float* CV = (const LAS float*)(lds + RW_CV);
    f32x4 y[4]; float s = 0.f;
#pragma unroll
    for (int i = 0; i < 4; ++i) { y[i] = *(const LAS f32x4*)(yb + 4 * i); s += (y[i][0] + y[i][1]) + (y[i][2] + y[i][3]); }
    const float mu = quad_sum(s) * (1.f / 64.f);
    float qv = 0.f;
#pragma unroll
    for (int i = 0; i < 4; ++i) { y[i] = y[i] - mu; qv += (y[i][0] * y[i][0] + y[i][1] * y[i][1]) + (y[i][2] * y[i][2] + y[i][3] * y[i][3]); }
    const float rs = __builtin_amdgcn_rsqf(quad_sum(qv) * (1.f / 64.f) + 64e-5f);
    const float bon = *(const LAS float*)(sl + SL_BON + tk * 4);
    const LAS bf16_t* pbp = (const LAS bf16_t*)(sl + SL_PB) + tk * 128 + c0;
    float g[16], v[16];
    { float t8[8]; unpk8(*(const LAS u32x4*)pbp, t8);
#pragma unroll
      for (int j = 0; j < 8; ++j) g[j] = t8[j];
      unpk8(*(const LAS u32x4*)(pbp + 8), t8);
#pragma unroll
      for (int j = 0; j < 8; ++j) g[8 + j] = t8[j];
      unpk8(*(const LAS u32x4*)(pbp + 64), t8);
#pragma unroll
      for (int j = 0; j < 8; ++j) v[j] = t8[j];
      unpk8(*(const LAS u32x4*)(pbp + 72), t8);
#pragma unroll
      for (int j = 0; j < 8; ++j) v[8 + j] = t8[j]; }
    f32x4 o[4];
#pragma unroll
    for (int i = 0; i < 4; ++i) {
        const f32x4 lg = *(const LAS f32x4*)(CV + CV_LG * 64 + c0 + 4 * i), lb = *(const LAS f32x4*)(CV + CV_LB * 64 + c0 + 4 * i);
#pragma unroll
        for (int j = 0; j < 4; ++j) o[i][j] = ((y[i][j] * rs) * lg[j] + lb[j] + v[4 * i + j] * bon) * g[4 * i + j];
    }
    GAS bf16_t* op = sq.mix + (size_t)t * 1024 + 512 + 64 * sq.h + c0;
    *(GAS u32x4*)op = pk8(o[0], o[1]); *(GAS u32x4*)(op + 8) = pk8(o[2], o[3]);
}
DI bf16x8 pack_acc8(const f32x16& x, int s2) {
    u32x4 w;
    if (s2 == 0) { w.x = pk2(x[0], x[1]); w.y = pk2(x[2], x[3]); w.z = pk2(x[4], x[5]); w.w = pk2(x[6], x[7]); }
    else { w.x = pk2(x[8], x[9]); w.y = pk2(x[10], x[11]); w.z = pk2(x[12], x[13]); w.w = pk2(x[14], x[15]); }
    return __builtin_bit_cast(bf16x8, w);
}
DI void rwkv_phase(const Params& p, LAS unsigned char* lds, int G, int kwid) {
    const int wid = kwid;
    unsigned char* ws = p.ws;
    volatile LAS unsigned* FLG = (volatile LAS unsigned*)(lds + RW_FLG);
    for (int it = blockIdx.x; it < 2 * BATCH * 8; it += G) {
        const bool samp = it >= BATCH * 8;
        const int bh = samp ? it - BATCH * 8 : it, b = bh >> 3, h = bh & 7;
        RwSeq sq;
        const int row0 = samp ? MP + b * DEC_SEQ : b * SEQ;
        sq.prw = (const GAS bf16_t*)(ws + WS_PRW) + (size_t)row0 * RW_COLS;
        sq.mix = (GAS bf16_t*)(ws + WS_MIX) + (size_t)row0 * 1024;
        sq.shift0 = samp ? (const GAS float*)p.in[5] + (size_t)b * RW_COLS : nullptr;
        sq.wkv0 = samp ? (const GAS float*)p.in[4] + (size_t)bh * 4096 : nullptr;
        sq.wkv_out = (GAS float*)p.out + (samp ? O_SW : O_PW) + (size_t)bh * 4096;
        sq.ntok = samp ? DEC_SEQ : SEQ; sq.h = h;
        const int NC = sq.ntok / 16;
        __syncthreads();
        int td = wid * 64 + lane_id(); asm volatile("" : "+v"(td));
        { const GAS bf16_t* W2T = (const GAS bf16_t*)(ws + WS_W2T) + (size_t)(64 * h) * 64; const GAS bf16_t* A2T = (const GAS bf16_t*)(ws + WS_A2T) + (size_t)(64 * h) * 64;
          const GAS bf16_t* G2T = (const GAS bf16_t*)(ws + WS_G2T) + (size_t)(64 * h) * 160;
          { const int row = td >> 3, ch = td & 7;
            *(LAS u32x4*)(lds + RW_LW2 + row * 144 + ch * 16) = *(const GAS u32x4*)(W2T + row * 64 + ch * 8);
            *(LAS u32x4*)(lds + RW_LA2 + row * 144 + ch * 16) = *(const GAS u32x4*)(A2T + row * 64 + ch * 8); }
          for (int i = td; i < 64 * 20; i += 512) { const int row = i / 20, ch = i % 20; *(LAS u32x4*)(lds + RW_LG2 + row * 336 + ch * 16) = *(const GAS u32x4*)(G2T + row * 160 + ch * 8); }
          LAS float* CV = (LAS float*)(lds + RW_CV);
          if (td < 64) {
              const int c = 64 * h + td;
              CV[CV_W0 * 64 + td] = ((const GAS float*)p.in[12])[c]; CV[CV_A0 * 64 + td] = ((const GAS float*)p.in[14])[c];
              CV[CV_KK * 64 + td] = ((const GAS float*)p.in[17])[c]; CV[CV_KA * 64 + td] = ((const GAS float*)p.in[18])[c];
              CV[CV_RK * 64 + td] = ((const GAS float*)p.in[19])[c]; CV[CV_LG * 64 + td] = ((const GAS float*)p.in[20])[c];
              CV[CV_LB * 64 + td] = ((const GAS float*)p.in[21])[c];
              const GAS float* mu = (const GAS float*)p.in[11];
              CV[CV_MR * 64 + td] = mu[c]; CV[CV_MK * 64 + td] = mu[512 + c]; CV[CV_MV * 64 + td] = mu[1024 + c];
          }
          if (td >= 64 && td < 64 + 288) ((LAS float*)(lds + RW_MUL))[td - 64] = ((const GAS float*)p.in[11])[1536 + td - 64];
          if (td >= 384 && td < 384 + 24) FLG[td - 384] = 0u;
        }
        __syncthreads();
        if (wid == 0) {
            __builtin_amdgcn_s_setprio(3);
            int ln = lane_id(); asm volatile("" : "+v"(ln));
            const int r = ln & 31, hh = ln >> 5;
            f32x16 St[2][2];
#pragma unroll
            for (int jt = 0; jt < 2; ++jt)
#pragma unroll
                for (int nt = 0; nt < 2; ++nt)
#pragma unroll
                    for (int g4 = 0; g4 < 4; ++g4) {
                        f32x4 x = {0.f, 0.f, 0.f, 0.f};
                        if (sq.wkv0) x = *(const GAS f32x4*)(sq.wkv0 + (size_t)(32 * nt + r) * 64 + 32 * jt + 8 * g4 + 4 * hh);
                        St[jt][nt][4 * g4] = x[0]; St[jt][nt][4 * g4 + 1] = x[1]; St[jt][nt][4 * g4 + 2] = x[2]; St[jt][nt][4 * g4 + 3] = x[3];
                    }
            for (int m = 0; m < NC; ++m) {
                const int hw = m % NHELP; const unsigned k = (unsigned)(m / NHELP);
                LAS unsigned char* sl = lds + RW_SLOTS + hw * SLOT_BYTES;
                flag_wait(FLG + hw, k + 1);
                f32x16 P1[2];
#pragma unroll
                for (int nt = 0; nt < 2; ++nt)
#pragma unroll
                    for (int i = 0; i < 16; ++i) P1[nt][i] = 0.f;
#pragma unroll
                for (int jt = 0; jt < 2; ++jt)
#pragma unroll
                    for (int s2 = 0; s2 < 2; ++s2) {
                        const LAS unsigned char* ap = sl + SL_AQ + r * AQ_STR + (32 * jt + 16 * s2 + 4 * hh) * 2;
                        const u32x2 a0 = *(const LAS u32x2*)ap, a1 = *(const LAS u32x2*)(ap + 16);
                        u32x4 aw_; aw_.x = a0.x; aw_.y = a0.y; aw_.z = a1.x; aw_.w = a1.y;
                        const bf16x8 af = __builtin_bit_cast(bf16x8, aw_);
#pragma unroll
                        for (int nt = 0; nt < 2; ++nt) P1[nt] = MFMA32(af, pack_acc8(St[jt][nt], s2), P1[nt]);
                    }
                bf16x8 vf[2];
                { const bf16x8 gf = *(const LAS bf16x8*)(sl + SL_GH + r * GH_STR + hh * 16);
#pragma unroll
                  for (int nt = 0; nt < 2; ++nt) { vf[nt] = *(const LAS bf16x8*)(sl + SL_VT + (32 * nt + r) * T_STR + hh * 16); P1[nt] = MFMA32(gf, vf[nt], P1[nt]); } }
#pragma unroll
                for (int jt = 0; jt < 2; ++jt) {
                    const LAS unsigned char* bp = sl + SL_BT + (32 * jt + r) * BT_STR + (4 * hh) * 2;
                    const u32x2 b0 = *(const LAS u32x2*)bp, b1 = *(const LAS u32x2*)(bp + 16);
                    u32x4 bw_; bw_.x = b0.x; bw_.y = b0.y; bw_.z = b1.x; bw_.w = b1.y;
                    const bf16x8 bf_ = __builtin_bit_cast(bf16x8, bw_);
                    const bf16x8 kf_ = *(const LAS bf16x8*)(sl + SL_KT + (32 * jt + r) * T_STR + hh * 16);
                    f32x4 wv[4];
#pragma unroll
                    for (int g4 = 0; g4 < 4; ++g4) wv[g4] = *(const LAS f32x4*)(sl + SL_WV + (32 * jt + 8 * g4 + 4 * hh) * 4);
#pragma unroll
                    for (int nt = 0; nt < 2; ++nt) {
                        f32x16 c_;
#pragma unroll
                        for (int i = 0; i < 16; ++i) c_[i] = St[jt][nt][i] * wv[i >> 2][i & 3];
                        c_ = MFMA32(bf_, pack_acc8(P1[nt], 0), c_);
                        St[jt][nt] = MFMA32(kf_, vf[nt], c_);
                    }
                }
                asm volatile("s_waitcnt lgkmcnt(0)" ::: "memory");
#pragma unroll
                for (int nt = 0; nt < 2; ++nt)
#pragma unroll
                    for (int i = 8; i < 16; ++i) { const int t_ = (i & 3) + 8 * ((i >> 2) & 1) + 4 * hh; *(LAS float*)(sl + SL_AQ + (t_ * 64 + 32 * nt + r) * 4) = P1[nt][i]; }
                flag_set(FLG + 8 + hw, k + 1, ln);
            }
#pragma unroll
            for (int jt = 0; jt < 2; ++jt)
#pragma unroll
                for (int nt = 0; nt < 2; ++nt)
#pragma unroll
                    for (int g4 = 0; g4 < 4; ++g4)
                        *(GAS f32x4*)(sq.wkv_out + (size_t)(32 * nt + r) * 64 + 32 * jt + 8 * g4 + 4 * hh) = (f32x4){St[jt][nt][4 * g4], St[jt][nt][4 * g4 + 1], St[jt][nt][4 * g4 + 2], St[jt][nt][4 * g4 + 3]};
            __builtin_amdgcn_s_setprio(0);
        } else if (wid != 4) {
            int ln = lane_id(); asm volatile("" : "+v"(ln));
            const int hw = wid < 4 ? wid - 1 : wid - 2;
            unsigned k = 0;
            for (int m = hw; m < NC; m += NHELP, ++k) rw_helper_chunk(lds, sq, m, k, hw, ln);
        } else {
            int ln = lane_id(); asm volatile("" : "+v"(ln));
            for (int m = 0; m < NC; ++m) {
                const int hw = m % NHELP; const unsigned k = (unsigned)(m / NHELP);
                flag_wait(FLG + 8 + hw, k + 1);
                rw_post_chunk(lds, sq, m, hw, ln);
                flag_set(FLG + 16 + hw, k + 1, ln);
            }
        }
    }
    __syncthreads();
}

#define XB_TMO      128
#define XB_XCNT(j)  (256  + 64 * (j))
#define XB_XSUB(j)  (1280 + 64 * (j))
#define XB_XGEN(j)  (2304 + 64 * (j))
#define XB_TOP      3328
#define XB_TOPGEN   3392
#define XCD_BAR_WORDS 3456
#define XB_SPIN_CAP (1u << 18)

__device__ __forceinline__ unsigned xb_ld(unsigned* p)              { return __hip_atomic_load(p, __ATOMIC_RELAXED, __HIP_MEMORY_SCOPE_AGENT); }
__device__ __forceinline__ unsigned xb_add(unsigned* p, unsigned v) { return __hip_atomic_fetch_add(p, v, __ATOMIC_RELAXED, __HIP_MEMORY_SCOPE_AGENT); }
__device__ __forceinline__ unsigned xb_xcc_id() { return (unsigned)__builtin_amdgcn_s_getreg((3 << 11) | 20) & 0xFu; }
#define XB_SPIN(cond, bar) do { unsigned _sp = 0; while (cond) { __builtin_amdgcn_s_sleep(1); \
    if ((++_sp & 255u) == 0u) { if (xb_ld(&(bar)[XB_TMO])) break; if (_sp > XB_SPIN_CAP) { atomicAdd(&(bar)[XB_TMO], 1u); break; } } } } while (0)

struct XcdBarrier {
    int wid;
    unsigned* bar; unsigned x;
    volatile LAS unsigned* st;
};

__device__ __forceinline__ XcdBarrier xcd_barrier_post(unsigned* bar, volatile LAS unsigned* st, int kwid) {
    XcdBarrier b; b.wid = kwid; b.bar = bar; b.x = xb_xcc_id(); b.st = st;
    if (kwid == 0 && lane_id() == 0) (void)xb_add(&bar[XB_XCNT(b.x)], 1u);
    return b;
}
__device__ __forceinline__ void xcd_barrier_complete(unsigned* bar, unsigned x, unsigned& nloc, unsigned& nx) {
    const unsigned G = gridDim.x * gridDim.y * gridDim.z;
    unsigned sum, cnt, mine, sp = 0u;
    for (;;) {
        sum = 0u; cnt = 0u; mine = 0u;
#pragma unroll
        for (unsigned j = 0; j < 16; ++j) { const unsigned c = xb_ld(&bar[XB_XCNT(j)]); sum += c; cnt += (c > 0u) ? 1u : 0u; mine = (j == x) ? c : mine; }
        if (sum == G) break;
        __builtin_amdgcn_s_sleep(1);
        if ((++sp & 255u) == 0u) { if (xb_ld(&bar[XB_TMO])) break; if (sp > XB_SPIN_CAP) { atomicAdd(&bar[XB_TMO], 1u); break; } }
    }
    nloc = mine > 0u ? mine : 1u; nx = cnt > 0u ? cnt : 1u;
}

__device__ __forceinline__ void xcd_barrier(const XcdBarrier& b) {
    asm volatile("s_waitcnt vmcnt(0)" ::: "memory");
    __syncthreads();
    if (b.wid == 0 && lane_id() == 0) {
        unsigned* bar = b.bar;
        __builtin_amdgcn_s_waitcnt(0);
        unsigned nloc = b.st[0], nx = b.st[1];
        if (nloc == 0u) { xcd_barrier_complete(bar, b.x, nloc, nx); b.st[0] = nloc; b.st[1] = nx; }
        const unsigned old = xb_add(&bar[XB_XSUB(b.x)], 1u);
        const unsigned gen = old / nloc;
        if (old + 1u == (gen + 1u) * nloc) {
            __builtin_amdgcn_fence(__ATOMIC_RELEASE, "agent");
            asm volatile("s_waitcnt vmcnt(0)" ::: "memory");
            const unsigned og = xb_add(&bar[XB_TOP], 1u);
            const unsigned tg = og / nx;
            if (og + 1u == (tg + 1u) * nx) xb_add(&bar[XB_TOPGEN], 1u);
            else XB_SPIN(xb_ld(&bar[XB_TOPGEN]) == tg, bar);
            __builtin_amdgcn_fence(__ATOMIC_ACQUIRE, "agent");
            xb_add(&bar[XB_XGEN(b.x)], 1u);
            asm volatile("s_waitcnt vmcnt(0)" ::: "memory");
        } else {
            XB_SPIN(xb_ld(&bar[XB_XGEN(b.x)]) == gen, bar);
            __builtin_amdgcn_fence(__ATOMIC_ACQUIRE, "agent");
            asm volatile("s_waitcnt vmcnt(0)" ::: "memory");
        }
    }
    __syncthreads();
}

DI void finish_out(const Params& p, int G, int kwid) {
    const int lane = lane_id(), gw = blockIdx.x * 8 + kwid, NGW = G * 8;
    const GAS float* slab = (const GAS float*)(p.ws + WS_SLAB); const GAS float* xs = (const GAS float*)p.in[1];
    GAS float* out = (GAS float*)p.out; GAS bf16_t* X1B = (GAS bf16_t*)(p.ws + WS_X1B); GAS float* SSQ = (GAS float*)(p.ws + WS_SSQ);
    for (int r = gw; r < MS; r += NGW) {
        float ss = 0.f;
#pragma unroll
        for (int j = 0; j < 4; ++j) {
            const size_t o = (size_t)r * 1024 + 4 * lane + 256 * j;
            f32x4 v = *(const GAS f32x4*)(xs + o);
#pragma unroll
            for (int sp = 0; sp < SPLIT_OUT; ++sp) v += *(const GAS f32x4*)(slab + (size_t)sp * MS * 1024 + o);
            *(GAS f32x4*)(out + (size_t)MP * 1024 + o) = v;
            u32x2 w; w.x = pk2(v[0], v[1]); w.y = pk2(v[2], v[3]); *(GAS u32x2*)(X1B + (size_t)MP * 1024 + o) = w;
            ss += (v[0] * v[0] + v[1] * v[1]) + (v[2] * v[2] + v[3] * v[3]);
        }
        ss = wave_sum(ss);
        if (lane < 16) SSQ[(size_t)(MP + r) * 16 + lane] = lane == 0 ? ss : 0.f;
    }
}
DI void finish_down(const Params& p, int G, int kwid) {
    const GAS float* slab = (const GAS float*)(p.ws + WS_SLAB); GAS float* out = (GAS float*)p.out + (size_t)MP * 1024;
    for (int i = blockIdx.x * 512 + kwid * 64 + lane_id(); i < MS * 256; i += G * 512) {
        f32x4 v = *(const GAS f32x4*)(out + (size_t)i * 4);
#pragma unroll
        for (int sp = 0; sp < SPLIT_DN; ++sp) v += *(const GAS f32x4*)(slab + (size_t)sp * MS * 1024 + (size_t)i * 4);
        *(GAS f32x4*)(out + (size_t)i * 4) = v;
    }
}

__global__ void __launch_bounds__(512, 2) fwd_kernel(Params p) {
    extern __shared__ __attribute__((aligned(16))) unsigned char lds_raw[];
    LAS unsigned char* lds = (LAS unsigned char*)lds_raw;
    const int G = gridDim.x;
    unsigned char* ws = p.ws;
    const int lo = p.ph_lo, hi = p.ph_hi;
#define IN(k) (lo <= (k) && (k) < hi)
    const int kwid = __builtin_amdgcn_readfirstlane((int)(threadIdx.x >> 6));
    volatile LAS unsigned* bst = (volatile LAS unsigned*)(lds + LDS_BYTES - 16);
    if (threadIdx.x < 4) bst[threadIdx.x] = 0u;
    __syncthreads();
    const XcdBarrier bar = xcd_barrier_post((unsigned*)(ws + WS_CTL), bst, kwid);
#define SEAM(k) do { if (IN(k) && IN((k) + 1)) { xcd_barrier(bar); } } while (0)
    if (IN(0)) { phase0(p, lds, G, kwid); }
    SEAM(0);
    if (IN(1)) {
        pg8::Gemm g{(const bf16_t*)(ws + WS_H), (const bf16_t*)(ws + WS_WIN), MT, IN_PAD, 1024}; pg8::StaticOrder S; S.init(MT, IN_PAD, 1024, G, (int)blockIdx.x);
        EpiIn E{(GAS bf16_t*)(ws + WS_Q), (GAS bf16_t*)(ws + WS_K), (GAS bf16_t*)(ws + WS_V), (GAS bf16_t*)(ws + WS_PRW), (GAS float*)p.out, (const GAS float*)(ws + WS_ROPE), (const GAS float*)p.in[8], (const GAS float*)p.in[9]};
        pg8::gemm_phase<EpiIn, pg8::StaticOrder>(lds, g, S, E, kwid);
    }
    SEAM(1);
    if (IN(2)) { attn_phase(p, lds, G, kwid); rwkv_phase(p, lds, G, kwid); }
    SEAM(2);
    if (IN(3)) {
        pg8::Gemm g{(const bf16_t*)(ws + WS_MIX), (const bf16_t*)(ws + WS_WOUT), MT, 1024, 1024}; pg8::StaticOrder S; S.init(MT, 1024, 1024, G, (int)blockIdx.x, MP, SPLIT_OUT);
        EpiOut E{(const GAS float*)p.in[0], (const GAS float*)p.in[1], (GAS float*)p.out, (GAS bf16_t*)(ws + WS_X1B), (GAS float*)(ws + WS_SSQ), (GAS float*)(ws + WS_SLAB)};
        pg8::gemm_phase<EpiOut, pg8::StaticOrder>(lds, g, S, E, kwid);
        xcd_barrier(bar);
        finish_out(p, G, kwid);
    }
    SEAM(3);
    if (IN(4)) {
        pg8::Gemm g{(const bf16_t*)(ws + WS_X1B), (const bf16_t*)(ws + WS_WUP), MT, D_FF, 1024}; pg8::StaticOrder S; S.init(MT, D_FF, 1024, G, (int)blockIdx.x);
        EpiUp E{(const GAS float*)(ws + WS_SSQ), (GAS bf16_t*)(ws + WS_U)};
        pg8::gemm_phase<EpiUp, pg8::StaticOrder>(lds, g, S, E, kwid);
    }
    SEAM(4);
    if (IN(5)) {
        pg8::Gemm g{(const bf16_t*)(ws + WS_U), (const bf16_t*)(ws + WS_WDN), MT, 1024, D_FF}; pg8::StaticOrder S; S.init(MT, 1024, D_FF, G, (int)blockIdx.x, MP, SPLIT_DN);
        EpiDown E{(GAS float*)p.out, (GAS float*)(ws + WS_SLAB)};
        pg8::gemm_phase<EpiDown, pg8::StaticOrder>(lds, g, S, E, kwid);
        xcd_barrier(bar);
        finish_down(p, G, kwid);
    }
#undef IN
#undef SEAM
}

extern "C" void kernel_launch(void* const* d_in, const int* in_sizes, int n_in, void* d_out, int out_size, void* d_ws, size_t ws_size, hipStream_t stream) {
    static int grid = 0;
    if (grid == 0) {
        if (n_in != 26 || ws_size < WS_END) { fprintf(stderr, "kernel_launch: expected 26 inputs and >= %zu bytes of workspace (got %d, %zu)\n", (size_t)WS_END, n_in, ws_size); grid = -1; return; }
        int dev = 0, cus = 0, per_cu = 0;
        hipGetDevice(&dev);
        hipDeviceGetAttribute(&cus, hipDeviceAttributeMultiprocessorCount, dev);
        if (hipFuncSetAttribute((const void*)fwd_kernel, hipFuncAttributeMaxDynamicSharedMemorySize, LDS_BYTES) != hipSuccess) { fprintf(stderr, "kernel_launch: hipFuncSetAttribute failed\n"); grid = -1; return; }
        if (hipOccupancyMaxActiveBlocksPerMultiprocessor(&per_cu, (const void*)fwd_kernel, 512, LDS_BYTES) != hipSuccess || per_cu < 1) { fprintf(stderr, "kernel_launch: occupancy query failed (%d)\n", per_cu); (void)hipGetLastError(); per_cu = 1; }
        grid = cus * per_cu;
        if (grid > 256) grid = 256;
    }
    if (grid < 0) return;
    Params a{};
    for (int i = 0; i < 26; ++i) a.in[i] = (const float*)d_in[i];
    a.out = (float*)d_out; a.ws = (unsigned char*)d_ws;
#if MK_N_LAUNCHES == 1
    a.ph_lo = 0; a.ph_hi = 6;
    if (hipMemsetAsync((char*)d_ws + WS_CTL, 0, CTL_BYTES, stream) != hipSuccess) { fprintf(stderr, "kernel_launch: memset of the barrier words failed\n"); return; }
    hipLaunchKernelGGL(fwd_kernel, dim3(grid), dim3(512), LDS_BYTES, stream, a);
    { const hipError_t e = hipPeekAtLastError(); if (e != hipSuccess) fprintf(stderr, "launch failed: %s (grid %d)\n", hipGetErrorString(e), grid); }
#else
    for (int ph = 0; ph < 6; ++ph) {
        a.ph_lo = ph; a.ph_hi = ph + 1;
        hipLaunchKernelGGL(fwd_kernel, dim3(grid), dim3(512), LDS_BYTES, stream, a);
    }
#endif
}
```

```cpp
#include <hip/hip_runtime.h>
#include <hip/hip_cooperative_groups.h>
#include <cstdio>
#include <cstdint>
namespace cg = cooperative_groups;

#ifndef MK_N_LAUNCHES
#define MK_N_LAUNCHES 1
#endif

#define GAS __attribute__((address_space(1)))
#define LAS __attribute__((address_space(3)))
typedef unsigned short bf16_t;
typedef short bf16x8 __attribute__((ext_vector_type(8)));
typedef short s16x4 __attribute__((ext_vector_type(4)));
typedef float f32x2 __attribute__((ext_vector_type(2)));
typedef float f32x4 __attribute__((ext_vector_type(4)));
typedef float f32x16 __attribute__((ext_vector_type(16)));
typedef unsigned u32x2 __attribute__((ext_vector_type(2)));
typedef unsigned u32x4 __attribute__((ext_vector_type(4)));
typedef __bf16 bf16v2 __attribute__((ext_vector_type(2)));
#define DI __device__ __forceinline__

constexpr int D_MODEL = 1024, SEQ = 2048, BATCH = 32, DEC_SEQ = 16;
constexpr int MP = BATCH * SEQ;
constexpr int MS = BATCH * DEC_SEQ;
constexpr int MT = MP + MS;
constexpr int IN_COLS = 2592, IN_PAD = 2816;
constexpr int RW_COLS = 1824, D_FF = 4096;
constexpr int NPOS = SEQ + DEC_SEQ;

constexpr size_t O_PK = 67633152, O_PV = 68157440, O_PW = 68681728, O_PS = 69730304, O_SK = 69788672, O_SV = 69854208, O_SW = 69919744, O_SS = 70968320;

constexpr size_t al256(size_t x) { return (x + 255) & ~(size_t)255; }
constexpr size_t WS_WIN = 0;
constexpr size_t WS_WOUT = WS_WIN + (size_t)IN_PAD * 1024 * 2;
constexpr size_t WS_WUP = WS_WOUT + (size_t)1024 * 1024 * 2;
constexpr size_t WS_WDN = WS_WUP + (size_t)4096 * 1024 * 2;
constexpr size_t WS_W2T = WS_WDN + (size_t)4096 * 1024 * 2;
constexpr size_t WS_A2T = WS_W2T + 512 * 64 * 2;
constexpr size_t WS_G2T = WS_A2T + 512 * 64 * 2;
constexpr size_t WS_ROPE = al256(WS_G2T + 512 * 160 * 2);
constexpr size_t WS_SSQ = al256(WS_ROPE + (size_t)NPOS * 64 * 4);
constexpr size_t WS_X1B = al256(WS_SSQ + (size_t)MT * 16 * 4);
constexpr size_t WS_H = al256(WS_X1B + (size_t)MT * 1024 * 2);
constexpr size_t WS_Q = WS_H + (size_t)MT * 1024 * 2;
constexpr size_t WS_K = WS_Q + (size_t)MT * 512 * 2;
constexpr size_t WS_V = WS_K + (size_t)MT * 128 * 2;
constexpr size_t WS_PRW = WS_V + (size_t)MT * 128 * 2;
constexpr size_t WS_MIX = WS_PRW + (size_t)MT * RW_COLS * 2;
constexpr size_t WS_AEND = WS_MIX + (size_t)MT * 1024 * 2;
constexpr size_t WS_U = WS_H;
static_assert(WS_U + (size_t)MT * 4096 * 2 <= WS_AEND, "U overlay");
constexpr size_t WS_CTL = al256(WS_AEND);
constexpr size_t CTL_BYTES = 16384;
constexpr int SPLIT_OUT = 4, SPLIT_DN = 16;
constexpr size_t WS_SLAB = WS_CTL + CTL_BYTES;
constexpr size_t WS_END = WS_SLAB + (size_t)SPLIT_DN * MS * 1024 * 4;
static_assert(WS_END <= (size_t)1 << 30, "workspace");

constexpr int LDS_BYTES = 163840;

DI unsigned pk2(float lo, float hi) { f32x2 v = {lo, hi}; return __builtin_bit_cast(unsigned, __builtin_convertvector(v, bf16v2)); }
DI float bf2f(unsigned short b) { return __builtin_bit_cast(float, (unsigned)b << 16); }
DI float bflo(unsigned w) { return __builtin_bit_cast(float, w << 16); }
DI float bfhi(unsigned w) { return __builtin_bit_cast(float, w & 0xffff0000u); }
DI u32x4 pk8(f32x4 a, f32x4 b) { u32x4 w; w.x = pk2(a[0], a[1]); w.y = pk2(a[2], a[3]); w.z = pk2(b[0], b[1]); w.w = pk2(b[2], b[3]); return w; }
DI float wave_sum(float v) {
#pragma unroll
    for (int o = 1; o < 64; o <<= 1) v += __shfl_xor(v, o);
    return v;
}
template <int CTRL> DI float dpp_f(float x) { return __builtin_bit_cast(float, __builtin_amdgcn_mov_dpp(__builtin_bit_cast(int, x), CTRL, 0xf, 0xf, true)); }
DI float quad_sum(float x) { x += dpp_f<0xB1>(x); x += dpp_f<0x4E>(x); return x; }
DI float oct_sum(float x) { x = quad_sum(x); x += dpp_f<0x141>(x); return x; }
#define LDS_WAIT() asm volatile("s_waitcnt lgkmcnt(0)" ::: "memory")
DI int lane_id() { int x; asm volatile("v_mbcnt_lo_u32_b32 %0, -1, 0\n\tv_mbcnt_hi_u32_b32 %0, -1, %0" : "=v"(x)); return x; }

namespace pg8 {
constexpr int BM = 256, BK = 64, HALF = 128, HTB = HALF * BK * 2, STAGE_BYTES = 8 * HTB, NXCD = 8, WGM = 8;
__host__ __device__ __forceinline__ int lds_byte(int r, int c) { const int st = (r >> 4) * 2 + (c >> 5), rr = r & 15, cc = c & 31, ob = rr * 64 + cc * 2; return st * 1024 + (ob ^ (((ob >> 9) & 1) << 5)); }
__host__ __device__ __forceinline__ void stage_rc(int b, int& R, int& C) { const int st = b / 1024, sb = b % 1024, swz = sb ^ (((sb >> 9) & 1) << 5); R = (st >> 1) * 16 + swz / 64; C = (st & 1) * 32 + (swz % 64) / 2; }
struct Unit { int pm, pn, k0, nk, slab; };
struct Gemm { const bf16_t* A; const bf16_t* Bt; int M, N, K; };
struct StaticOrder {
    int nM, nMm, nN, nwg, ntail, S, nkt, G, c;
    __host__ __device__ void init(int M, int N, int K, int G_, int c_, int Mmain = 0, int S_ = 1) {
        nM = M / BM; nN = N / BM; nkt = K / BK; G = G_; c = c_;
        nMm = Mmain ? Mmain / BM : nM; S = S_; nwg = nMm * nN; ntail = (nM - nMm) * nN * S;
    }
    __host__ __device__ bool next(int i, Unit& u) const {
        const long L = (long)i * G + c; if (L >= nwg + ntail) return false;
        const bool tail = L >= nwg;
        const int e = tail ? (int)(L - nwg) : 0;
        int wgid = tail ? 0 : (int)L; { const int q = nwg / NXCD, r = nwg % NXCD, xcd = wgid % NXCD, off = wgid / NXCD; wgid = (xcd < r ? xcd * (q + 1) : r * (q + 1) + (xcd - r) * q) + off; }
        const int nig = WGM * nN, gid = wgid / nig, fm = gid * WGM, gsz = (nMm - fm) < WGM ? (nMm - fm) : WGM;
        const int mpm = fm + ((wgid % nig) % gsz), mpn = (wgid % nig) / gsz;
        const int tsl = e % S, tnk = nkt / S;
        u.pm = tail ? nMm + e / (nN * S) : mpm; u.pn = tail ? (e / S) % nN : mpn;
        u.slab = tail ? tsl : -1; u.nk = tail ? tnk : nkt; u.k0 = tail ? tsl * tnk : 0;
        return true;
    }
};
template <class Epi, class Sched, bool ALIGN_EPI = true, bool SP2 = true>
__device__ __forceinline__ void gemm_phase(LAS unsigned char* lds, const Gemm g, const Sched& S, const Epi& E, int kwid) {
    const int lane = lane_id(), wid = kwid, tid = wid * 64 + lane, wr = wid >> 2, wc = wid & 3, fr = lane & 15, fq = lane >> 4;
    const int K = g.K;
    unsigned voffA[2];
#pragma unroll
    for (int i = 0; i < 2; ++i) { int R, C; stage_rc(tid * 16 + i * 8192, R, C); voffA[i] = (unsigned)(R * K + C) * 2u; }
    const size_t kstep = (size_t)(BK * 2);
    const size_t hstep = (size_t)HALF * K * 2;
    const size_t tstep = 2 * hstep;
    const unsigned ldsw = (unsigned)wid * 1024u;
    const int aoff = lds_byte(wr * 64 + fr, fq * 8), boff = lds_byte(wc * 32 + fr, fq * 8);
#define PG8_SA(b, h) (((b) * 2 + (h)) * HTB)
#define PG8_SB(b, h) ((4 + (b) * 2 + (h)) * HTB)
#define PG8_STAGE(bufoff, gbase, voff) do { _Pragma("unroll") for (int _i = 0; _i < 2; ++_i) \
        __builtin_amdgcn_global_load_lds((const unsigned*)((const char*)(gbase) + (voff)[_i]), (LAS unsigned*)(lds + (bufoff) + ldsw + _i * 8192), 16, 0, 0); } while (0)
#define PG8_LDA(dst, b, h) do { _Pragma("unroll") for (int m = 0; m < 4; ++m) _Pragma("unroll") for (int k = 0; k < 2; ++k) dst[m][k] = *(const LAS bf16x8*)(lds + PG8_SA(b, h) + aoff + m * 2048 + k * 1024); } while (0)
#define PG8_LDB(dst, b, h) do { _Pragma("unroll") for (int n = 0; n < 2; ++n) _Pragma("unroll") for (int k = 0; k < 2; ++k) dst[n][k] = *(const LAS bf16x8*)(lds + PG8_SB(b, h) + boff + n * 2048 + k * 1024); } while (0)
#define PG8_MMA(ai, bj, At, Bt) do { __builtin_amdgcn_s_setprio(1); _Pragma("unroll") for (int m = 0; m < 4; ++m) _Pragma("unroll") for (int n = 0; n < 2; ++n) _Pragma("unroll") for (int k = 0; k < 2; ++k) \
        acc[ai][bj][m][n] = __builtin_amdgcn_mfma_f32_16x16x32_bf16(Bt[n][k], At[m][k], acc[ai][bj][m][n], 0, 0, 0); __builtin_amdgcn_s_setprio(0); } while (0)
#define PG8_WAIT_V(n) asm volatile("s_waitcnt vmcnt(" #n ")" ::: "memory")
#define PG8_WAIT_L(n) asm volatile("s_waitcnt lgkmcnt(" #n ")" ::: "memory")
#define PG8_BAR __builtin_amdgcn_s_barrier()
#define PG8_SCHED __builtin_amdgcn_sched_barrier(0)
    Unit cur, nxt; int ui = 0;
    if (!S.next(0, cur)) return;
    f32x4 acc[2][2][4][2];
#pragma unroll
    for (int a = 0; a < 2; ++a)
#pragma unroll
        for (int b = 0; b < 2; ++b)
#pragma unroll
            for (int m = 0; m < 4; ++m)
#pragma unroll
                for (int n = 0; n < 2; ++n) acc[a][b][m][n] = (f32x4){0.f, 0.f, 0.f, 0.f};
    bf16x8 At[4][2], B0[2][2], B1[2][2];
    const char* cA = (const char*)g.A + (size_t)cur.pm * tstep + (size_t)cur.k0 * kstep; const char* cB = (const char*)g.Bt + (size_t)cur.pn * tstep + (size_t)cur.k0 * kstep;
    if constexpr (SP2) {
        PG8_STAGE(PG8_SB(0, 0), cB, voffA); PG8_STAGE(PG8_SB(0, 1), cB + hstep, voffA); PG8_STAGE(PG8_SA(0, 0), cA, voffA); PG8_STAGE(PG8_SA(0, 1), cA + hstep, voffA);
        if (wr == 1) PG8_BAR;
        PG8_WAIT_V(2); PG8_BAR;
        PG8_STAGE(PG8_SB(1, 0), cB + kstep, voffA); PG8_STAGE(PG8_SA(1, 0), cA + kstep, voffA); PG8_STAGE(PG8_SB(1, 1), cB + hstep + kstep, voffA);
        PG8_WAIT_V(6); PG8_BAR;
    } else {
        PG8_STAGE(PG8_SB(0, 0), cB, voffA); PG8_STAGE(PG8_SA(0, 0), cA, voffA); PG8_STAGE(PG8_SB(0, 1), cB + hstep, voffA); PG8_STAGE(PG8_SA(0, 1), cA + hstep, voffA);
        if (wr == 1) PG8_BAR;
        PG8_WAIT_V(4); PG8_BAR;
        PG8_STAGE(PG8_SB(1, 0), cB + kstep, voffA); PG8_STAGE(PG8_SA(1, 0), cA + kstep, voffA); PG8_STAGE(PG8_SB(1, 1), cB + hstep + kstep, voffA);
        PG8_WAIT_V(6); PG8_BAR;
    }
    for (;;) {
        const bool has_next = S.next(ui + 1, nxt);
        const char* nA = has_next ? (const char*)g.A + (size_t)nxt.pm * tstep + (size_t)nxt.k0 * kstep : cA; const char* nB = has_next ? (const char*)g.Bt + (size_t)nxt.pn * tstep + (size_t)nxt.k0 * kstep : cB;
        const int nt = cur.nk;
        for (int t = 0; t < nt; t += 2) {
            const bool last = (t == nt - 2);
            const char* a1 = cA + (size_t)(t + 1) * kstep;
            const char* a2 = last ? nA : cA + (size_t)(t + 2) * kstep; const char* b2 = last ? nB : cB + (size_t)(t + 2) * kstep;
            const char* a3 = a2 + kstep; const char* b3 = b2 + kstep;
            if constexpr (SP2) {
            PG8_LDB(B0, 0, 0); PG8_LDB(B1, 0, 1); PG8_SCHED; PG8_LDA(At, 0, 0); PG8_STAGE(PG8_SA(1, 1), a1 + hstep, voffA);
            PG8_WAIT_V(8); PG8_WAIT_L(0); PG8_BAR; PG8_MMA(0, 0, At, B0); PG8_MMA(0, 1, At, B1); PG8_BAR; PG8_SCHED;
            PG8_LDA(At, 0, 1); PG8_STAGE(PG8_SB(0, 0), b2, voffA); PG8_STAGE(PG8_SB(0, 1), b2 + hstep, voffA); PG8_STAGE(PG8_SA(0, 0), a2, voffA);
            PG8_WAIT_V(8); PG8_WAIT_L(0); PG8_BAR; PG8_MMA(1, 0, At, B0); PG8_MMA(1, 1, At, B1); PG8_BAR; PG8_SCHED;
            PG8_LDB(B0, 1, 0); PG8_LDB(B1, 1, 1); PG8_SCHED; PG8_LDA(At, 1, 0); PG8_STAGE(PG8_SA(0, 1), a2 + hstep, voffA);
            PG8_WAIT_V(8); PG8_WAIT_L(0); PG8_BAR; PG8_MMA(0, 0, At, B0); PG8_MMA(0, 1, At, B1); PG8_BAR; PG8_SCHED;
            PG8_LDA(At, 1, 1); PG8_STAGE(PG8_SB(1, 0), b3, voffA); PG8_STAGE(PG8_SB(1, 1), b3 + hstep, voffA); PG8_STAGE(PG8_SA(1, 0), a3, voffA);
            PG8_WAIT_V(8); PG8_WAIT_L(0); PG8_BAR; PG8_MMA(1, 0, At, B0); PG8_MMA(1, 1, At, B1); PG8_BAR; PG8_SCHED;
            } else {
            PG8_LDB(B0, 0, 0); PG8_SCHED; PG8_LDA(At, 0, 0); PG8_STAGE(PG8_SA(1, 1), a1 + hstep, voffA);
            PG8_WAIT_L(8); PG8_BAR; PG8_WAIT_L(0); PG8_MMA(0, 0, At, B0); PG8_BAR; PG8_SCHED;
            PG8_LDB(B1, 0, 1); PG8_STAGE(PG8_SB(0, 0), b2, voffA);
            PG8_BAR; PG8_WAIT_L(0); PG8_MMA(0, 1, At, B1); PG8_BAR;
            PG8_LDA(At, 0, 1); PG8_STAGE(PG8_SA(0, 0), a2, voffA);
            PG8_BAR; PG8_WAIT_L(0); PG8_MMA(1, 0, At, B0); PG8_BAR; PG8_SCHED;
            PG8_STAGE(PG8_SB(0, 1), b2 + hstep, voffA);
            PG8_WAIT_V(6); PG8_BAR; PG8_MMA(1, 1, At, B1); PG8_BAR;
            PG8_LDB(B0, 1, 0); PG8_SCHED; PG8_LDA(At, 1, 0); PG8_STAGE(PG8_SA(0, 1), a2 + hstep, voffA);
            PG8_WAIT_L(8); PG8_BAR; PG8_WAIT_L(0); PG8_MMA(0, 0, At, B0); PG8_BAR; PG8_SCHED;
            PG8_LDB(B1, 1, 1); PG8_STAGE(PG8_SB(1, 0), b3, voffA);
            PG8_BAR; PG8_WAIT_L(0); PG8_MMA(0, 1, At, B1); PG8_BAR;
            PG8_LDA(At, 1, 1); PG8_STAGE(PG8_SA(1, 0), a3, voffA);
            PG8_BAR; PG8_WAIT_L(0); PG8_MMA(1, 0, At, B0); PG8_BAR; PG8_SCHED;
            PG8_STAGE(PG8_SB(1, 1), b3 + hstep, voffA);
            PG8_WAIT_V(6); PG8_BAR; PG8_MMA(1, 1, At, B1); PG8_BAR;
            }
        }
        if constexpr (ALIGN_EPI) { if (wr == 0) PG8_BAR; }
        E(acc, cur, wr, wc, fr, fq);
        if (!has_next) break;
#pragma unroll
        for (int a = 0; a < 2; ++a)
#pragma unroll
            for (int b = 0; b < 2; ++b)
#pragma unroll
                for (int m = 0; m < 4; ++m)
#pragma unroll
                    for (int n = 0; n < 2; ++n) acc[a][b][m][n] = (f32x4){0.f, 0.f, 0.f, 0.f};
        cur = nxt; cA = nA; cB = nB; ++ui;
        if constexpr (ALIGN_EPI) { if (wr == 1) PG8_BAR; }
    }
    PG8_WAIT_V(0);
    if constexpr (!ALIGN_EPI) { if (wr == 0) PG8_BAR; }
    PG8_BAR;
#undef PG8_SA
#undef PG8_SB
#undef PG8_STAGE
#undef PG8_LDA
#undef PG8_LDB
#undef PG8_MMA
#undef PG8_WAIT_V
#undef PG8_WAIT_L
#undef PG8_BAR
#undef PG8_SCHED
}
}

enum { MAP_NAT = 0, MAP_A = 1, MAP_B = 2 };
DI int rowmap(int mode, int c) {
    if (mode == MAP_NAT) return c;
    if (mode == MAP_A) { const int rem = c & 31; return (c & ~31) + 16 * ((rem >> 2) & 1) + 4 * (rem >> 3) + (rem & 3); }
    const int rem = c & 255; return (c & ~255) + 128 * ((rem >> 5) & 1) + 32 * (rem >> 6) + 16 * ((rem >> 2) & 1) + 4 * ((rem >> 3) & 3) + (rem & 3);
}

struct EpiIn {
    GAS bf16_t* Q; GAS bf16_t* Kb; GAS bf16_t* Vb; GAS bf16_t* PRW; GAS float* out; const GAS float* rope; const GAS float* qg; const GAS float* kg;
    DI void operator()(const f32x4 (&acc)[2][2][4][2], const pg8::Unit& u, int wr, int wc, int fr, int fq) const {
        const int H = u.pn * 4 + wc;
        const int row0 = u.pm * 256 + wr * 64 + fr;
        if (H < 10) {
            const bool isq = H < 8;
            const GAS float* g = isq ? qg : kg;
            f32x4 gv[2][2];
#pragma unroll
            for (int bj = 0; bj < 2; ++bj)
#pragma unroll
                for (int n = 0; n < 2; ++n) gv[bj][n] = *(const GAS f32x4*)(g + 32 * bj + 8 * fq + 4 * n);
#pragma unroll
            for (int ai = 0; ai < 2; ++ai)
#pragma unroll
                for (int m = 0; m < 4; ++m) {
                    const int row = row0 + ai * 128 + m * 16;
                    float ss = 0.f;
#pragma unroll
                    for (int bj = 0; bj < 2; ++bj)
#pragma unroll
                        for (int n = 0; n < 2; ++n) { const f32x4 x = acc[ai][bj][m][n]; ss += (x[0] * x[0] + x[1] * x[1]) + (x[2] * x[2] + x[3] * x[3]); }
                    ss += __shfl_xor(ss, 16); ss += __shfl_xor(ss, 32);
                    float rinv = __builtin_amdgcn_rsqf(ss * (1.f / 64.f) + 1e-6f);
                    if (isq) rinv *= 0.125f;
                    const bool samp = row >= MP;
                    const int rs = row - MP;
                    const int b = samp ? (rs >> 4) : (row >> 11), t = samp ? (rs & 15) : (row & 2047);
                    const int pi = samp ? (SEQ + t) : t;
                    const GAS float* rp = rope + (size_t)pi * 64 + 8 * fq;
                    f32x4 o1[2], o2[2];
#pragma unroll
                    for (int n = 0; n < 2; ++n) {
                        const f32x4 c4 = *(const GAS f32x4*)(rp + 4 * n), s4 = *(const GAS f32x4*)(rp + 32 + 4 * n);
                        const f32x4 x1 = acc[ai][0][m][n] * rinv * gv[0][n], x2 = acc[ai][1][m][n] * rinv * gv[1][n];
                        o1[n] = x1 * c4 - x2 * s4; o2[n] = x2 * c4 + x1 * s4;
                    }
                    if (isq) {
                        GAS bf16_t* qp = Q + (size_t)row * 512 + 64 * H + 8 * fq;
                        *(GAS u32x4*)qp = pk8(o1[0], o1[1]); *(GAS u32x4*)(qp + 32) = pk8(o2[0], o2[1]);
                    } else {
                        const int kvh = H - 8;
                        GAS bf16_t* kp = Kb + (size_t)row * 128 + 64 * kvh + 8 * fq;
                        *(GAS u32x4*)kp = pk8(o1[0], o1[1]); *(GAS u32x4*)(kp + 32) = pk8(o2[0], o2[1]);
                        if (samp || t >= SEQ - 128) {
                            GAS float* op = samp ? out + O_SK + ((size_t)(b * 16 + t) * 2 + kvh) * 64 + 8 * fq : out + O_PK + ((size_t)(b * 128 + (t - (SEQ - 128))) * 2 + kvh) * 64 + 8 * fq;
                            *(GAS f32x4*)op = o1[0]; *(GAS f32x4*)(op + 4) = o1[1]; *(GAS f32x4*)(op + 32) = o2[0]; *(GAS f32x4*)(op + 36) = o2[1];
                        }
                    }
                }
        } else if (H < 12) {
            const int kvh = H - 10;
#pragma unroll
            for (int ai = 0; ai < 2; ++ai)
#pragma unroll
                for (int m = 0; m < 4; ++m) {
                    const int row = row0 + ai * 128 + m * 16;
                    const bool samp = row >= MP;
                    const int rs = row - MP;
                    const int b = samp ? (rs >> 4) : (row >> 11), t = samp ? (rs & 15) : (row & 2047);
                    GAS bf16_t* vp = Vb + (size_t)row * 128 + 64 * kvh + 8 * fq;
                    *(GAS u32x4*)vp = pk8(acc[ai][0][m][0], acc[ai][0][m][1]); *(GAS u32x4*)(vp + 32) = pk8(acc[ai][1][m][0], acc[ai][1][m][1]);
                    if (samp || t >= SEQ - 128) {
                        GAS float* op = samp ? out + O_SV + ((size_t)(b * 16 + t) * 2 + kvh) * 64 + 8 * fq : out + O_PV + ((size_t)(b * 128 + (t - (SEQ - 128))) * 2 + kvh) * 64 + 8 * fq;
                        *(GAS f32x4*)op = acc[ai][0][m][0]; *(GAS f32x4*)(op + 4) = acc[ai][0][m][1]; *(GAS f32x4*)(op + 32) = acc[ai][1][m][0]; *(GAS f32x4*)(op + 36) = acc[ai][1][m][1];
                    }
                }
        } else {
            const int cr0 = (H - 12) * 64 + 8 * fq;
#pragma unroll
            for (int ai = 0; ai < 2; ++ai)
#pragma unroll
                for (int m = 0; m < 4; ++m) {
                    const int row = row0 + ai * 128 + m * 16;
                    const bool samp = row >= MP;
                    const int rs = row - MP;
                    const int b = samp ? (rs >> 4) : (row >> 11), t = samp ? (rs & 15) : (row & 2047);
                    const bool lastrow = samp ? (t == DEC_SEQ - 1) : (t == SEQ - 1);
#pragma unroll
                    for (int bj = 0; bj < 2; ++bj) {
                        const int cr = cr0 + 32 * bj;
                        if (cr < RW_COLS) {
                            *(GAS u32x4*)(PRW + (size_t)row * RW_COLS + cr) = pk8(acc[ai][bj][m][0], acc[ai][bj][m][1]);
                            if (lastrow) { GAS float* op = out + (samp ? O_SS : O_PS) + (size_t)b * RW_COLS + cr; *(GAS f32x4*)op = acc[ai][bj][m][0]; *(GAS f32x4*)(op + 4) = acc[ai][bj][m][1]; }
                        }
                    }
                }
        }
    }
};
DI void store_slab(GAS float* slab, const f32x4 (&acc)[2][2][4][2], const pg8::Unit& u, int wr, int wc, int fr, int fq) {
    const int row0 = (u.pm * 256 - MP) + wr * 64 + fr, col0 = u.pn * 256 + wc * 32 + 4 * fq;
    GAS float* base = slab + (size_t)u.slab * MS * 1024;
#pragma unroll
    for (int ai = 0; ai < 2; ++ai)
#pragma unroll
        for (int m = 0; m < 4; ++m) {
            const size_t off = (size_t)(row0 + ai * 128 + m * 16) * 1024 + col0;
#pragma unroll
            for (int bj = 0; bj < 2; ++bj)
#pragma unroll
                for (int n = 0; n < 2; ++n) *(GAS f32x4*)(base + off + bj * 128 + n * 16) = acc[ai][bj][m][n];
        }
}
struct EpiOut {
    const GAS float* xp; const GAS float* xs; GAS float* out; GAS bf16_t* X1B; GAS float* SSQ; GAS float* slab;
    DI void operator()(const f32x4 (&acc)[2][2][4][2], const pg8::Unit& u, int wr, int wc, int fr, int fq) const {
        if (u.slab >= 0) { store_slab(slab, acc, u, wr, wc, fr, fq); return; }
        const int row0 = u.pm * 256 + wr * 64 + fr, col0 = u.pn * 256 + wc * 32 + 4 * fq;
        const GAS float* xin = (u.pm < 256) ? xp : xs - (size_t)MP * 1024;
#pragma unroll
        for (int ai = 0; ai < 2; ++ai)
#pragma unroll
            for (int m = 0; m < 4; ++m) {
                const int row = row0 + ai * 128 + m * 16; const size_t off = (size_t)row * 1024 + col0;
                float ss = 0.f;
#pragma unroll
                for (int bj = 0; bj < 2; ++bj)
#pragma unroll
                    for (int n = 0; n < 2; ++n) {
                        const f32x4 o = *(const GAS f32x4*)(xin + off + bj * 128 + n * 16) + acc[ai][bj][m][n];
                        u32x2 w; w.x = pk2(o[0], o[1]); w.y = pk2(o[2], o[3]);
                        *(GAS u32x2*)(X1B + off + bj * 128 + n * 16) = w;
                        ss += (o[0] * o[0] + o[1] * o[1]) + (o[2] * o[2] + o[3] * o[3]);
                    }
                ss += __shfl_xor(ss, 16); ss += __shfl_xor(ss, 32);
                if (fq == 0) SSQ[(size_t)row * 16 + u.pn * 4 + wc] = ss;
            }
    }
};
struct EpiUp {
    const GAS float* SSQ; GAS bf16_t* U;
    DI void operator()(const f32x4 (&acc)[2][2][4][2], const pg8::Unit& u, int wr, int wc, int fr, int fq) const {
        const int row0 = u.pm * 256 + wr * 64 + fr, col0 = u.pn * 256 + wc * 32 + 8 * fq;
#pragma unroll
        for (int ai = 0; ai < 2; ++ai)
#pragma unroll
            for (int m = 0; m < 4; ++m) {
                const int row = row0 + ai * 128 + m * 16;
                const GAS f32x4* sp = (const GAS f32x4*)(SSQ + (size_t)row * 16);
                const f32x4 a = sp[0], b = sp[1], c = sp[2], d = sp[3];
                const f32x4 t4 = (a + b) + (c + d);
                const float tot = (t4[0] + t4[1]) + (t4[2] + t4[3]);
                const float s2 = 1.0f / (tot * (1.f / 1024.f) + 1e-6f);
#pragma unroll
                for (int bj = 0; bj < 2; ++bj) {
                    f32x4 v0 = acc[ai][bj][m][0], v1 = acc[ai][bj][m][1];
#pragma unroll
                    for (int j = 0; j < 4; ++j) { const float r0 = fmaxf(v0[j], 0.f), r1 = fmaxf(v1[j], 0.f); v0[j] = r0 * r0 * s2; v1[j] = r1 * r1 * s2; }
                    *(GAS u32x4*)(U + (size_t)row * D_FF + col0 + bj * 128) = pk8(v0, v1);
                }
            }
    }
};
struct EpiDown {
    GAS float* out; GAS float* slab; const GAS bf16_t* X1B;
    DI void operator()(const f32x4 (&acc)[2][2][4][2], const pg8::Unit& u, int wr, int wc, int fr, int fq) const {
        if (u.slab >= 0) { store_slab(slab, acc, u, wr, wc, fr, fq); return; }
        const int row0 = u.pm * 256 + wr * 64 + fr, col0 = u.pn * 256 + wc * 32 + 4 * fq;
#pragma unroll
        for (int ai = 0; ai < 2; ++ai)
#pragma unroll
            for (int m = 0; m < 4; ++m) {
                const size_t off = (size_t)(row0 + ai * 128 + m * 16) * 1024 + col0;
#pragma unroll
                for (int bj = 0; bj < 2; ++bj)
#pragma unroll
                    for (int n = 0; n < 2; ++n) { const u32x2 w = *(const GAS u32x2*)(X1B + off + bj * 128 + n * 16);
                        *(GAS f32x4*)(out + off + bj * 128 + n * 16) = (f32x4){bflo(w.x), bfhi(w.x), bflo(w.y), bfhi(w.y)} + acc[ai][bj][m][n]; }
            }
    }
};

DI void p0_transpose_item(const GAS float* W, int K, int N, GAS bf16_t* WT, int mode, const GAS float* kscale, LAS float* scr, int item, int lane) {
    const int nblk = N / 32, kb = item / nblk, nb = item % nblk, k0 = 64 * kb, n0 = 32 * nb;
#pragma unroll 8
    for (int i = 0; i < 32; ++i) { const int kk = 2 * i + (lane >> 5); float v = W[(size_t)(k0 + kk) * N + n0 + (lane & 31)]; if (kscale) v *= kscale[k0 + kk]; scr[kk * 33 + (lane & 31)] = v; }
    LDS_WAIT();
    const int c = lane & 7;
#pragma unroll
    for (int j = 0; j < 4; ++j) { const int n = (lane >> 3) + 8 * j; const LAS float* s = scr + (8 * c) * 33 + n;
        u32x4 o; o.x = pk2(s[0 * 33], s[1 * 33]); o.y = pk2(s[2 * 33], s[3 * 33]); o.z = pk2(s[4 * 33], s[5 * 33]); o.w = pk2(s[6 * 33], s[7 * 33]);
        *(GAS u32x4*)(WT + (size_t)rowmap(mode, n0 + n) * K + k0 + 8 * c) = o; }
    LDS_WAIT();
}
DI void sincos_d(double x, double& s, double& c) {
    const double TWO_PI = 6.283185307179586476925287;
    const double n = __builtin_rint(x * (1.0 / TWO_PI));
    const double r = x - n * TWO_PI, r2 = r * r;
    double ps = 1.0, pc = 1.0;
#pragma unroll
    for (int k = 14; k >= 1; --k) { ps = 1.0 - ps * r2 / (double)((2 * k) * (2 * k + 1)); pc = 1.0 - pc * r2 / (double)((2 * k - 1) * (2 * k)); }
    s = r * ps; c = pc;
}

struct Params { const float* in[26]; float* out; unsigned char* ws; int ph_lo, ph_hi; };

DI void phase0(const Params& p, LAS unsigned char* lds, int G, int kwid) {
    const int lane = lane_id(), wave = kwid, tid = wave * 64 + lane;
    const int gw = blockIdx.x * 8 + wave, NGW = G * 8;
    LAS float* scr = (LAS float*)(lds + wave * 8704);
    unsigned char* ws = p.ws;
    const GAS float* w_in = (const GAS float*)p.in[7]; const GAS float* w_out = (const GAS float*)p.in[22]; const GAS float* w_up = (const GAS float*)p.in[24]; const GAS float* w_dn = (const GAS float*)p.in[25];
    const GAS float* ln2 = (const GAS float*)p.in[23];
    constexpr int I_IN = 16 * (IN_COLS / 32), I_OUT = 16 * 32, I_UP = 16 * 128, I_DN = 64 * 32, NITEMS = I_IN + I_OUT + I_UP + I_DN;
    for (int it = gw; it < NITEMS; it += NGW) {
        int r = it;
        if (r < I_IN) { p0_transpose_item(w_in, 1024, IN_COLS, (GAS bf16_t*)(ws + WS_WIN), MAP_B, nullptr, scr, r, lane); continue; } r -= I_IN;
        if (r < I_OUT) { p0_transpose_item(w_out, 1024, 1024, (GAS bf16_t*)(ws + WS_WOUT), MAP_NAT, nullptr, scr, r, lane); continue; } r -= I_OUT;
        if (r < I_UP) { p0_transpose_item(w_up, 1024, 4096, (GAS bf16_t*)(ws + WS_WUP), MAP_A, ln2, scr, r, lane); continue; } r -= I_UP;
        p0_transpose_item(w_dn, 4096, 1024, (GAS bf16_t*)(ws + WS_WDN), MAP_NAT, nullptr, scr, r, lane);
    }
    const int gt = blockIdx.x * 512 + tid, NGT = G * 512;
    for (int i = gt; i < (IN_PAD - IN_COLS) * 128; i += NGT) { const int c = IN_COLS + i / 128; *(GAS u32x4*)((GAS bf16_t*)(ws + WS_WIN) + (size_t)rowmap(MAP_B, c) * 1024 + (i % 128) * 8) = (u32x4){0u, 0u, 0u, 0u}; }
    { const GAS float* w2 = (const GAS float*)p.in[13]; const GAS float* a2 = (const GAS float*)p.in[15]; const GAS float* g2 = (const GAS float*)p.in[16];
      GAS bf16_t* W2T = (GAS bf16_t*)(ws + WS_W2T); GAS bf16_t* A2T = (GAS bf16_t*)(ws + WS_A2T); GAS bf16_t* G2T = (GAS bf16_t*)(ws + WS_G2T);
      for (int i = gt; i < 512 * 32; i += NGT) { const int n = i >> 5, k2 = (i & 31) * 2;
          *(GAS unsigned*)(W2T + n * 64 + k2) = pk2(w2[k2 * 512 + n], w2[(k2 + 1) * 512 + n]);
          *(GAS unsigned*)(A2T + n * 64 + k2) = pk2(a2[k2 * 512 + n], a2[(k2 + 1) * 512 + n]); }
      for (int i = gt; i < 512 * 80; i += NGT) { const int n = i / 80, k2 = (i % 80) * 2; *(GAS unsigned*)(G2T + n * 160 + k2) = pk2(g2[k2 * 512 + n], g2[(k2 + 1) * 512 + n]); } }
    { GAS float* rope = (GAS float*)(ws + WS_ROPE);
      for (int i = gt; i < NPOS * 32; i += NGT) { const int pi = i >> 5, f = i & 31; const int pos = pi < SEQ ? pi : 4096 + (pi - SEQ);
          const float inv = (float)exp(-(double)f * (9.210340371976182736 / 32.0));
          const float ang = (float)pos * inv;
          double s, c; sincos_d((double)ang, s, c);
          rope[(size_t)pi * 64 + f] = (float)c; rope[(size_t)pi * 64 + 32 + f] = (float)s; } }
    { const GAS float* g1 = (const GAS float*)p.in[6]; GAS bf16_t* Hh = (GAS bf16_t*)(ws + WS_H);
      f32x4 gv[4];
#pragma unroll
      for (int j = 0; j < 4; ++j) gv[j] = *((const GAS f32x4*)g1 + lane + 64 * j);
      for (int m = gw; m < MT; m += NGW) {
          const GAS float* xrow = (m < MP) ? (const GAS float*)p.in[0] + (size_t)m * 1024 : (const GAS float*)p.in[1] + (size_t)(m - MP) * 1024;
          const GAS f32x4* xr = (const GAS f32x4*)xrow + lane;
          f32x4 v[4]; float s = 0.f;
#pragma unroll
          for (int j = 0; j < 4; ++j) { v[j] = xr[64 * j]; s += (v[j][0] * v[j][0] + v[j][1] * v[j][1]) + (v[j][2] * v[j][2] + v[j][3] * v[j][3]); }
          const float rinv = __builtin_amdgcn_rsqf(wave_sum(s) * (1.f / 1024.f) + 1e-6f);
          GAS u32x2* o8 = (GAS u32x2*)(Hh + (size_t)m * 1024) + lane;
#pragma unroll
          for (int j = 0; j < 4; ++j) { const f32x4 y = v[j] * rinv * gv[j]; u32x2 w; w.x = pk2(y[0], y[1]); w.y = pk2(y[2], y[3]); o8[64 * j] = w; }
      } }
}

constexpr int KS_STRIDE = 144;
constexpr int VT_STRIDE = 392;
constexpr int VT_OFF = 192 * KS_STRIDE;
#define MFMA32(a, b, c) __builtin_amdgcn_mfma_f32_32x32x16_bf16((a), (b), (c), 0, 0, 0)

DI void attn_store_kv(LAS unsigned char* lds, int row, int ch, u32x4 kv, u32x4 vv) {
    *(LAS u32x4*)(lds + row * KS_STRIDE + ch * 16) = kv;
    LAS unsigned short* vt = (LAS unsigned short*)(lds + VT_OFF + (8 * ch) * VT_STRIDE + row * 2);
    const unsigned w[4] = {vv.x, vv.y, vv.z, vv.w};
#pragma unroll
    for (int i = 0; i < 4; ++i) { vt[(2 * i) * (VT_STRIDE / 2)] = (unsigned short)(w[i] & 0xffffu); vt[(2 * i + 1) * (VT_STRIDE / 2)] = (unsigned short)(w[i] >> 16); }
}
DI void attn_wave(LAS unsigned char* lds, const GAS bf16_t* qptr  , GAS bf16_t* optr, float sink, int kt0, int nkt, bool mask_last_half, bool do_store, int lane) {
    const int r = lane & 31, h = lane >> 5;
    bf16x8 qf[4];
#pragma unroll
    for (int ks = 0; ks < 4; ++ks) qf[ks] = *(const GAS bf16x8*)(qptr + 16 * ks + 8 * h);
    f32x16 st[6];
#pragma unroll
    for (int kt = 0; kt < 6; ++kt) {
#pragma unroll
        for (int i = 0; i < 16; ++i) st[kt][i] = 0.f;
        if (kt >= kt0 && kt < nkt) {
#pragma unroll
            for (int ks = 0; ks < 4; ++ks) { const bf16x8 kf = *(const LAS bf16x8*)(lds + (32 * kt + r) * KS_STRIDE + (16 * ks + 8 * h) * 2); st[kt] = MFMA32(kf, qf[ks], st[kt]); }
        }
    }
    float mx = sink;
#pragma unroll
    for (int kt = 0; kt < 6; ++kt) if (kt >= kt0 && kt < nkt) {
#pragma unroll
        for (int i = 0; i < 16; ++i) { const bool dead = mask_last_half && kt == nkt - 1 && i >= 8; if (!dead) mx = fmaxf(mx, st[kt][i]); }
    }
    mx = fmaxf(mx, __shfl_xor(mx, 32));
    float l = 0.f;
#pragma unroll
    for (int kt = 0; kt < 6; ++kt) if (kt >= kt0 && kt < nkt) {
#pragma unroll
        for (int i = 0; i < 16; ++i) { const bool dead = mask_last_half && kt == nkt - 1 && i >= 8; const float pv = dead ? 0.f : __expf(st[kt][i] - mx); st[kt][i] = pv; l += pv; }
    }
    l += __shfl_xor(l, 32);
    const float inv = 1.0f / (l + __expf(sink - mx));
    f32x16 ot[2];
#pragma unroll
    for (int dt = 0; dt < 2; ++dt)
#pragma unroll
        for (int i = 0; i < 16; ++i) ot[dt][i] = 0.f;
#pragma unroll
    for (int kt = 0; kt < 6; ++kt) if (kt >= kt0 && kt < nkt) {
#pragma unroll
        for (int s = 0; s < 2; ++s) {
            u32x4 pw; pw.x = pk2(st[kt][8 * s], st[kt][8 * s + 1]); pw.y = pk2(st[kt][8 * s + 2], st[kt][8 * s + 3]); pw.z = pk2(st[kt][8 * s + 4], st[kt][8 * s + 5]); pw.w = pk2(st[kt][8 * s + 6], st[kt][8 * s + 7]);
            const bf16x8 pf = __builtin_bit_cast(bf16x8, pw);
#pragma unroll
            for (int dt = 0; dt < 2; ++dt) {
                const LAS unsigned char* vp = lds + VT_OFF + (32 * dt + r) * VT_STRIDE + (32 * kt + 16 * s + 4 * h) * 2;
                const u32x2 v0 = *(const LAS u32x2*)vp, v1 = *(const LAS u32x2*)(vp + 16);
                u32x4 vw; vw.x = v0.x; vw.y = v0.y; vw.z = v1.x; vw.w = v1.y;
                ot[dt] = MFMA32(__builtin_bit_cast(bf16x8, vw), pf, ot[dt]);
            }
        }
    }
    if (do_store) {
#pragma unroll
        for (int dt = 0; dt < 2; ++dt)
#pragma unroll
            for (int rg = 0; rg < 4; ++rg) {
                u32x2 w; w.x = pk2(ot[dt][4 * rg] * inv, ot[dt][4 * rg + 1] * inv); w.y = pk2(ot[dt][4 * rg + 2] * inv, ot[dt][4 * rg + 3] * inv);
                *(GAS u32x2*)(optr + 32 * dt + 8 * rg + 4 * h) = w;
            }
    }
}
DI void attn_phase(const Params& p, LAS unsigned char* lds, int G, int kwid) {
    const int lane = lane_id(), wid = kwid, tid = wid * 64 + lane;
    unsigned char* ws = p.ws;
    const GAS bf16_t* Q = (const GAS bf16_t*)(ws + WS_Q); const GAS bf16_t* Kb = (const GAS bf16_t*)(ws + WS_K); const GAS bf16_t* Vb = (const GAS bf16_t*)(ws + WS_V);
    GAS bf16_t* MIX = (GAS bf16_t*)(ws + WS_MIX);
    const GAS float* sinks = (const GAS float*)p.in[10];
    constexpr int NPI = BATCH * 32 * 2, NSI = BATCH * 2;
    for (int it = blockIdx.x; it < NPI + NSI; it += G) {
        __syncthreads();
        if (it < NPI) {
            const int g = it & 1, n = (it >> 1) & 31, b = it >> 6;
            const int kt0 = n >= 2 ? 0 : (2 - n) * 2;
            const int krow0 = b * SEQ + 64 * (n - 2);
#pragma unroll
            for (int i = 0; i < 3; ++i) {
                const int cid = tid + 512 * i, row = cid >> 3, ch = cid & 7;
                if (row >= 32 * kt0) {
                    const size_t go = (size_t)(krow0 + row) * 128 + 64 * g + 8 * ch;
                    attn_store_kv(lds, row, ch, *(const GAS u32x4*)(Kb + go), *(const GAS u32x4*)(Vb + go));
                }
            }
            __syncthreads();
            const int hq = 4 * g + (wid >> 1);
            const int qrow = b * SEQ + 64 * n + 32 * (wid & 1) + (lane & 31);
            attn_wave(lds, Q + (size_t)qrow * 512 + 64 * hq, MIX + (size_t)qrow * 1024 + 64 * hq, sinks[hq], kt0, 6, false, true, lane);
        } else {
            const int si = it - NPI, g = si & 1, b = si >> 1;
            const GAS float* ck = (const GAS float*)p.in[2]; const GAS float* cv = (const GAS float*)p.in[3];
#pragma unroll
            for (int i = 0; i < 3; ++i) {
                const int cid = tid + 512 * i, row = cid >> 3, ch = cid & 7;
                if (row < 160) {
                    u32x4 kv = {0u, 0u, 0u, 0u}, vv = {0u, 0u, 0u, 0u};
                    if (row < 128) {
                        const size_t go = ((size_t)(b * 128 + row) * 2 + g) * 64 + 8 * ch;
                        kv = pk8(*(const GAS f32x4*)(ck + go), *(const GAS f32x4*)(ck + go + 4)); vv = pk8(*(const GAS f32x4*)(cv + go), *(const GAS f32x4*)(cv + go + 4));
                    } else if (row < 144) {
                        const size_t go = (size_t)(MP + b * 16 + (row - 128)) * 128 + 64 * g + 8 * ch;
                        kv = *(const GAS u32x4*)(Kb + go); vv = *(const GAS u32x4*)(Vb + go);
                    }
                    attn_store_kv(lds, row, ch, kv, vv);
                }
            }
            __syncthreads();
            if (wid < 4) {
                const int hq = 4 * g + wid;
                const int qrow = MP + b * 16 + (lane & 15);
                attn_wave(lds, Q + (size_t)qrow * 512 + 64 * hq, MIX + (size_t)qrow * 1024 + 64 * hq, sinks[hq], 0, 5, true, (lane & 31) < 16, lane);
            }
        }
    }
    __syncthreads();
}

constexpr int NHELP = 6;
constexpr int SL_AQ = 0, AQ_STR = 136;
constexpr int SL_GH = SL_AQ + 32 * AQ_STR, GH_STR = 48;
constexpr int SL_VT = SL_GH + 32 * GH_STR, T_STR = 48;
constexpr int SL_KT = SL_VT + 64 * T_STR;
constexpr int SL_BT = SL_KT + 64 * T_STR, BT_STR = 40;
constexpr int SL_WV = SL_BT + 64 * BT_STR;
constexpr int SL_PB = SL_WV + 256;
constexpr int SL_BON = SL_PB + 16 * 128 * 2;
constexpr int SLOT_BYTES = SL_BON + 64;
constexpr int RW_SLOTS = 0;
constexpr int RW_LW2 = RW_SLOTS + NHELP * SLOT_BYTES;
constexpr int RW_LA2 = RW_LW2 + 64 * 144;
constexpr int RW_LG2 = RW_LA2 + 64 * 144;
constexpr int RW_CV = RW_LG2 + 64 * 336;
constexpr int RW_MUL = RW_CV + 10 * 64 * 4;
constexpr int RW_FLG = RW_MUL + 288 * 4;
constexpr int RW_END = RW_FLG + 3 * 8 * 4;
static_assert(RW_END <= LDS_BYTES - 16, "rwkv LDS");
enum { CV_W0 = 0, CV_A0, CV_KK, CV_KA, CV_RK, CV_LG, CV_LB, CV_MR, CV_MK, CV_MV };
#define MFMA16(a, b, c) __builtin_amdgcn_mfma_f32_16x16x32_bf16((a), (b), (c), 0, 0, 0)

struct RwSeq { const GAS bf16_t* prw; const GAS bf16_t* act; const GAS float* shift0; const GAS float* wkv0; GAS float* wkv_out; GAS bf16_t* mix; int ntok; int h; };

DI void unpk8(u32x4 w, float (&o)[8]) { o[0] = bflo(w.x); o[1] = bfhi(w.x); o[2] = bflo(w.y); o[3] = bfhi(w.y); o[4] = bflo(w.z); o[5] = bfhi(w.z); o[6] = bflo(w.w); o[7] = bfhi(w.w); }
DI unsigned dpp_shr1_u(unsigned x) { return (unsigned)__builtin_amdgcn_update_dpp(0, (int)x, 0x111, 0xf, 0xf, true); }
template <int CTRL> DI float dpp_shr_f(float x) { return __builtin_bit_cast(float, __builtin_amdgcn_update_dpp(0, __builtin_bit_cast(int, x), CTRL, 0xf, 0xf, true)); }
DI void flag_wait(volatile LAS unsigned* f, unsigned v) { unsigned sp = 0; while (*f < v) { __builtin_amdgcn_s_sleep(1); if (++sp > (1u << 24)) break; } asm volatile("" ::: "memory"); }
DI void flag_set(volatile LAS unsigned* f, unsigned v, int ln) { asm volatile("s_waitcnt vmcnt(0) lgkmcnt(0)" ::: "memory"); if (ln == 0) *f = v; }
DI bf16x8 pack8f(const float (&x)[8]) { u32x4 w; w.x = pk2(x[0], x[1]); w.y = pk2(x[2], x[3]); w.z = pk2(x[4], x[5]); w.w = pk2(x[6], x[7]); return __builtin_bit_cast(bf16x8, w); }

DI void lora_act_pass(const Params& p, int G, int kwid) {
    const GAS bf16_t* PRW = (const GAS bf16_t*)(p.ws + WS_PRW); GAS bf16_t* ACTB = (GAS bf16_t*)(p.ws + WS_X1B);
    const GAS float* mu = (const GAS float*)p.in[11] + 1536; const GAS float* sh = (const GAS float*)p.in[5];
    for (int i = blockIdx.x * 512 + kwid * 64 + lane_id(); i < MT * 36; i += G * 512) {
        const int row = i / 36, pc = i - row * 36, d = pc * 8;
        const bool samp = row >= MP; const int t = samp ? ((row - MP) & 15) : (row & 2047);
        float c[8], pv[8], xs[8];
        unpk8(*(const GAS u32x4*)(PRW + (size_t)row * RW_COLS + 1536 + d), c);
        if (t > 0) unpk8(*(const GAS u32x4*)(PRW + (size_t)(row - 1) * RW_COLS + 1536 + d), pv);
        else if (samp) { const GAS float* sp = sh + (size_t)((row - MP) >> 4) * RW_COLS + 1536 + d; const f32x4 a = *(const GAS f32x4*)sp, b = *(const GAS f32x4*)(sp + 4);
#pragma unroll
            for (int j = 0; j < 4; ++j) { pv[j] = a[j]; pv[4 + j] = b[j]; } }
        else {
#pragma unroll
            for (int j = 0; j < 8; ++j) pv[j] = 0.f; }
        const f32x4 m0 = *(const GAS f32x4*)(mu + d), m1 = *(const GAS f32x4*)(mu + d + 4);
#pragma unroll
        for (int j = 0; j < 8; ++j) {
            const float x = c[j] + (pv[j] - c[j]) * (j < 4 ? m0[j] : m1[j - 4]);
            xs[j] = d < 64 ? 1.0f - 2.0f * __builtin_amdgcn_rcpf(__expf(2.0f * x) + 1.0f) : (d < 128 ? x : __builtin_amdgcn_rcpf(1.0f + __expf(-x)));
        }
        u32x4 w; w.x = pk2(xs[0], xs[1]); w.y = pk2(xs[2], xs[3]); w.z = pk2(xs[4], xs[5]); w.w = pk2(xs[6], xs[7]);
        *(GAS u32x4*)(ACTB + (size_t)row * 288 + d) = w;
    }
}
DI void rw_helper_chunk(LAS unsigned char* lds, const RwSeq& sq, int m, unsigned k, int hw, int ln_) {
    int ln = ln_; asm volatile("" : "+v"(ln));
    const int tk = ln & 15, q = ln >> 4, t = 16 * m + tk;
    LAS unsigned char* sl = lds + RW_SLOTS + hw * SLOT_BYTES;
    const LAS float* CV = (const LAS float*)(lds + RW_CV);
    volatile LAS unsigned* FLG = (volatile LAS unsigned*)(lds + RW_FLG);
    const GAS bf16_t* prow = sq.prw + (size_t)t * RW_COLS;
    const bool tk0 = tk == 0;
    const GAS bf16_t* pprev = prow - RW_COLS;
    const bool gprev = tk0 && t > 0, sprev = tk0 && t == 0 && sq.shift0 != nullptr;
    f32x4 aw[4], aa[4], ag[4];
    f32x4 rr[4], kx[4];
    u32x2 vvp[4];
    float ssq = 0.f;
    {
        bf16x8 f[9]; u32x2 rraw[3][4], rbnd[3][4];
        const GAS bf16_t* arow = sq.act + (size_t)t * 288 + 8 * q;
#pragma unroll
        for (int ks = 0; ks < 9; ++ks) f[ks] = *(const GAS bf16x8*)(arow + 32 * ks);
#pragma unroll
        for (int w = 0; w < 3; ++w)
#pragma unroll
            for (int ct = 0; ct < 4; ++ct) {
                const int col = w * 512 + 64 * sq.h + 16 * ct + 4 * q;
                rraw[w][ct] = *(const GAS u32x2*)(prow + col); rbnd[w][ct] = (u32x2){0u, 0u};
                if (gprev) rbnd[w][ct] = *(const GAS u32x2*)(pprev + col);
                else if (sprev) { const f32x4 x = *(const GAS f32x4*)(sq.shift0 + col); u32x2 o; o.x = pk2(x[0], x[1]); o.y = pk2(x[2], x[3]); rbnd[w][ct] = o; }
            }
#pragma unroll
        for (int ct = 0; ct < 4; ++ct) {
            const int wrow = 16 * ct + tk;
            f32x4 x = {0.f, 0.f, 0.f, 0.f}, y = x, z = x;
#pragma unroll
            for (int ks = 0; ks < 2; ++ks) {
                x = MFMA16(*(const LAS bf16x8*)(lds + RW_LW2 + wrow * 144 + (32 * ks + 8 * q) * 2), f[ks], x);
                y = MFMA16(*(const LAS bf16x8*)(lds + RW_LA2 + wrow * 144 + (32 * ks + 8 * q) * 2), f[2 + ks], y);
            }
#pragma unroll
            for (int ks = 0; ks < 5; ++ks) z = MFMA16(*(const LAS bf16x8*)(lds + RW_LG2 + wrow * 336 + (32 * ks + 8 * q) * 2), f[4 + ks], z);
            aw[ct] = x; aa[ct] = y; ag[ct] = z;
        }
#pragma unroll
        for (int ct = 0; ct < 4; ++ct) {
            const int c = 16 * ct + 4 * q;
#pragma unroll
            for (int w = 0; w < 3; ++w) {
                u32x2 pw; pw.x = dpp_shr1_u(rraw[w][ct].x); pw.y = dpp_shr1_u(rraw[w][ct].y);
                if (tk0) pw = rbnd[w][ct];
                const f32x4 cu = (f32x4){bflo(rraw[w][ct].x), bfhi(rraw[w][ct].x), bflo(rraw[w][ct].y), bfhi(rraw[w][ct].y)};
                const f32x4 pr = (f32x4){bflo(pw.x), bfhi(pw.x), bflo(pw.y), bfhi(pw.y)};
                const f32x4 mu = *(const LAS f32x4*)(CV + (CV_MR + w) * 64 + c);
                const f32x4 xs = cu + (pr - cu) * mu;
                if (w == 0) rr[ct] = xs; else if (w == 1) kx[ct] = xs; else { u32x2 o; o.x = pk2(xs[0], xs[1]); o.y = pk2(xs[2], xs[3]); vvp[ct] = o; }
            }
            const f32x4 kkr = kx[ct] * *(const LAS f32x4*)(CV + CV_KK * 64 + c);
            ssq += (kkr[0] * kkr[0] + kkr[1] * kkr[1]) + (kkr[2] * kkr[2] + kkr[3] * kkr[3]);
        }
    }
    ssq += __shfl_xor(ssq, 16); ssq += __shfl_xor(ssq, 32);
    const float kinv = __builtin_amdgcn_rsqf(fmaxf(ssq, 1e-24f));
    flag_wait(FLG + 16 + hw, k);
    u32x2 fa2[4], fb2[4], fk2[4], fr2[4];
    u32x2 Bbp[4], Kbp[4];
    float bon = 0.f;
#pragma unroll
    for (int ct = 0; ct < 4; ++ct) {
        const int c = 16 * ct + 4 * q;
        const f32x4 w0 = *(const LAS f32x4*)(CV + CV_W0 * 64 + c), a0 = *(const LAS f32x4*)(CV + CV_A0 * 64 + c), kkc = *(const LAS f32x4*)(CV + CV_KK * 64 + c),
                    kac = *(const LAS f32x4*)(CV + CV_KA * 64 + c), rkc = *(const LAS f32x4*)(CV + CV_RK * 64 + c);
        f32x4 Bb, Kb, Wc, xa, xb, xk, xr;
#pragma unroll
        for (int j = 0; j < 4; ++j) {
            const float lw = -0.60653066f * __builtin_amdgcn_rcpf(1.0f + __expf(-(w0[j] + aw[ct][j])));
            float cl = lw;
            cl += dpp_shr_f<0x111>(cl); cl += dpp_shr_f<0x112>(cl); cl += dpp_shr_f<0x114>(cl); cl += dpp_shr_f<0x118>(cl);
            const float E = __expf(cl), Einv = __builtin_amdgcn_rcpf(E);
            const float Ep = dpp_shr_f<0x111>(E), Em1 = tk0 ? 1.0f : Ep;
            const float WC = __shfl(E, (ln & 48) | 15);
            const float sg = __builtin_amdgcn_rcpf(1.0f + __expf(-(a0[j] + aa[ct][j])));
            const float kp = kx[ct][j] * (1.0f + (sg - 1.0f) * kac[j]);
            const float ah = kx[ct][j] * kkc[j] * kinv;
            const float bt = ah * sg * Einv, kt = kp * Einv;
            xa[j] = -ah * Em1; xb[j] = bt; xk[j] = kt; xr[j] = rr[ct][j] * E;
            Bb[j] = bt * WC; Kb[j] = kt * WC; Wc[j] = WC;
            bon += rr[ct][j] * kp * rkc[j];
        }
        { u32x2 o; o.x = pk2(xa[0], xa[1]); o.y = pk2(xa[2], xa[3]); fa2[ct] = o; o.x = pk2(xb[0], xb[1]); o.y = pk2(xb[2], xb[3]); fb2[ct] = o;
          o.x = pk2(xk[0], xk[1]); o.y = pk2(xk[2], xk[3]); fk2[ct] = o; o.x = pk2(xr[0], xr[1]); o.y = pk2(xr[2], xr[3]); fr2[ct] = o;
          o.x = pk2(Bb[0], Bb[1]); o.y = pk2(Bb[2], Bb[3]); Bbp[ct] = o; o.x = pk2(Kb[0], Kb[1]); o.y = pk2(Kb[2], Kb[3]); Kbp[ct] = o; }
        if (tk0) *(LAS f32x4*)(sl + SL_WV + c * 4) = Wc;
        { u32x2 gw; gw.x = pk2(ag[ct][0], ag[ct][1]); gw.y = pk2(ag[ct][2], ag[ct][3]);
          *(LAS u32x2*)(sl + SL_PB + tk * 256 + c * 2) = gw; *(LAS u32x2*)(sl + SL_PB + tk * 256 + 128 + c * 2) = vvp[ct]; }
        { const unsigned aw2[2] = {fa2[ct].x, fa2[ct].y}, rw2[2] = {fr2[ct].x, fr2[ct].y};
#pragma unroll
          for (int j = 0; j < 4; ++j) { const int sh = (j & 1) * 16;
              *(LAS unsigned short*)(sl + SL_VT + (c + j) * T_STR + tk * 2) = (unsigned short)(aw2[j >> 1] >> sh);
              *(LAS unsigned short*)(sl + SL_KT + (c + j) * T_STR + tk * 2) = (unsigned short)(rw2[j >> 1] >> sh); } }
    }
    bon += __shfl_xor(bon, 16); bon += __shfl_xor(bon, 32);
    if (q == 0) *(LAS float*)(sl + SL_BON + tk * 4) = bon;
    f32x4 Mab, Mak, Mbr, Mkr;
    { u32x4 w_;
#define RW_FR(P, KS) (w_.x = P[2 * (KS)].x, w_.y = P[2 * (KS)].y, w_.z = P[2 * (KS) + 1].x, w_.w = P[2 * (KS) + 1].y, __builtin_bit_cast(bf16x8, w_))
      const bf16x8 fa0 = RW_FR(fa2, 0), fa1 = RW_FR(fa2, 1), fb0 = RW_FR(fb2, 0), fb1 = RW_FR(fb2, 1), fk0 = RW_FR(fk2, 0), fk1 = RW_FR(fk2, 1), fr0 = RW_FR(fr2, 0), fr1 = RW_FR(fr2, 1);
#undef RW_FR
      const f32x4 z = {0.f, 0.f, 0.f, 0.f};
      Mab = MFMA16(fb1, fa1, MFMA16(fb0, fa0, z)); Mak = MFMA16(fk1, fa1, MFMA16(fk0, fa0, z));
      Mbr = MFMA16(fb1, fr1, MFMA16(fb0, fr0, z)); Mkr = MFMA16(fk1, fr1, MFMA16(fk0, fr0, z)); }
#pragma unroll
    for (int j = 0; j < 4; ++j) { const int s_ = 4 * q + j; if (s_ >= tk) { Mab[j] = 0.f; Mak[j] = 0.f; } if (s_ > tk) { Mbr[j] = 0.f; Mkr[j] = 0.f; } }
    LAS float* MabL = (LAS float*)(sl + SL_AQ); LAS float* MakL = MabL + 256; LAS float* MbrL = MabL + 512; LAS float* TNL = MabL + 768;
#pragma unroll
    for (int j = 0; j < 4; ++j) { const int o_ = (4 * q + j) * 16 + tk; MabL[o_] = Mab[j]; MakL[o_] = Mak[j]; MbrL[o_] = Mbr[j]; }
    LDS_WAIT();
    float Y[16];
    {
        f32x4 mm[8][2];
#pragma unroll
        for (int i = 0; i < 8; ++i) { mm[i][0] = *(const LAS f32x4*)(MabL + (8 + i) * 16 + 8); mm[i][1] = *(const LAS f32x4*)(MabL + (8 + i) * 16 + 12); }
#pragma unroll
        for (int s_ = 15; s_ >= 8; --s_) { float acc = (s_ == tk) ? 1.0f : 0.0f;
#pragma unroll
            for (int u = s_ + 1; u < 16; ++u) acc += Y[u] * mm[s_ - 8][(u - 8) >> 2][(u - 8) & 3];
            Y[s_] = acc; }
    }
    {
        f32x4 mm[4][3];
#pragma unroll
        for (int i = 0; i < 4; ++i)
#pragma unroll
            for (int g4 = 0; g4 < 3; ++g4) mm[i][g4] = *(const LAS f32x4*)(MabL + (4 + i) * 16 + 4 + 4 * g4);
#pragma unroll
        for (int s_ = 7; s_ >= 4; --s_) { float acc = (s_ == tk) ? 1.0f : 0.0f;
#pragma unroll
            for (int u = s_ + 1; u < 16; ++u) acc += Y[u] * mm[s_ - 4][(u - 4) >> 2][(u - 4) & 3];
            Y[s_] = acc; }
    }
    {
        f32x4 mm[4][4];
#pragma unroll
        for (int i = 0; i < 4; ++i)
#pragma unroll
            for (int g4 = 0; g4 < 4; ++g4) mm[i][g4] = *(const LAS f32x4*)(MabL + i * 16 + 4 * g4);
#pragma unroll
        for (int s_ = 3; s_ >= 0; --s_) { float acc = (s_ == tk) ? 1.0f : 0.0f;
#pragma unroll
            for (int u = s_ + 1; u < 16; ++u) acc += Y[u] * mm[s_][u >> 2][u & 3];
            Y[s_] = acc; }
    }
    if (q == 0) {
#pragma unroll
        for (int s_ = 0; s_ < 16; ++s_) TNL[s_ * 16 + tk] = Y[s_];
    }
    LDS_WAIT();
    float mbc[16];
#pragma unroll
    for (int u = 0; u < 16; ++u) mbc[u] = MbrL[u * 16 + tk];
    f32x4 Nq;
#pragma unroll
    for (int j = 0; j < 4; ++j) {
        const LAS float* row = TNL + (4 * q + j) * 16; float acc = 0.f;
#pragma unroll
        for (int g4 = 0; g4 < 4; ++g4) { const f32x4 x = *(const LAS f32x4*)(row + 4 * g4); acc += (x[0] * mbc[4 * g4] + x[1] * mbc[4 * g4 + 1]) + (x[2] * mbc[4 * g4 + 2] + x[3] * mbc[4 * g4 + 3]); }
        Nq[j] = acc;
    }
    LDS_WAIT();
#pragma unroll
    for (int j = 0; j < 4; ++j) TNL[(4 * q + j) * 16 + tk] = Nq[j];
    LDS_WAIT();
    float Nc[16];
#pragma unroll
    for (int u = 0; u < 16; ++u) Nc[u] = TNL[u * 16 + tk];
    f32x4 Gq, Hq;
#pragma unroll
    for (int j = 0; j < 4; ++j) {
        const LAS float* row = MakL + (4 * q + j) * 16; float ag_ = 0.f, ah_ = 0.f;
#pragma unroll
        for (int g4 = 0; g4 < 4; ++g4) { const f32x4 x = *(const LAS f32x4*)(row + 4 * g4);
            ag_ += (x[0] * Y[4 * g4] + x[1] * Y[4 * g4 + 1]) + (x[2] * Y[4 * g4 + 2] + x[3] * Y[4 * g4 + 3]);
            ah_ += (x[0] * Nc[4 * g4] + x[1] * Nc[4 * g4 + 1]) + (x[2] * Nc[4 * g4 + 2] + x[3] * Nc[4 * g4 + 3]); }
        Gq[j] = ag_; Hq[j] = ah_ + Mkr[j];
    }
    bf16x8 bA, bQ;
    { float xa[8], xq[8];
#pragma unroll
      for (int e = 0; e < 8; ++e) {
          xa[e] = (q == 2) ? Y[e] : ((q == 3) ? Y[8 + e] : 0.f);
          xq[e] = (q == 2) ? Nc[e] : ((q == 3) ? Nc[8 + e] : (((q << 3) + e == tk) ? 1.0f : 0.f));
      }
      bA = pack8f(xa); bQ = pack8f(xq); }
    f32x4 dA[4], dQ[4];
#pragma unroll
    for (int ct = 0; ct < 4; ++ct) {
        const int crow = 16 * ct + tk;
        const bf16x8 af = *(const LAS bf16x8*)(sl + ((q < 2) ? SL_KT : SL_VT) + crow * T_STR + (q & 1) * 16);
        const f32x4 z = {0.f, 0.f, 0.f, 0.f};
        dA[ct] = MFMA16(af, bA, z); dQ[ct] = MFMA16(af, bQ, z);
    }
    LDS_WAIT();
#pragma unroll
    for (int ct = 0; ct < 4; ++ct) {
        u32x2 o; o.x = pk2(dA[ct][0], dA[ct][1]); o.y = pk2(dA[ct][2], dA[ct][3]); *(LAS u32x2*)(sl + SL_AQ + tk * AQ_STR + (16 * ct + 4 * q) * 2) = o;
        o.x = pk2(dQ[ct][0], dQ[ct][1]); o.y = pk2(dQ[ct][2], dQ[ct][3]); *(LAS u32x2*)(sl + SL_AQ + (16 + tk) * AQ_STR + (16 * ct + 4 * q) * 2) = o;
    }
    { u32x2 o; o.x = pk2(Gq[0], Gq[1]); o.y = pk2(Gq[2], Gq[3]); *(LAS u32x2*)(sl + SL_GH + tk * GH_STR + (4 * q) * 2) = o;
      o.x = pk2(Hq[0], Hq[1]); o.y = pk2(Hq[2], Hq[3]); *(LAS u32x2*)(sl + SL_GH + (16 + tk) * GH_STR + (4 * q) * 2) = o; }
#pragma unroll
    for (int ct = 0; ct < 4; ++ct) {
        const unsigned bw[2] = {Bbp[ct].x, Bbp[ct].y}, kw[2] = {Kbp[ct].x, Kbp[ct].y};
        const unsigned vw[2] = {vvp[ct].x, vvp[ct].y};
#pragma unroll
        for (int j = 0; j < 4; ++j) {
            const int c = 16 * ct + 4 * q + j; const int sh = (j & 1) * 16;
            *(LAS unsigned short*)(sl + SL_BT + c * BT_STR + tk * 2) = (unsigned short)(bw[j >> 1] >> sh);
            *(LAS unsigned short*)(sl + SL_KT + c * T_STR + tk * 2) = (unsigned short)(kw[j >> 1] >> sh);
            *(LAS unsigned short*)(sl + SL_VT + c * T_STR + tk * 2) = (unsigned short)(vw[j >> 1] >> sh);
        }
    }
    flag_set(FLG + hw, k + 1, ln);
}
DI void rw_post_chunk(LAS unsigned char* lds, const RwSeq& sq, int m, int hw, int lane_) {
    int lane = lane_; asm volatile("" : "+v"(lane));
    LAS unsigned char* sl = lds + RW_SLOTS + hw * SLOT_BYTES;
    const int tk = lane >> 2, cq = lane & 3, c0 = 16 * cq, t = 16 * m + tk;
    const LAS float* yb = (const LAS float*)(sl + SL_AQ) + tk * 64 + c0;
    const LAS float* CV = (const LAS float*)(lds + RW_CV);
    f32x4 y[4]; float s = 0.f;
#pragma unroll
    for (int i = 0; i < 4; ++i) { y[i] = *(const LAS f32x4*)(yb + 4 * i); s += (y[i][0] + y[i][1]) + (y[i][2] + y[i][3]); }
    const float mu = quad_sum(s) * (1.f / 64.f);
    float qv = 0.f;
#pragma unroll
    for (int i = 0; i < 4; ++i) { y[i] = y[i] - mu; qv += (y[i][0] * y[i][0] + y[i][1] * y[i][1]) + (y[i][2] * y[i][2] + y[i][3] * y[i][3]); }
    const float rs = __builtin_amdgcn_rsqf(quad_sum(qv) * (1.f / 64.f) + 64e-5f);
    const float bon = *(const LAS float*)(sl + SL_BON + tk * 4);
    const LAS bf16_t* pbp = (const LAS bf16_t*)(sl + SL_PB) + tk * 128 + c0;
    float g[16], v[16];
    { float t8[8]; unpk8(*(const LAS u32x4*)pbp, t8);
#pragma unroll
      for (int j = 0; j < 8; ++j) g[j] = t8[j];
      unpk8(*(const LAS u32x4*)(pbp + 8), t8);
#pragma unroll
      for (int j = 0; j < 8; ++j) g[8 + j] = t8[j];
      unpk8(*(const LAS u32x4*)(pbp + 64), t8);
#pragma unroll
      for (int j = 0; j < 8; ++j) v[j] = t8[j];
      unpk8(*(const LAS u32x4*)(pbp + 72), t8);
#pragma unroll
      for (int j = 0; j < 8; ++j) v[8 + j] = t8[j]; }
    f32x4 o[4];
#pragma unroll
    for (int i = 0; i < 4; ++i) {
        const f32x4 lg = *(const LAS f32x4*)(CV + CV_LG * 64 + c0 + 4 * i), lb = *(const LAS f32x4*)(CV + CV_LB * 64 + c0 + 4 * i);
#pragma unroll
        for (int j = 0; j < 4; ++j) o[i][j] = ((y[i][j] * rs) * lg[j] + lb[j] + v[4 * i + j] * bon) * g[4 * i + j];
    }
    GAS bf16_t* op = sq.mix + (size_t)t * 1024 + 512 + 64 * sq.h + c0;
    *(GAS u32x4*)op = pk8(o[0], o[1]); *(GAS u32x4*)(op + 8) = pk8(o[2], o[3]);
}
DI bf16x8 pack_acc8(const f32x16& x, int s2) {
    u32x4 w;
    if (s2 == 0) { w.x = pk2(x[0], x[1]); w.y = pk2(x[2], x[3]); w.z = pk2(x[4], x[5]); w.w = pk2(x[6], x[7]); }
    else { w.x = pk2(x[8], x[9]); w.y = pk2(x[10], x[11]); w.z = pk2(x[12], x[13]); w.w = pk2(x[14], x[15]); }
    return __builtin_bit_cast(bf16x8, w);
}
DI void rwkv_phase(const Params& p, LAS unsigned char* lds, int G, int kwid) {
    const int wid = kwid;
    unsigned char* ws = p.ws;
    volatile LAS unsigned* FLG = (volatile LAS unsigned*)(lds + RW_FLG);
    for (int it = blockIdx.x; it < 2 * BATCH * 8; it += G) {
        const bool samp = it >= BATCH * 8;
        const int bh = samp ? it - BATCH * 8 : it, b = bh >> 3, h = bh & 7;
        RwSeq sq;
        const int row0 = samp ? MP + b * DEC_SEQ : b * SEQ;
        sq.prw = (const GAS bf16_t*)(ws + WS_PRW) + (size_t)row0 * RW_COLS;
        sq.mix = (GAS bf16_t*)(ws + WS_MIX) + (size_t)row0 * 1024;
        sq.act = (const GAS bf16_t*)(ws + WS_X1B) + (size_t)row0 * 288;
        sq.shift0 = samp ? (const GAS float*)p.in[5] + (size_t)b * RW_COLS : nullptr;
        sq.wkv0 = samp ? (const GAS float*)p.in[4] + (size_t)bh * 4096 : nullptr;
        sq.wkv_out = (GAS float*)p.out + (samp ? O_SW : O_PW) + (size_t)bh * 4096;
        sq.ntok = samp ? DEC_SEQ : SEQ; sq.h = h;
        const int NC = sq.ntok / 16;
        __syncthreads();
        int td = wid * 64 + lane_id(); asm volatile("" : "+v"(td));
        { const GAS bf16_t* W2T = (const GAS bf16_t*)(ws + WS_W2T) + (size_t)(64 * h) * 64; const GAS bf16_t* A2T = (const GAS bf16_t*)(ws + WS_A2T) + (size_t)(64 * h) * 64;
          const GAS bf16_t* G2T = (const GAS bf16_t*)(ws + WS_G2T) + (size_t)(64 * h) * 160;
          { const int row = td >> 3, ch = td & 7;
            *(LAS u32x4*)(lds + RW_LW2 + row * 144 + ch * 16) = *(const GAS u32x4*)(W2T + row * 64 + ch * 8);
            *(LAS u32x4*)(lds + RW_LA2 + row * 144 + ch * 16) = *(const GAS u32x4*)(A2T + row * 64 + ch * 8); }
          for (int i = td; i < 64 * 20; i += 512) { const int row = i / 20, ch = i % 20; *(LAS u32x4*)(lds + RW_LG2 + row * 336 + ch * 16) = *(const GAS u32x4*)(G2T + row * 160 + ch * 8); }
          LAS float* CV = (LAS float*)(lds + RW_CV);
          if (td < 64) {
              const int c = 64 * h + td;
              CV[CV_W0 * 64 + td] = ((const GAS float*)p.in[12])[c]; CV[CV_A0 * 64 + td] = ((const GAS float*)p.in[14])[c];
              CV[CV_KK * 64 + td] = ((const GAS float*)p.in[17])[c]; CV[CV_KA * 64 + td] = ((const GAS float*)p.in[18])[c];
              CV[CV_RK * 64 + td] = ((const GAS float*)p.in[19])[c]; CV[CV_LG * 64 + td] = ((const GAS float*)p.in[20])[c];
              CV[CV_LB * 64 + td] = ((const GAS float*)p.in[21])[c];
              const GAS float* mu = (const GAS float*)p.in[11];
              CV[CV_MR * 64 + td] = mu[c]; CV[CV_MK * 64 + td] = mu[512 + c]; CV[CV_MV * 64 + td] = mu[1024 + c];
          }
          if (td >= 64 && td < 64 + 288) ((LAS float*)(lds + RW_MUL))[td - 64] = ((const GAS float*)p.in[11])[1536 + td - 64];
          if (td >= 384 && td < 384 + 24) FLG[td - 384] = 0u;
        }
        __syncthreads();
        if (wid == 0) {
            __builtin_amdgcn_s_setprio(3);
            int ln = lane_id(); asm volatile("" : "+v"(ln));
            const int r = ln & 31, hh = ln >> 5;
            f32x16 St[2][2];
#pragma unroll
            for (int jt = 0; jt < 2; ++jt)
#pragma unroll
                for (int nt = 0; nt < 2; ++nt)
#pragma unroll
                    for (int g4 = 0; g4 < 4; ++g4) {
                        f32x4 x = {0.f, 0.f, 0.f, 0.f};
                        if (sq.wkv0) x = *(const GAS f32x4*)(sq.wkv0 + (size_t)(32 * nt + r) * 64 + 32 * jt + 8 * g4 + 4 * hh);
                        St[jt][nt][4 * g4] = x[0]; St[jt][nt][4 * g4 + 1] = x[1]; St[jt][nt][4 * g4 + 2] = x[2]; St[jt][nt][4 * g4 + 3] = x[3];
                    }
            for (int m = 0; m < NC; ++m) {
                const int hw = m % NHELP; const unsigned k = (unsigned)(m / NHELP);
                LAS unsigned char* sl = lds + RW_SLOTS + hw * SLOT_BYTES;
                flag_wait(FLG + hw, k + 1);
                f32x16 P1[2];
#pragma unroll
                for (int nt = 0; nt < 2; ++nt)
#pragma unroll
                    for (int i = 0; i < 16; ++i) P1[nt][i] = 0.f;
#pragma unroll
                for (int jt = 0; jt < 2; ++jt)
#pragma unroll
                    for (int s2 = 0; s2 < 2; ++s2) {
                        const LAS unsigned char* ap = sl + SL_AQ + r * AQ_STR + (32 * jt + 16 * s2 + 4 * hh) * 2;
                        const u32x2 a0 = *(const LAS u32x2*)ap, a1 = *(const LAS u32x2*)(ap + 16);
                        u32x4 aw_; aw_.x = a0.x; aw_.y = a0.y; aw_.z = a1.x; aw_.w = a1.y;
                        const bf16x8 af = __builtin_bit_cast(bf16x8, aw_);
#pragma unroll
                        for (int nt = 0; nt < 2; ++nt) P1[nt] = MFMA32(af, pack_acc8(St[jt][nt], s2), P1[nt]);
                    }
                bf16x8 vf[2];
                { const bf16x8 gf = *(const LAS bf16x8*)(sl + SL_GH + r * GH_STR + hh * 16);
#pragma unroll
                  for (int nt = 0; nt < 2; ++nt) { vf[nt] = *(const LAS bf16x8*)(sl + SL_VT + (32 * nt + r) * T_STR + hh * 16); P1[nt] = MFMA32(gf, vf[nt], P1[nt]); } }
#pragma unroll
                for (int jt = 0; jt < 2; ++jt) {
                    const LAS unsigned char* bp = sl + SL_BT + (32 * jt + r) * BT_STR + (4 * hh) * 2;
                    const u32x2 b0 = *(const LAS u32x2*)bp, b1 = *(const LAS u32x2*)(bp + 16);
                    u32x4 bw_; bw_.x = b0.x; bw_.y = b0.y; bw_.z = b1.x; bw_.w = b1.y;
                    const bf16x8 bf_ = __builtin_bit_cast(bf16x8, bw_);
                    const bf16x8 kf_ = *(const LAS bf16x8*)(sl + SL_KT + (32 * jt + r) * T_STR + hh * 16);
                    f32x4 wv[4];
#pragma unroll
                    for (int g4 = 0; g4 < 4; ++g4) wv[g4] = *(const LAS f32x4*)(sl + SL_WV + (32 * jt + 8 * g4 + 4 * hh) * 4);
#pragma unroll
                    for (int nt = 0; nt < 2; ++nt) {
                        f32x16 c_;
#pragma unroll
                        for (int i = 0; i < 16; ++i) c_[i] = St[jt][nt][i] * wv[i >> 2][i & 3];
                        c_ = MFMA32(bf_, pack_acc8(P1[nt], 0), c_);
                        St[jt][nt] = MFMA32(kf_, vf[nt], c_);
                    }
                }
                asm volatile("s_waitcnt lgkmcnt(0)" ::: "memory");
#pragma unroll
                for (int nt = 0; nt < 2; ++nt)
#pragma unroll
                    for (int i = 8; i < 16; ++i) { const int t_ = (i & 3) + 8 * ((i >> 2) & 1) + 4 * hh; *(LAS float*)(sl + SL_AQ + (t_ * 64 + 32 * nt + r) * 4) = P1[nt][i]; }
                flag_set(FLG + 8 + hw, k + 1, ln);
            }
#pragma unroll
            for (int jt = 0; jt < 2; ++jt)
#pragma unroll
                for (int nt = 0; nt < 2; ++nt)
#pragma unroll
                    for (int g4 = 0; g4 < 4; ++g4)
                        *(GAS f32x4*)(sq.wkv_out + (size_t)(32 * nt + r) * 64 + 32 * jt + 8 * g4 + 4 * hh) = (f32x4){St[jt][nt][4 * g4], St[jt][nt][4 * g4 + 1], St[jt][nt][4 * g4 + 2], St[jt][nt][4 * g4 + 3]};
            __builtin_amdgcn_s_setprio(0);
        } else if (wid != 4) {
            int ln = lane_id(); asm volatile("" : "+v"(ln));
            const int hw = wid < 4 ? wid - 1 : wid - 2;
            unsigned k = 0;
            for (int m = hw; m < NC; m += NHELP, ++k) rw_helper_chunk(lds, sq, m, k, hw, ln);
        } else {
            int ln = lane_id(); asm volatile("" : "+v"(ln));
            for (int m = 0; m < NC; ++m) {
                const int hw = m % NHELP; const unsigned k = (unsigned)(m / NHELP);
                flag_wait(FLG + 8 + hw, k + 1);
                rw_post_chunk(lds, sq, m, hw, ln);
                flag_set(FLG + 16 + hw, k + 1, ln);
            }
        }
    }
    __syncthreads();
}

#define XB_TMO      128
#define XB_XCNT(j)  (256  + 64 * (j))
#define XB_XSUB(j)  (1280 + 64 * (j))
#define XB_XGEN(j)  (2304 + 64 * (j))
#define XB_TOP      3328
#define XB_TOPGEN   3392
#define XCD_BAR_WORDS 3456
#define XB_SPIN_CAP (1u << 18)

__device__ __forceinline__ unsigned xb_ld(unsigned* p)              { return __hip_atomic_load(p, __ATOMIC_RELAXED, __HIP_MEMORY_SCOPE_AGENT); }
__device__ __forceinline__ unsigned xb_add(unsigned* p, unsigned v) { return __hip_atomic_fetch_add(p, v, __ATOMIC_RELAXED, __HIP_MEMORY_SCOPE_AGENT); }
__device__ __forceinline__ unsigned xb_xcc_id() { return (unsigned)__builtin_amdgcn_s_getreg((3 << 11) | 20) & 0xFu; }
#define XB_SPIN(cond, bar) do { unsigned _sp = 0; while (cond) { __builtin_amdgcn_s_sleep(1); \
    if ((++_sp & 255u) == 0u) { if (xb_ld(&(bar)[XB_TMO])) break; if (_sp > XB_SPIN_CAP) { atomicAdd(&(bar)[XB_TMO], 1u); break; } } } } while (0)

struct XcdBarrier {
    int wid;
    unsigned* bar; unsigned x;
    volatile LAS unsigned* st;
};

__device__ __forceinline__ XcdBarrier xcd_barrier_post(unsigned* bar, volatile LAS unsigned* st, int kwid) {
    XcdBarrier b; b.wid = kwid; b.bar = bar; b.x = xb_xcc_id(); b.st = st;
    if (kwid == 0 && lane_id() == 0) (void)xb_add(&bar[XB_XCNT(b.x)], 1u);
    return b;
}
__device__ __forceinline__ void xcd_barrier_complete(unsigned* bar, unsigned x, unsigned& nloc, unsigned& nx) {
    const unsigned G = gridDim.x * gridDim.y * gridDim.z;
    unsigned sum, cnt, mine, sp = 0u;
    for (;;) {
        sum = 0u; cnt = 0u; mine = 0u;
#pragma unroll
        for (unsigned j = 0; j < 16; ++j) { const unsigned c = xb_ld(&bar[XB_XCNT(j)]); sum += c; cnt += (c > 0u) ? 1u : 0u; mine = (j == x) ? c : mine; }
        if (sum == G) break;
        __builtin_amdgcn_s_sleep(1);
        if ((++sp & 255u) == 0u) { if (xb_ld(&bar[XB_TMO])) break; if (sp > XB_SPIN_CAP) { atomicAdd(&bar[XB_TMO], 1u); break; } }
    }
    nloc = mine > 0u ? mine : 1u; nx = cnt > 0u ? cnt : 1u;
}

__device__ __forceinline__ void xcd_barrier(const XcdBarrier& b) {
    asm volatile("s_waitcnt vmcnt(0)" ::: "memory");
    __syncthreads();
    if (b.wid == 0 && lane_id() == 0) {
        unsigned* bar = b.bar;
        __builtin_amdgcn_s_waitcnt(0);
        unsigned nloc = b.st[0], nx = b.st[1];
        if (nloc == 0u) { xcd_barrier_complete(bar, b.x, nloc, nx); b.st[0] = nloc; b.st[1] = nx; }
        const unsigned old = xb_add(&bar[XB_XSUB(b.x)], 1u);
        const unsigned gen = old / nloc;
        if (old + 1u == (gen + 1u) * nloc) {
            __builtin_amdgcn_fence(__ATOMIC_RELEASE, "agent");
            asm volatile("s_waitcnt vmcnt(0)" ::: "memory");
            const unsigned og = xb_add(&bar[XB_TOP], 1u);
            const unsigned tg = og / nx;
            if (og + 1u == (tg + 1u) * nx) xb_add(&bar[XB_TOPGEN], 1u);
            else XB_SPIN(xb_ld(&bar[XB_TOPGEN]) == tg, bar);
            __builtin_amdgcn_fence(__ATOMIC_ACQUIRE, "agent");
            xb_add(&bar[XB_XGEN(b.x)], 1u);
            asm volatile("s_waitcnt vmcnt(0)" ::: "memory");
        } else {
            XB_SPIN(xb_ld(&bar[XB_XGEN(b.x)]) == gen, bar);
            __builtin_amdgcn_fence(__ATOMIC_ACQUIRE, "agent");
            asm volatile("s_waitcnt vmcnt(0)" ::: "memory");
        }
    }
    __syncthreads();
}

DI void finish_out(const Params& p, int G, int kwid) {
    const int lane = lane_id(), gw = blockIdx.x * 8 + kwid, NGW = G * 8;
    const GAS float* slab = (const GAS float*)(p.ws + WS_SLAB); const GAS float* xs = (const GAS float*)p.in[1];
    GAS float* out = (GAS float*)p.out; GAS bf16_t* X1B = (GAS bf16_t*)(p.ws + WS_X1B); GAS float* SSQ = (GAS float*)(p.ws + WS_SSQ);
    for (int r = gw; r < MS; r += NGW) {
        float ss = 0.f;
#pragma unroll
        for (int j = 0; j < 4; ++j) {
            const size_t o = (size_t)r * 1024 + 4 * lane + 256 * j;
            f32x4 v = *(const GAS f32x4*)(xs + o);
#pragma unroll
            for (int sp = 0; sp < SPLIT_OUT; ++sp) v += *(const GAS f32x4*)(slab + (size_t)sp * MS * 1024 + o);
            *(GAS f32x4*)(out + (size_t)MP * 1024 + o) = v;
            u32x2 w; w.x = pk2(v[0], v[1]); w.y = pk2(v[2], v[3]); *(GAS u32x2*)(X1B + (size_t)MP * 1024 + o) = w;
            ss += (v[0] * v[0] + v[1] * v[1]) + (v[2] * v[2] + v[3] * v[3]);
        }
        ss = wave_sum(ss);
        if (lane < 16) SSQ[(size_t)(MP + r) * 16 + lane] = lane == 0 ? ss : 0.f;
    }
}
DI void finish_down(const Params& p, int G, int kwid) {
    const GAS float* slab = (const GAS float*)(p.ws + WS_SLAB); GAS float* out = (GAS float*)p.out + (size_t)MP * 1024;
    for (int i = blockIdx.x * 512 + kwid * 64 + lane_id(); i < MS * 256; i += G * 512) {
        f32x4 v = *(const GAS f32x4*)(out + (size_t)i * 4);
#pragma unroll
        for (int sp = 0; sp < SPLIT_DN; ++sp) v += *(const GAS f32x4*)(slab + (size_t)sp * MS * 1024 + (size_t)i * 4);
        *(GAS f32x4*)(out + (size_t)i * 4) = v;
    }
}

__global__ void __launch_bounds__(512, 2) fwd_kernel(Params p) {
    extern __shared__ __attribute__((aligned(16))) unsigned char lds_raw[];
    LAS unsigned char* lds = (LAS unsigned char*)lds_raw;
    const int G = gridDim.x;
    unsigned char* ws = p.ws;
    const int lo = p.ph_lo, hi = p.ph_hi;
#define IN(k) (lo <= (k) && (k) < hi)
    const int kwid = __builtin_amdgcn_readfirstlane((int)(threadIdx.x >> 6));
    volatile LAS unsigned* bst = (volatile LAS unsigned*)(lds + LDS_BYTES - 16);
    if (threadIdx.x < 4) bst[threadIdx.x] = 0u;
    __syncthreads();
    const XcdBarrier bar = xcd_barrier_post((unsigned*)(ws + WS_CTL), bst, kwid);
#define SEAM(k) do { if (IN(k) && IN((k) + 1)) { xcd_barrier(bar); } } while (0)
    if (IN(0)) { phase0(p, lds, G, kwid); }
    SEAM(0);
    if (IN(1)) {
        pg8::Gemm g{(const bf16_t*)(ws + WS_H), (const bf16_t*)(ws + WS_WIN), MT, IN_PAD, 1024}; pg8::StaticOrder S; S.init(MT, IN_PAD, 1024, G, (int)blockIdx.x);
        EpiIn E{(GAS bf16_t*)(ws + WS_Q), (GAS bf16_t*)(ws + WS_K), (GAS bf16_t*)(ws + WS_V), (GAS bf16_t*)(ws + WS_PRW), (GAS float*)p.out, (const GAS float*)(ws + WS_ROPE), (const GAS float*)p.in[8], (const GAS float*)p.in[9]};
        pg8::gemm_phase<EpiIn, pg8::StaticOrder>(lds, g, S, E, kwid);
    }
    SEAM(1);
    if (IN(2)) { lora_act_pass(p, G, kwid); attn_phase(p, lds, G, kwid); xcd_barrier(bar); rwkv_phase(p, lds, G, kwid); }
    SEAM(2);
    if (IN(3)) {
        pg8::Gemm g{(const bf16_t*)(ws + WS_MIX), (const bf16_t*)(ws + WS_WOUT), MT, 1024, 1024}; pg8::StaticOrder S; S.init(MT, 1024, 1024, G, (int)blockIdx.x, MP, SPLIT_OUT);
        EpiOut E{(const GAS float*)p.in[0], (const GAS float*)p.in[1], (GAS float*)p.out, (GAS bf16_t*)(ws + WS_X1B), (GAS float*)(ws + WS_SSQ), (GAS float*)(ws + WS_SLAB)};
        pg8::gemm_phase<EpiOut, pg8::StaticOrder>(lds, g, S, E, kwid);
        xcd_barrier(bar);
        finish_out(p, G, kwid);
    }
    SEAM(3);
    if (IN(4)) {
        pg8::Gemm g{(const bf16_t*)(ws + WS_X1B), (const bf16_t*)(ws + WS_WUP), MT, D_FF, 1024}; pg8::StaticOrder S; S.init(MT, D_FF, 1024, G, (int)blockIdx.x);
        EpiUp E{(const GAS float*)(ws + WS_SSQ), (GAS bf16_t*)(ws + WS_U)};
        pg8::gemm_phase<EpiUp, pg8::StaticOrder>(lds, g, S, E, kwid);
    }
    SEAM(4);
    if (IN(5)) {
        pg8::Gemm g{(const bf16_t*)(ws + WS_U), (const bf16_t*)(ws + WS_WDN), MT, 1024, D_FF}; pg8::StaticOrder S; S.init(MT, 1024, D_FF, G, (int)blockIdx.x, MP, SPLIT_DN);
        EpiDown E{(GAS float*)p.out, (GAS float*)(ws + WS_SLAB), (const GAS bf16_t*)(ws + WS_X1B)};
        pg8::gemm_phase<EpiDown, pg8::StaticOrder>(lds, g, S, E, kwid);
        xcd_barrier(bar);
        finish_down(p, G, kwid);
    }
#undef IN
#undef SEAM
}

extern "C" void kernel_launch(void* const* d_in, const int* in_sizes, int n_in, void* d_out, int out_size, void* d_ws, size_t ws_size, hipStream_t stream) {
    static int grid = 0;
    if (grid == 0) {
        if (n_in != 26 || ws_size < WS_END) { fprintf(stderr, "kernel_launch: expected 26 inputs and >= %zu bytes of workspace (got %d, %zu)\n", (size_t)WS_END, n_in, ws_size); grid = -1; return; }
        int dev = 0, cus = 0, per_cu = 0;
        hipGetDevice(&dev);
        hipDeviceGetAttribute(&cus, hipDeviceAttributeMultiprocessorCount, dev);
        if (hipFuncSetAttribute((const void*)fwd_kernel, hipFuncAttributeMaxDynamicSharedMemorySize, LDS_BYTES) != hipSuccess) { fprintf(stderr, "kernel_launch: hipFuncSetAttribute failed\n"); grid = -1; return; }
        if (hipOccupancyMaxActiveBlocksPerMultiprocessor(&per_cu, (const void*)fwd_kernel, 512, LDS_BYTES) != hipSuccess || per_cu < 1) { fprintf(stderr, "kernel_launch: occupancy query failed (%d)\n", per_cu); (void)hipGetLastError(); per_cu = 1; }
        grid = cus * per_cu;
        if (grid > 256) grid = 256;
    }
    if (grid < 0) return;
    Params a{};
    for (int i = 0; i < 26; ++i) a.in[i] = (const float*)d_in[i];
    a.out = (float*)d_out; a.ws = (unsigned char*)d_ws;
#if MK_N_LAUNCHES == 1
    a.ph_lo = 0; a.ph_hi = 6;
    if (hipMemsetAsync((char*)d_ws + WS_CTL, 0, CTL_BYTES, stream) != hipSuccess) { fprintf(stderr, "kernel_launch: memset of the barrier words failed\n"); return; }
    hipLaunchKernelGGL(fwd_kernel, dim3(grid), dim3(512), LDS_BYTES, stream, a);
    { const hipError_t e = hipPeekAtLastError(); if (e != hipSuccess) fprintf(stderr, "launch failed: %s (grid %d)\n", hipGetErrorString(e), grid); }
#else
    for (int ph = 0; ph < 6; ++ph) {
        a.ph_lo = ph; a.ph_hi = ph + 1;
        hipLaunchKernelGGL(fwd_kernel, dim3(grid), dim3(512), LDS_BYTES, stream, a);
    }
#endif
}
```

```cpp
#include <hip/hip_runtime.h>
#include <hip/hip_cooperative_groups.h>
#include <cstdio>
#include <cstdint>
namespace cg = cooperative_groups;

#ifndef MK_N_LAUNCHES
#define MK_N_LAUNCHES 1
#endif

#define GAS __attribute__((address_space(1)))
#define LAS __attribute__((address_space(3)))
typedef unsigned short bf16_t;
typedef short bf16x8 __attribute__((ext_vector_type(8)));
typedef short s16x4 __attribute__((ext_vector_type(4)));
typedef float f32x2 __attribute__((ext_vector_type(2)));
typedef float f32x4 __attribute__((ext_vector_type(4)));
typedef float f32x16 __attribute__((ext_vector_type(16)));
typedef unsigned u32x2 __attribute__((ext_vector_type(2)));
typedef unsigned u32x4 __attribute__((ext_vector_type(4)));
typedef __bf16 bf16v2 __attribute__((ext_vector_type(2)));
#define DI __device__ __forceinline__

constexpr int D_MODEL = 1024, SEQ = 2048, BATCH = 32, DEC_SEQ = 16;
constexpr int MP = BATCH * SEQ;
constexpr int MS = BATCH * DEC_SEQ;
constexpr int MT = MP + MS;
constexpr int IN_COLS = 2592, IN_PAD = 2816;
constexpr int RW_COLS = 1824, D_FF = 4096;
constexpr int NPOS = SEQ + DEC_SEQ;

constexpr size_t O_PK = 67633152, O_PV = 68157440, O_PW = 68681728, O_PS = 69730304, O_SK = 69788672, O_SV = 69854208, O_SW = 69919744, O_SS = 70968320;

constexpr size_t al256(size_t x) { return (x + 255) & ~(size_t)255; }
constexpr size_t WS_WIN = 0;
constexpr size_t WS_WOUT = WS_WIN + (size_t)IN_PAD * 1024 * 2;
constexpr size_t WS_WUP = WS_WOUT + (size_t)1024 * 1024 * 2;
constexpr size_t WS_WDN = WS_WUP + (size_t)4096 * 1024 * 2;
constexpr size_t WS_W2T = WS_WDN + (size_t)4096 * 1024 * 2;
constexpr size_t WS_A2T = WS_W2T + 512 * 64 * 2;
constexpr size_t WS_G2T = WS_A2T + 512 * 64 * 2;
constexpr size_t WS_ROPE = al256(WS_G2T + 512 * 160 * 2);
constexpr size_t WS_SSQ = al256(WS_ROPE + (size_t)NPOS * 64 * 4);
constexpr size_t WS_SS1 = al256(WS_SSQ + (size_t)MT * 16 * 4);
constexpr size_t WS_X1B = al256(WS_SS1 + (size_t)MT * 4);
constexpr size_t WS_H = al256(WS_X1B + (size_t)MT * 1024 * 2);
constexpr size_t WS_Q = WS_H + (size_t)MT * 1024 * 2;
constexpr size_t WS_K = WS_Q + (size_t)MT * 512 * 2;
constexpr size_t WS_V = WS_K + (size_t)MT * 128 * 2;
constexpr size_t WS_PRW = WS_V + (size_t)MT * 128 * 2;
constexpr size_t WS_MIX = WS_PRW + (size_t)MT * RW_COLS * 2;
constexpr size_t WS_AEND = WS_MIX + (size_t)MT * 1024 * 2;
constexpr size_t WS_U = WS_H;
static_assert(WS_U + (size_t)MT * 4096 * 2 <= WS_AEND, "U overlay");
constexpr size_t WS_CTL = al256(WS_AEND);
constexpr size_t CTL_BYTES = 16384;
constexpr int SPLIT_OUT = 4, SPLIT_DN = 16;
constexpr size_t WS_SLAB = WS_CTL + CTL_BYTES;
constexpr size_t WS_END = WS_SLAB + (size_t)SPLIT_DN * MS * 1024 * 4;
static_assert(WS_END <= (size_t)1 << 30, "workspace");

constexpr int LDS_BYTES = 163840;

DI unsigned pk2(float lo, float hi) { f32x2 v = {lo, hi}; return __builtin_bit_cast(unsigned, __builtin_convertvector(v, bf16v2)); }
DI float bf2f(unsigned short b) { return __builtin_bit_cast(float, (unsigned)b << 16); }
DI float bflo(unsigned w) { return __builtin_bit_cast(float, w << 16); }
DI float bfhi(unsigned w) { return __builtin_bit_cast(float, w & 0xffff0000u); }
DI u32x4 pk8(f32x4 a, f32x4 b) { u32x4 w; w.x = pk2(a[0], a[1]); w.y = pk2(a[2], a[3]); w.z = pk2(b[0], b[1]); w.w = pk2(b[2], b[3]); return w; }
DI float wave_sum(float v) {
#pragma unroll
    for (int o = 1; o < 64; o <<= 1) v += __shfl_xor(v, o);
    return v;
}
template <int CTRL> DI float dpp_f(float x) { return __builtin_bit_cast(float, __builtin_amdgcn_mov_dpp(__builtin_bit_cast(int, x), CTRL, 0xf, 0xf, true)); }
DI float quad_sum(float x) { x += dpp_f<0xB1>(x); x += dpp_f<0x4E>(x); return x; }
DI float oct_sum(float x) { x = quad_sum(x); x += dpp_f<0x141>(x); return x; }
#define LDS_WAIT() asm volatile("s_waitcnt lgkmcnt(0)" ::: "memory")
DI int lane_id() { int x; asm volatile("v_mbcnt_lo_u32_b32 %0, -1, 0\n\tv_mbcnt_hi_u32_b32 %0, -1, %0" : "=v"(x)); return x; }

namespace pg8 {
constexpr int BM = 256, BK = 64, HALF = 128, HTB = HALF * BK * 2, STAGE_BYTES = 8 * HTB, NXCD = 8, WGM = 8;
__host__ __device__ __forceinline__ int lds_byte(int r, int c) { const int st = (r >> 4) * 2 + (c >> 5), rr = r & 15, cc = c & 31, ob = rr * 64 + cc * 2; return st * 1024 + (ob ^ (((ob >> 9) & 1) << 5)); }
__host__ __device__ __forceinline__ void stage_rc(int b, int& R, int& C) { const int st = b / 1024, sb = b % 1024, swz = sb ^ (((sb >> 9) & 1) << 5); R = (st >> 1) * 16 + swz / 64; C = (st & 1) * 32 + (swz % 64) / 2; }
struct Unit { int pm, pn, k0, nk, slab; };
struct Gemm { const bf16_t* A; const bf16_t* Bt; int M, N, K; };
struct StaticOrder {
    int nM, nMm, nN, nwg, ntail, S, nkt, G, c;
    __host__ __device__ void init(int M, int N, int K, int G_, int c_, int Mmain = 0, int S_ = 1) {
        nM = M / BM; nN = N / BM; nkt = K / BK; G = G_; c = c_;
        nMm = Mmain ? Mmain / BM : nM; S = S_; nwg = nMm * nN; ntail = (nM - nMm) * nN * S;
    }
    __host__ __device__ bool next(int i, Unit& u) const {
        const long L = (long)i * G + c; if (L >= nwg + ntail) return false;
        const bool tail = L >= nwg;
        const int e = tail ? (int)(L - nwg) : 0;
        int wgid = tail ? 0 : (int)L; { const int q = nwg / NXCD, r = nwg % NXCD, xcd = wgid % NXCD, off = wgid / NXCD; wgid = (xcd < r ? xcd * (q + 1) : r * (q + 1) + (xcd - r) * q) + off; }
        const int nig = WGM * nN, gid = wgid / nig, fm = gid * WGM, gsz = (nMm - fm) < WGM ? (nMm - fm) : WGM;
        const int mpm = fm + ((wgid % nig) % gsz), mpn = (wgid % nig) / gsz;
        const int tsl = e % S, tnk = nkt / S;
        u.pm = tail ? nMm + e / (nN * S) : mpm; u.pn = tail ? (e / S) % nN : mpn;
        u.slab = tail ? tsl : -1; u.nk = tail ? tnk : nkt; u.k0 = tail ? tsl * tnk : 0;
        return true;
    }
};
template <class Epi, class Sched, bool ALIGN_EPI = true, bool SP2 = true>
__device__ __forceinline__ void gemm_phase(LAS unsigned char* lds, const Gemm g, const Sched& S, const Epi& E, int kwid) {
    const int lane = lane_id(), wid = kwid, tid = wid * 64 + lane, wr = wid >> 2, wc = wid & 3, fr = lane & 15, fq = lane >> 4;
    const int K = g.K;
    unsigned voffA[2];
#pragma unroll
    for (int i = 0; i < 2; ++i) { int R, C; stage_rc(tid * 16 + i * 8192, R, C); voffA[i] = (unsigned)(R * K + C) * 2u; }
    const size_t kstep = (size_t)(BK * 2);
    const size_t hstep = (size_t)HALF * K * 2;
    const size_t tstep = 2 * hstep;
    const unsigned ldsw = (unsigned)wid * 1024u;
    const int aoff = lds_byte(wr * 64 + fr, fq * 8), boff = lds_byte(wc * 32 + fr, fq * 8);
#define PG8_SA(b, h) (((b) * 2 + (h)) * HTB)
#define PG8_SB(b, h) ((4 + (b) * 2 + (h)) * HTB)
#define PG8_STAGE(bufoff, gbase, voff) do { _Pragma("unroll") for (int _i = 0; _i < 2; ++_i) \
        __builtin_amdgcn_global_load_lds((const unsigned*)((const char*)(gbase) + (voff)[_i]), (LAS unsigned*)(lds + (bufoff) + ldsw + _i * 8192), 16, 0, 0); } while (0)
#define PG8_LDA(dst, b, h) do { _Pragma("unroll") for (int m = 0; m < 4; ++m) _Pragma("unroll") for (int k = 0; k < 2; ++k) dst[m][k] = *(const LAS bf16x8*)(lds + PG8_SA(b, h) + aoff + m * 2048 + k * 1024); } while (0)
#define PG8_LDB(dst, b, h) do { _Pragma("unroll") for (int n = 0; n < 2; ++n) _Pragma("unroll") for (int k = 0; k < 2; ++k) dst[n][k] = *(const LAS bf16x8*)(lds + PG8_SB(b, h) + boff + n * 2048 + k * 1024); } while (0)
#define PG8_MMA(ai, bj, At, Bt) do { __builtin_amdgcn_s_setprio(1); _Pragma("unroll") for (int m = 0; m < 4; ++m) _Pragma("unroll") for (int n = 0; n < 2; ++n) _Pragma("unroll") for (int k = 0; k < 2; ++k) \
        acc[ai][bj][m][n] = __builtin_amdgcn_mfma_f32_16x16x32_bf16(Bt[n][k], At[m][k], acc[ai][bj][m][n], 0, 0, 0); __builtin_amdgcn_s_setprio(0); } while (0)
#define PG8_WAIT_V(n) asm volatile("s_waitcnt vmcnt(" #n ")" ::: "memory")
#define PG8_WAIT_L(n) asm volatile("s_waitcnt lgkmcnt(" #n ")" ::: "memory")
#define PG8_BAR __builtin_amdgcn_s_barrier()
#define PG8_SCHED __builtin_amdgcn_sched_barrier(0)
    Unit cur, nxt; int ui = 0;
    if (!S.next(0, cur)) return;
    f32x4 acc[2][2][4][2];
#pragma unroll
    for (int a = 0; a < 2; ++a)
#pragma unroll
        for (int b = 0; b < 2; ++b)
#pragma unroll
            for (int m = 0; m < 4; ++m)
#pragma unroll
                for (int n = 0; n < 2; ++n) acc[a][b][m][n] = (f32x4){0.f, 0.f, 0.f, 0.f};
    bf16x8 At[4][2], B0[2][2], B1[2][2];
    const char* cA = (const char*)g.A + (size_t)cur.pm * tstep + (size_t)cur.k0 * kstep; const char* cB = (const char*)g.Bt + (size_t)cur.pn * tstep + (size_t)cur.k0 * kstep;
    if constexpr (SP2) {
        PG8_STAGE(PG8_SB(0, 0), cB, voffA); PG8_STAGE(PG8_SB(0, 1), cB + hstep, voffA); PG8_STAGE(PG8_SA(0, 0), cA, voffA); PG8_STAGE(PG8_SA(0, 1), cA + hstep, voffA);
        if (wr == 1) PG8_BAR;
        PG8_WAIT_V(2); PG8_BAR;
        PG8_STAGE(PG8_SB(1, 0), cB + kstep, voffA); PG8_STAGE(PG8_SA(1, 0), cA + kstep, voffA); PG8_STAGE(PG8_SB(1, 1), cB + hstep + kstep, voffA);
        PG8_WAIT_V(6); PG8_BAR;
    } else {
        PG8_STAGE(PG8_SB(0, 0), cB, voffA); PG8_STAGE(PG8_SA(0, 0), cA, voffA); PG8_STAGE(PG8_SB(0, 1), cB + hstep, voffA); PG8_STAGE(PG8_SA(0, 1), cA + hstep, voffA);
        if (wr == 1) PG8_BAR;
        PG8_WAIT_V(4); PG8_BAR;
        PG8_STAGE(PG8_SB(1, 0), cB + kstep, voffA); PG8_STAGE(PG8_SA(1, 0), cA + kstep, voffA); PG8_STAGE(PG8_SB(1, 1), cB + hstep + kstep, voffA);
        PG8_WAIT_V(6); PG8_BAR;
    }
    for (;;) {
        const bool has_next = S.next(ui + 1, nxt);
        const char* nA = has_next ? (const char*)g.A + (size_t)nxt.pm * tstep + (size_t)nxt.k0 * kstep : cA; const char* nB = has_next ? (const char*)g.Bt + (size_t)nxt.pn * tstep + (size_t)nxt.k0 * kstep : cB;
        const int nt = cur.nk;
        for (int t = 0; t < nt; t += 2) {
            const bool last = (t == nt - 2);
            const char* a1 = cA + (size_t)(t + 1) * kstep;
            const char* a2 = last ? nA : cA + (size_t)(t + 2) * kstep; const char* b2 = last ? nB : cB + (size_t)(t + 2) * kstep;
            const char* a3 = a2 + kstep; const char* b3 = b2 + kstep;
            if constexpr (SP2) {
            PG8_LDB(B0, 0, 0); PG8_LDB(B1, 0, 1); PG8_SCHED; PG8_LDA(At, 0, 0); PG8_STAGE(PG8_SA(1, 1), a1 + hstep, voffA);
            PG8_WAIT_V(8); PG8_WAIT_L(0); PG8_BAR; PG8_MMA(0, 0, At, B0); PG8_MMA(0, 1, At, B1); PG8_BAR; PG8_SCHED;
            PG8_LDA(At, 0, 1); PG8_STAGE(PG8_SB(0, 0), b2, voffA); PG8_STAGE(PG8_SB(0, 1), b2 + hstep, voffA); PG8_STAGE(PG8_SA(0, 0), a2, voffA);
            PG8_WAIT_V(8); PG8_WAIT_L(0); PG8_BAR; PG8_MMA(1, 0, At, B0); PG8_MMA(1, 1, At, B1); PG8_BAR; PG8_SCHED;
            PG8_LDB(B0, 1, 0); PG8_LDB(B1, 1, 1); PG8_SCHED; PG8_LDA(At, 1, 0); PG8_STAGE(PG8_SA(0, 1), a2 + hstep, voffA);
            PG8_WAIT_V(8); PG8_WAIT_L(0); PG8_BAR; PG8_MMA(0, 0, At, B0); PG8_MMA(0, 1, At, B1); PG8_BAR; PG8_SCHED;
            PG8_LDA(At, 1, 1); PG8_STAGE(PG8_SB(1, 0), b3, voffA); PG8_STAGE(PG8_SB(1, 1), b3 + hstep, voffA); PG8_STAGE(PG8_SA(1, 0), a3, voffA);
            PG8_WAIT_V(8); PG8_WAIT_L(0); PG8_BAR; PG8_MMA(1, 0, At, B0); PG8_MMA(1, 1, At, B1); PG8_BAR; PG8_SCHED;
            } else {
            PG8_LDB(B0, 0, 0); PG8_SCHED; PG8_LDA(At, 0, 0); PG8_STAGE(PG8_SA(1, 1), a1 + hstep, voffA);
            PG8_WAIT_L(8); PG8_BAR; PG8_WAIT_L(0); PG8_MMA(0, 0, At, B0); PG8_BAR; PG8_SCHED;
            PG8_LDB(B1, 0, 1); PG8_STAGE(PG8_SB(0, 0), b2, voffA);
            PG8_BAR; PG8_WAIT_L(0); PG8_MMA(0, 1, At, B1); PG8_BAR;
            PG8_LDA(At, 0, 1); PG8_STAGE(PG8_SA(0, 0), a2, voffA);
            PG8_BAR; PG8_WAIT_L(0); PG8_MMA(1, 0, At, B0); PG8_BAR; PG8_SCHED;
            PG8_STAGE(PG8_SB(0, 1), b2 + hstep, voffA);
            PG8_WAIT_V(6); PG8_BAR; PG8_MMA(1, 1, At, B1); PG8_BAR;
            PG8_LDB(B0, 1, 0); PG8_SCHED; PG8_LDA(At, 1, 0); PG8_STAGE(PG8_SA(0, 1), a2 + hstep, voffA);
            PG8_WAIT_L(8); PG8_BAR; PG8_WAIT_L(0); PG8_MMA(0, 0, At, B0); PG8_BAR; PG8_SCHED;
            PG8_LDB(B1, 1, 1); PG8_STAGE(PG8_SB(1, 0), b3, voffA);
            PG8_BAR; PG8_WAIT_L(0); PG8_MMA(0, 1, At, B1); PG8_BAR;
            PG8_LDA(At, 1, 1); PG8_STAGE(PG8_SA(1, 0), a3, voffA);
            PG8_BAR; PG8_WAIT_L(0); PG8_MMA(1, 0, At, B0); PG8_BAR; PG8_SCHED;
            PG8_STAGE(PG8_SB(1, 1), b3 + hstep, voffA);
            PG8_WAIT_V(6); PG8_BAR; PG8_MMA(1, 1, At, B1); PG8_BAR;
            }
        }
        if constexpr (ALIGN_EPI) { if (wr == 0) PG8_BAR; }
        E(acc, cur, wr, wc, fr, fq);
        if (!has_next) break;
#pragma unroll
        for (int a = 0; a < 2; ++a)
#pragma unroll
            for (int b = 0; b < 2; ++b)
#pragma unroll
                for (int m = 0; m < 4; ++m)
#pragma unroll
                    for (int n = 0; n < 2; ++n) acc[a][b][m][n] = (f32x4){0.f, 0.f, 0.f, 0.f};
        cur = nxt; cA = nA; cB = nB; ++ui;
        if constexpr (ALIGN_EPI) { if (wr == 1) PG8_BAR; }
    }
    PG8_WAIT_V(0);
    if constexpr (!ALIGN_EPI) { if (wr == 0) PG8_BAR; }
    PG8_BAR;
#undef PG8_SA
#undef PG8_SB
#undef PG8_STAGE
#undef PG8_LDA
#undef PG8_LDB
#undef PG8_MMA
#undef PG8_WAIT_V
#undef PG8_WAIT_L
#undef PG8_BAR
#undef PG8_SCHED
}
}

enum { MAP_NAT = 0, MAP_A = 1, MAP_B = 2 };
DI int rowmap(int mode, int c) {
    if (mode == MAP_NAT) return c;
    if (mode == MAP_A) { const int rem = c & 31; return (c & ~31) + 16 * ((rem >> 2) & 1) + 4 * (rem >> 3) + (rem & 3); }
    const int rem = c & 255; return (c & ~255) + 128 * ((rem >> 5) & 1) + 32 * (rem >> 6) + 16 * ((rem >> 2) & 1) + 4 * ((rem >> 3) & 3) + (rem & 3);
}

struct EpiIn {
    GAS bf16_t* Q; GAS bf16_t* Kb; GAS bf16_t* Vb; GAS bf16_t* PRW; GAS float* out; const GAS float* rope; const GAS float* qg; const GAS float* kg;
    DI void operator()(const f32x4 (&acc)[2][2][4][2], const pg8::Unit& u, int wr, int wc, int fr, int fq) const {
        const int H = u.pn * 4 + wc;
        const int row0 = u.pm * 256 + wr * 64 + fr;
        if (H < 10) {
            const bool isq = H < 8;
            const GAS float* g = isq ? qg : kg;
            f32x4 gv[2][2];
#pragma unroll
            for (int bj = 0; bj < 2; ++bj)
#pragma unroll
                for (int n = 0; n < 2; ++n) gv[bj][n] = *(const GAS f32x4*)(g + 32 * bj + 8 * fq + 4 * n);
#pragma unroll
            for (int ai = 0; ai < 2; ++ai)
#pragma unroll
                for (int m = 0; m < 4; ++m) {
                    const int row = row0 + ai * 128 + m * 16;
                    float ss = 0.f;
#pragma unroll
                    for (int bj = 0; bj < 2; ++bj)
#pragma unroll
                        for (int n = 0; n < 2; ++n) { const f32x4 x = acc[ai][bj][m][n]; ss += (x[0] * x[0] + x[1] * x[1]) + (x[2] * x[2] + x[3] * x[3]); }
                    ss += __shfl_xor(ss, 16); ss += __shfl_xor(ss, 32);
                    float rinv = __builtin_amdgcn_rsqf(ss * (1.f / 64.f) + 1e-6f);
                    if (isq) rinv *= 0.125f;
                    const bool samp = row >= MP;
                    const int rs = row - MP;
                    const int b = samp ? (rs >> 4) : (row >> 11), t = samp ? (rs & 15) : (row & 2047);
                    const int pi = samp ? (SEQ + t) : t;
                    const GAS float* rp = rope + (size_t)pi * 64 + 8 * fq;
                    f32x4 o1[2], o2[2];
#pragma unroll
                    for (int n = 0; n < 2; ++n) {
                        const f32x4 c4 = *(const GAS f32x4*)(rp + 4 * n), s4 = *(const GAS f32x4*)(rp + 32 + 4 * n);
                        const f32x4 x1 = acc[ai][0][m][n] * rinv * gv[0][n], x2 = acc[ai][1][m][n] * rinv * gv[1][n];
                        o1[n] = x1 * c4 - x2 * s4; o2[n] = x2 * c4 + x1 * s4;
                    }
                    if (isq) {
                        GAS bf16_t* qp = Q + (size_t)row * 512 + 64 * H + 8 * fq;
                        *(GAS u32x4*)qp = pk8(o1[0], o1[1]); *(GAS u32x4*)(qp + 32) = pk8(o2[0], o2[1]);
                    } else {
                        const int kvh = H - 8;
                        GAS bf16_t* kp = Kb + (size_t)row * 128 + 64 * kvh + 8 * fq;
                        *(GAS u32x4*)kp = pk8(o1[0], o1[1]); *(GAS u32x4*)(kp + 32) = pk8(o2[0], o2[1]);
                        if (samp || t >= SEQ - 128) {
                            GAS float* op = samp ? out + O_SK + ((size_t)(b * 16 + t) * 2 + kvh) * 64 + 8 * fq : out + O_PK + ((size_t)(b * 128 + (t - (SEQ - 128))) * 2 + kvh) * 64 + 8 * fq;
                            *(GAS f32x4*)op = o1[0]; *(GAS f32x4*)(op + 4) = o1[1]; *(GAS f32x4*)(op + 32) = o2[0]; *(GAS f32x4*)(op + 36) = o2[1];
                        }
                    }
                }
        } else if (H < 12) {
            const int kvh = H - 10;
#pragma unroll
            for (int ai = 0; ai < 2; ++ai)
#pragma unroll
                for (int m = 0; m < 4; ++m) {
                    const int row = row0 + ai * 128 + m * 16;
                    const bool samp = row >= MP;
                    const int rs = row - MP;
                    const int b = samp ? (rs >> 4) : (row >> 11), t = samp ? (rs & 15) : (row & 2047);
                    GAS bf16_t* vp = Vb + (size_t)row * 128 + 64 * kvh + 8 * fq;
                    *(GAS u32x4*)vp = pk8(acc[ai][0][m][0], acc[ai][0][m][1]); *(GAS u32x4*)(vp + 32) = pk8(acc[ai][1][m][0], acc[ai][1][m][1]);
                    if (samp || t >= SEQ - 128) {
                        GAS float* op = samp ? out + O_SV + ((size_t)(b * 16 + t) * 2 + kvh) * 64 + 8 * fq : out + O_PV + ((size_t)(b * 128 + (t - (SEQ - 128))) * 2 + kvh) * 64 + 8 * fq;
                        *(GAS f32x4*)op = acc[ai][0][m][0]; *(GAS f32x4*)(op + 4) = acc[ai][0][m][1]; *(GAS f32x4*)(op + 32) = acc[ai][1][m][0]; *(GAS f32x4*)(op + 36) = acc[ai][1][m][1];
                    }
                }
        } else {
            const int cr0 = (H - 12) * 64 + 8 * fq;
#pragma unroll
            for (int ai = 0; ai < 2; ++ai)
#pragma unroll
                for (int m = 0; m < 4; ++m) {
                    const int row = row0 + ai * 128 + m * 16;
                    const bool samp = row >= MP;
                    const int rs = row - MP;
                    const int b = samp ? (rs >> 4) : (row >> 11), t = samp ? (rs & 15) : (row & 2047);
                    const bool lastrow = samp ? (t == DEC_SEQ - 1) : (t == SEQ - 1);
#pragma unroll
                    for (int bj = 0; bj < 2; ++bj) {
                        const int cr = cr0 + 32 * bj;
                        if (cr < RW_COLS) {
                            *(GAS u32x4*)(PRW + (size_t)row * RW_COLS + cr) = pk8(acc[ai][bj][m][0], acc[ai][bj][m][1]);
                            if (lastrow) { GAS float* op = out + (samp ? O_SS : O_PS) + (size_t)b * RW_COLS + cr; *(GAS f32x4*)op = acc[ai][bj][m][0]; *(GAS f32x4*)(op + 4) = acc[ai][bj][m][1]; }
                        }
                    }
                }
        }
    }
};
DI void store_slab(GAS float* slab, const f32x4 (&acc)[2][2][4][2], const pg8::Unit& u, int wr, int wc, int fr, int fq) {
    const int row0 = (u.pm * 256 - MP) + wr * 64 + fr, col0 = u.pn * 256 + wc * 32 + 4 * fq;
    GAS float* base = slab + (size_t)u.slab * MS * 1024;
#pragma unroll
    for (int ai = 0; ai < 2; ++ai)
#pragma unroll
        for (int m = 0; m < 4; ++m) {
            const size_t off = (size_t)(row0 + ai * 128 + m * 16) * 1024 + col0;
#pragma unroll
            for (int bj = 0; bj < 2; ++bj)
#pragma unroll
                for (int n = 0; n < 2; ++n) *(GAS f32x4*)(base + off + bj * 128 + n * 16) = acc[ai][bj][m][n];
        }
}
struct EpiOut {
    const GAS float* xp; const GAS float* xs; GAS float* out; GAS bf16_t* X1B; GAS float* SSQ; GAS float* slab;
    DI void operator()(const f32x4 (&acc)[2][2][4][2], const pg8::Unit& u, int wr, int wc, int fr, int fq) const {
        if (u.slab >= 0) { store_slab(slab, acc, u, wr, wc, fr, fq); return; }
        const int row0 = u.pm * 256 + wr * 64 + fr, col0 = u.pn * 256 + wc * 32 + 4 * fq;
        const GAS float* xin = (u.pm < 256) ? xp : xs - (size_t)MP * 1024;
#pragma unroll
        for (int ai = 0; ai < 2; ++ai) {
            f32x4 xv[4][2][2];
#pragma unroll
            for (int m = 0; m < 4; ++m)
#pragma unroll
                for (int bj = 0; bj < 2; ++bj)
#pragma unroll
                    for (int n = 0; n < 2; ++n) xv[m][bj][n] = *(const GAS f32x4*)(xin + (size_t)(row0 + ai * 128 + m * 16) * 1024 + col0 + bj * 128 + n * 16);
#pragma unroll
            for (int m = 0; m < 4; ++m) {
                const int row = row0 + ai * 128 + m * 16; const size_t off = (size_t)row * 1024 + col0;
                float ss = 0.f;
#pragma unroll
                for (int bj = 0; bj < 2; ++bj)
#pragma unroll
                    for (int n = 0; n < 2; ++n) {
                        const f32x4 o = xv[m][bj][n] + acc[ai][bj][m][n];
                        u32x2 w; w.x = pk2(o[0], o[1]); w.y = pk2(o[2], o[3]);
                        *(GAS u32x2*)(X1B + off + bj * 128 + n * 16) = w;
                        ss += (o[0] * o[0] + o[1] * o[1]) + (o[2] * o[2] + o[3] * o[3]);
                    }
                ss += __shfl_xor(ss, 16); ss += __shfl_xor(ss, 32);
                if (fq == 0) SSQ[(size_t)row * 16 + u.pn * 4 + wc] = ss;
            }
        }
    }
};
struct EpiUp {
    const GAS float* SS1; GAS bf16_t* U;
    DI void operator()(const f32x4 (&acc)[2][2][4][2], const pg8::Unit& u, int wr, int wc, int fr, int fq) const {
        const int row0 = u.pm * 256 + wr * 64 + fr, col0 = u.pn * 256 + wc * 32 + 8 * fq;
        float s2[2][4];
#pragma unroll
        for (int ai = 0; ai < 2; ++ai)
#pragma unroll
            for (int m = 0; m < 4; ++m) s2[ai][m] = SS1[row0 + ai * 128 + m * 16];
#pragma unroll
        for (int ai = 0; ai < 2; ++ai)
#pragma unroll
            for (int m = 0; m < 4; ++m) {
                const int row = row0 + ai * 128 + m * 16;
                const float sc = __builtin_amdgcn_rcpf(s2[ai][m] * (1.f / 1024.f) + 1e-6f);
#pragma unroll
                for (int bj = 0; bj < 2; ++bj) {
                    f32x4 v0 = acc[ai][bj][m][0], v1 = acc[ai][bj][m][1];
#pragma unroll
                    for (int j = 0; j < 4; ++j) { const float r0 = fmaxf(v0[j], 0.f), r1 = fmaxf(v1[j], 0.f); v0[j] = r0 * r0 * sc; v1[j] = r1 * r1 * sc; }
                    *(GAS u32x4*)(U + (size_t)row * D_FF + col0 + bj * 128) = pk8(v0, v1);
                }
            }
    }
};
struct EpiDown {
    GAS float* out; GAS float* slab; const GAS bf16_t* X1B;
    DI void operator()(const f32x4 (&acc)[2][2][4][2], const pg8::Unit& u, int wr, int wc, int fr, int fq) const {
        if (u.slab >= 0) { store_slab(slab, acc, u, wr, wc, fr, fq); return; }
        const int row0 = u.pm * 256 + wr * 64 + fr, col0 = u.pn * 256 + wc * 32 + 4 * fq;
        u32x2 xw[2][4][2][2];
#pragma unroll
        for (int ai = 0; ai < 2; ++ai)
#pragma unroll
            for (int m = 0; m < 4; ++m)
#pragma unroll
                for (int bj = 0; bj < 2; ++bj)
#pragma unroll
                    for (int n = 0; n < 2; ++n) xw[ai][m][bj][n] = *(const GAS u32x2*)(X1B + (size_t)(row0 + ai * 128 + m * 16) * 1024 + col0 + bj * 128 + n * 16);
#pragma unroll
        for (int ai = 0; ai < 2; ++ai)
#pragma unroll
            for (int m = 0; m < 4; ++m) {
                const size_t off = (size_t)(row0 + ai * 128 + m * 16) * 1024 + col0;
#pragma unroll
                for (int bj = 0; bj < 2; ++bj)
#pragma unroll
                    for (int n = 0; n < 2; ++n) { const u32x2 w = xw[ai][m][bj][n];
                        *(GAS f32x4*)(out + off + bj * 128 + n * 16) = (f32x4){bflo(w.x), bfhi(w.x), bflo(w.y), bfhi(w.y)} + acc[ai][bj][m][n]; }
            }
    }
};

DI void p0_transpose_item(const GAS float* W, int K, int N, GAS bf16_t* WT, int mode, const GAS float* kscale, LAS float* scr, int item, int lane) {
    const int nblk = N / 32, kb = item / nblk, nb = item % nblk, k0 = 64 * kb, n0 = 32 * nb;
#pragma unroll 8
    for (int i = 0; i < 32; ++i) { const int kk = 2 * i + (lane >> 5); float v = W[(size_t)(k0 + kk) * N + n0 + (lane & 31)]; if (kscale) v *= kscale[k0 + kk]; scr[kk * 33 + (lane & 31)] = v; }
    LDS_WAIT();
    const int c = lane & 7;
#pragma unroll
    for (int j = 0; j < 4; ++j) { const int n = (lane >> 3) + 8 * j; const LAS float* s = scr + (8 * c) * 33 + n;
        u32x4 o; o.x = pk2(s[0 * 33], s[1 * 33]); o.y = pk2(s[2 * 33], s[3 * 33]); o.z = pk2(s[4 * 33], s[5 * 33]); o.w = pk2(s[6 * 33], s[7 * 33]);
        *(GAS u32x4*)(WT + (size_t)rowmap(mode, n0 + n) * K + k0 + 8 * c) = o; }
    LDS_WAIT();
}
DI void sincos_d(double x, double& s, double& c) {
    const double TWO_PI = 6.283185307179586476925287;
    const double n = __builtin_rint(x * (1.0 / TWO_PI));
    const double r = x - n * TWO_PI, r2 = r * r;
    double ps = 1.0, pc = 1.0;
#pragma unroll
    for (int k = 14; k >= 1; --k) { ps = 1.0 - ps * r2 / (double)((2 * k) * (2 * k + 1)); pc = 1.0 - pc * r2 / (double)((2 * k - 1) * (2 * k)); }
    s = r * ps; c = pc;
}

struct Params { const float* in[26]; float* out; unsigned char* ws; int ph_lo, ph_hi; };

DI void phase0(const Params& p, LAS unsigned char* lds, int G, int kwid) {
    const int lane = lane_id(), wave = kwid, tid = wave * 64 + lane;
    const int gw = blockIdx.x * 8 + wave, NGW = G * 8;
    LAS float* scr = (LAS float*)(lds + wave * 8704);
    unsigned char* ws = p.ws;
    const GAS float* w_in = (const GAS float*)p.in[7]; const GAS float* w_out = (const GAS float*)p.in[22]; const GAS float* w_up = (const GAS float*)p.in[24]; const GAS float* w_dn = (const GAS float*)p.in[25];
    const GAS float* ln2 = (const GAS float*)p.in[23];
    constexpr int I_IN = 16 * (IN_COLS / 32), I_OUT = 16 * 32, I_UP = 16 * 128, I_DN = 64 * 32, NITEMS = I_IN + I_OUT + I_UP + I_DN;
    for (int it = gw; it < NITEMS; it += NGW) {
        int r = it;
        if (r < I_IN) { p0_transpose_item(w_in, 1024, IN_COLS, (GAS bf16_t*)(ws + WS_WIN), MAP_B, nullptr, scr, r, lane); continue; } r -= I_IN;
        if (r < I_OUT) { p0_transpose_item(w_out, 1024, 1024, (GAS bf16_t*)(ws + WS_WOUT), MAP_NAT, nullptr, scr, r, lane); continue; } r -= I_OUT;
        if (r < I_UP) { p0_transpose_item(w_up, 1024, 4096, (GAS bf16_t*)(ws + WS_WUP), MAP_A, ln2, scr, r, lane); continue; } r -= I_UP;
        p0_transpose_item(w_dn, 4096, 1024, (GAS bf16_t*)(ws + WS_WDN), MAP_NAT, nullptr, scr, r, lane);
    }
    const int gt = blockIdx.x * 512 + tid, NGT = G * 512;
    for (int i = gt; i < (IN_PAD - IN_COLS) * 128; i += NGT) { const int c = IN_COLS + i / 128; *(GAS u32x4*)((GAS bf16_t*)(ws + WS_WIN) + (size_t)rowmap(MAP_B, c) * 1024 + (i % 128) * 8) = (u32x4){0u, 0u, 0u, 0u}; }
    { const GAS float* w2 = (const GAS float*)p.in[13]; const GAS float* a2 = (const GAS float*)p.in[15]; const GAS float* g2 = (const GAS float*)p.in[16];
      GAS bf16_t* W2T = (GAS bf16_t*)(ws + WS_W2T); GAS bf16_t* A2T = (GAS bf16_t*)(ws + WS_A2T); GAS bf16_t* G2T = (GAS bf16_t*)(ws + WS_G2T);
      for (int i = gt; i < 512 * 32; i += NGT) { const int n = i >> 5, k2 = (i & 31) * 2;
          *(GAS unsigned*)(W2T + n * 64 + k2) = pk2(w2[k2 * 512 + n], w2[(k2 + 1) * 512 + n]);
          *(GAS unsigned*)(A2T + n * 64 + k2) = pk2(a2[k2 * 512 + n], a2[(k2 + 1) * 512 + n]); }
      for (int i = gt; i < 512 * 80; i += NGT) { const int n = i / 80, k2 = (i % 80) * 2; *(GAS unsigned*)(G2T + n * 160 + k2) = pk2(g2[k2 * 512 + n], g2[(k2 + 1) * 512 + n]); } }
    { GAS float* rope = (GAS float*)(ws + WS_ROPE);
      for (int i = gt; i < NPOS * 32; i += NGT) { const int pi = i >> 5, f = i & 31; const int pos = pi < SEQ ? pi : 4096 + (pi - SEQ);
          const float inv = (float)exp(-(double)f * (9.210340371976182736 / 32.0));
          const float ang = (float)pos * inv;
          double s, c; sincos_d((double)ang, s, c);
          rope[(size_t)pi * 64 + f] = (float)c; rope[(size_t)pi * 64 + 32 + f] = (float)s; } }
    { const GAS float* g1 = (const GAS float*)p.in[6]; GAS bf16_t* Hh = (GAS bf16_t*)(ws + WS_H);
      f32x4 gv[4];
#pragma unroll
      for (int j = 0; j < 4; ++j) gv[j] = *((const GAS f32x4*)g1 + lane + 64 * j);
      for (int m = gw; m < MT; m += NGW) {
          const GAS float* xrow = (m < MP) ? (const GAS float*)p.in[0] + (size_t)m * 1024 : (const GAS float*)p.in[1] + (size_t)(m - MP) * 1024;
          const GAS f32x4* xr = (const GAS f32x4*)xrow + lane;
          f32x4 v[4]; float s = 0.f;
#pragma unroll
          for (int j = 0; j < 4; ++j) { v[j] = xr[64 * j]; s += (v[j][0] * v[j][0] + v[j][1] * v[j][1]) + (v[j][2] * v[j][2] + v[j][3] * v[j][3]); }
          const float rinv = __builtin_amdgcn_rsqf(wave_sum(s) * (1.f / 1024.f) + 1e-6f);
          GAS u32x2* o8 = (GAS u32x2*)(Hh + (size_t)m * 1024) + lane;
#pragma unroll
          for (int j = 0; j < 4; ++j) { const f32x4 y = v[j] * rinv * gv[j]; u32x2 w; w.x = pk2(y[0], y[1]); w.y = pk2(y[2], y[3]); o8[64 * j] = w; }
      } }
}

constexpr int KS_STRIDE = 144;
constexpr int VT_STRIDE = 392;
constexpr int VT_OFF = 192 * KS_STRIDE;
#define MFMA32(a, b, c) __builtin_amdgcn_mfma_f32_32x32x16_bf16((a), (b), (c), 0, 0, 0)

DI void attn_store_kv(LAS unsigned char* lds, int row, int ch, u32x4 kv, u32x4 vv) {
    *(LAS u32x4*)(lds + row * KS_STRIDE + ch * 16) = kv;
    LAS unsigned short* vt = (LAS unsigned short*)(lds + VT_OFF + (8 * ch) * VT_STRIDE + row * 2);
    const unsigned w[4] = {vv.x, vv.y, vv.z, vv.w};
#pragma unroll
    for (int i = 0; i < 4; ++i) { vt[(2 * i) * (VT_STRIDE / 2)] = (unsigned short)(w[i] & 0xffffu); vt[(2 * i + 1) * (VT_STRIDE / 2)] = (unsigned short)(w[i] >> 16); }
}
DI void attn_wave(LAS unsigned char* lds, const bf16x8 (&qf)[4]  , GAS bf16_t* optr, float sink, int kt0, int nkt, bool mask_last_half, bool do_store, int lane) {
    const int r = lane & 31, h = lane >> 5;
    f32x16 st[6];
#pragma unroll
    for (int kt = 0; kt < 6; ++kt) {
#pragma unroll
        for (int i = 0; i < 16; ++i) st[kt][i] = 0.f;
        if (kt >= kt0 && kt < nkt) {
#pragma unroll
            for (int ks = 0; ks < 4; ++ks) { const bf16x8 kf = *(const LAS bf16x8*)(lds + (32 * kt + r) * KS_STRIDE + (16 * ks + 8 * h) * 2); st[kt] = MFMA32(kf, qf[ks], st[kt]); }
        }
    }
    float mx = sink;
#pragma unroll
    for (int kt = 0; kt < 6; ++kt) if (kt >= kt0 && kt < nkt) {
#pragma unroll
        for (int i = 0; i < 16; ++i) { const bool dead = mask_last_half && kt == nkt - 1 && i >= 8; if (!dead) mx = fmaxf(mx, st[kt][i]); }
    }
    mx = fmaxf(mx, __shfl_xor(mx, 32));
    float l = 0.f;
#pragma unroll
    for (int kt = 0; kt < 6; ++kt) if (kt >= kt0 && kt < nkt) {
#pragma unroll
        for (int i = 0; i < 16; ++i) { const bool dead = mask_last_half && kt == nkt - 1 && i >= 8; const float pv = dead ? 0.f : __expf(st[kt][i] - mx); st[kt][i] = pv; l += pv; }
    }
    l += __shfl_xor(l, 32);
    const float inv = 1.0f / (l + __expf(sink - mx));
    f32x16 ot[2];
#pragma unroll
    for (int dt = 0; dt < 2; ++dt)
#pragma unroll
        for (int i = 0; i < 16; ++i) ot[dt][i] = 0.f;
#pragma unroll
    for (int kt = 0; kt < 6; ++kt) if (kt >= kt0 && kt < nkt) {
#pragma unroll
        for (int s = 0; s < 2; ++s) {
            u32x4 pw; pw.x = pk2(st[kt][8 * s], st[kt][8 * s + 1]); pw.y = pk2(st[kt][8 * s + 2], st[kt][8 * s + 3]); pw.z = pk2(st[kt][8 * s + 4], st[kt][8 * s + 5]); pw.w = pk2(st[kt][8 * s + 6], st[kt][8 * s + 7]);
            const bf16x8 pf = __builtin_bit_cast(bf16x8, pw);
#pragma unroll
            for (int dt = 0; dt < 2; ++dt) {
                const LAS unsigned char* vp = lds + VT_OFF + (32 * dt + r) * VT_STRIDE + (32 * kt + 16 * s + 4 * h) * 2;
                const u32x2 v0 = *(const LAS u32x2*)vp, v1 = *(const LAS u32x2*)(vp + 16);
                u32x4 vw; vw.x = v0.x; vw.y = v0.y; vw.z = v1.x; vw.w = v1.y;
                ot[dt] = MFMA32(__builtin_bit_cast(bf16x8, vw), pf, ot[dt]);
            }
        }
    }
    if (do_store) {
#pragma unroll
        for (int dt = 0; dt < 2; ++dt)
#pragma unroll
            for (int rg = 0; rg < 4; ++rg) {
                u32x2 w; w.x = pk2(ot[dt][4 * rg] * inv, ot[dt][4 * rg + 1] * inv); w.y = pk2(ot[dt][4 * rg + 2] * inv, ot[dt][4 * rg + 3] * inv);
                *(GAS u32x2*)(optr + 32 * dt + 8 * rg + 4 * h) = w;
            }
    }
}
struct AttnRegs { u32x4 k0[2], k1[2], v0[2], v1[2]; bf16x8 q[4]; };
DI void attn_issue(const GAS bf16_t* Q, const GAS bf16_t* Kb, const GAS bf16_t* Vb, int it, int tid, int wid, int lane, AttnRegs& R) {
    const int g = it & 1, n = (it >> 1) & 31, b = it >> 6;
    const int kt0 = n >= 2 ? 0 : (2 - n) * 2, krow0 = b * SEQ + 64 * (n - 2);
#pragma unroll
    for (int i = 0; i < 2; ++i) {
        const int pc = tid + 512 * i, row = 2 * (pc >> 3), ch = pc & 7;
        if (pc < 768 && row >= 32 * kt0) {
            const size_t go = (size_t)(krow0 + row) * 128 + 64 * g + 8 * ch;
            R.k0[i] = *(const GAS u32x4*)(Kb + go); R.k1[i] = *(const GAS u32x4*)(Kb + go + 128);
            R.v0[i] = *(const GAS u32x4*)(Vb + go); R.v1[i] = *(const GAS u32x4*)(Vb + go + 128);
        }
    }
    const int hq = 4 * g + (wid >> 1), qrow = b * SEQ + 64 * n + 32 * (wid & 1) + (lane & 31);
#pragma unroll
    for (int ks = 0; ks < 4; ++ks) R.q[ks] = *(const GAS bf16x8*)(Q + (size_t)qrow * 512 + 64 * hq + 16 * ks + 8 * (lane >> 5));
}
DI void attn_commit(LAS unsigned char* lds, int it, int tid, const AttnRegs& R) {
    const int n = (it >> 1) & 31, kt0 = n >= 2 ? 0 : (2 - n) * 2;
#pragma unroll
    for (int i = 0; i < 2; ++i) {
        const int pc = tid + 512 * i, row = 2 * (pc >> 3), ch = pc & 7;
        if (pc < 768 && row >= 32 * kt0) {
            *(LAS u32x4*)(lds + row * KS_STRIDE + ch * 16) = R.k0[i]; *(LAS u32x4*)(lds + (row + 1) * KS_STRIDE + ch * 16) = R.k1[i];
            const unsigned a[4] = {R.v0[i].x, R.v0[i].y, R.v0[i].z, R.v0[i].w}, c[4] = {R.v1[i].x, R.v1[i].y, R.v1[i].z, R.v1[i].w};
            LAS unsigned char* vt = lds + VT_OFF + (8 * ch) * VT_STRIDE + row * 2;
#pragma unroll
            for (int j = 0; j < 4; ++j) {
                *(LAS unsigned*)(vt + (2 * j) * VT_STRIDE) = (a[j] & 0xffffu) | (c[j] << 16);
                *(LAS unsigned*)(vt + (2 * j + 1) * VT_STRIDE) = (a[j] >> 16) | (c[j] & 0xffff0000u);
            }
        }
    }
}
DI void attn_phase(const Params& p, LAS unsigned char* lds, int G, int kwid) {
    const int lane = lane_id(), wid = kwid, tid = wid * 64 + lane;
    unsigned char* ws = p.ws;
    const GAS bf16_t* Q = (const GAS bf16_t*)(ws + WS_Q); const GAS bf16_t* Kb = (const GAS bf16_t*)(ws + WS_K); const GAS bf16_t* Vb = (const GAS bf16_t*)(ws + WS_V);
    GAS bf16_t* MIX = (GAS bf16_t*)(ws + WS_MIX);
    const GAS float* sinks = (const GAS float*)p.in[10];
    constexpr int NPI = BATCH * 32 * 2, NSI = BATCH * 2;
    {
        AttnRegs R;
        int it = blockIdx.x;
        if (it < NPI) attn_issue(Q, Kb, Vb, it, tid, wid, lane, R);
        for (; it < NPI; it += G) {
            __syncthreads();
            attn_commit(lds, it, tid, R);
            bf16x8 qf[4];
#pragma unroll
            for (int ks = 0; ks < 4; ++ks) qf[ks] = R.q[ks];
            __syncthreads();
            if (it + G < NPI) attn_issue(Q, Kb, Vb, it + G, tid, wid, lane, R);
            const int g = it & 1, n = (it >> 1) & 31, b = it >> 6;
            const int kt0 = n >= 2 ? 0 : (2 - n) * 2;
            const int hq = 4 * g + (wid >> 1), qrow = b * SEQ + 64 * n + 32 * (wid & 1) + (lane & 31);
            attn_wave(lds, qf, MIX + (size_t)qrow * 1024 + 64 * hq, sinks[hq], kt0, 6, false, true, lane);
        }
    }
    for (int si = blockIdx.x; si < NSI; si += G) {
        __syncthreads();
        const int g = si & 1, b = si >> 1;
        const GAS float* ck = (const GAS float*)p.in[2]; const GAS float* cv = (const GAS float*)p.in[3];
#pragma unroll
        for (int i = 0; i < 3; ++i) {
            const int cid = tid + 512 * i, row = cid >> 3, ch = cid & 7;
            if (row < 160) {
                u32x4 kv = {0u, 0u, 0u, 0u}, vv = {0u, 0u, 0u, 0u};
                if (row < 128) {
                    const size_t go = ((size_t)(b * 128 + row) * 2 + g) * 64 + 8 * ch;
                    kv = pk8(*(const GAS f32x4*)(ck + go), *(const GAS f32x4*)(ck + go + 4)); vv = pk8(*(const GAS f32x4*)(cv + go), *(const GAS f32x4*)(cv + go + 4));
                } else if (row < 144) {
                    const size_t go = (size_t)(MP + b * 16 + (row - 128)) * 128 + 64 * g + 8 * ch;
                    kv = *(const GAS u32x4*)(Kb + go); vv = *(const GAS u32x4*)(Vb + go);
                }
                attn_store_kv(lds, row, ch, kv, vv);
            }
        }
        __syncthreads();
        if (wid < 4) {
            const int hq = 4 * g + wid;
            const int qrow = MP + b * 16 + (lane & 15);
            bf16x8 qf[4];
#pragma unroll
            for (int ks = 0; ks < 4; ++ks) qf[ks] = *(const GAS bf16x8*)(Q + (size_t)qrow * 512 + 64 * hq + 16 * ks + 8 * (lane >> 5));
            attn_wave(lds, qf, MIX + (size_t)qrow * 1024 + 64 * hq, sinks[hq], 0, 5, true, (lane & 31) < 16, lane);
        }
    }
    __syncthreads();
}

constexpr int NHELP = 7;
constexpr int SL_AQ = 0, AQ_STR = 136;
constexpr int SL_GH = SL_AQ + 32 * AQ_STR, GH_STR = 48;
constexpr int SL_VT = SL_GH + 32 * GH_STR, T_STR = 48;
constexpr int SL_KT = SL_VT + 64 * T_STR;
constexpr int SL_BT = SL_KT + 64 * T_STR, BT_STR = 40;
constexpr int SL_WV = SL_BT + 64 * BT_STR;
constexpr int SL_PB = SL_WV + 256;
constexpr int SL_BON = SL_PB + 16 * 64 * 2;
constexpr int SLOT_BYTES = SL_BON + 64;
constexpr int RW_SLOTS = 0;
constexpr int RW_LW2 = RW_SLOTS + NHELP * SLOT_BYTES;
constexpr int RW_LA2 = RW_LW2 + 64 * 144;
constexpr int RW_LG2 = RW_LA2 + 64 * 144;
constexpr int RW_CV = RW_LG2 + 64 * 336;
constexpr int RW_MUL = RW_CV + 10 * 64 * 4;
constexpr int RW_FLG = RW_MUL + 288 * 4;
constexpr int RW_END = RW_FLG + 3 * 8 * 4;
static_assert(RW_END <= LDS_BYTES - 16, "rwkv LDS");
enum { CV_W0 = 0, CV_A0, CV_KK, CV_KA, CV_RK, CV_LG, CV_LB, CV_MR, CV_MK, CV_MV };
#define MFMA16(a, b, c) __builtin_amdgcn_mfma_f32_16x16x32_bf16((a), (b), (c), 0, 0, 0)

constexpr int RW_NC = SEQ / 16 + 1;
struct RwSeq { const GAS bf16_t* prw_p; const GAS bf16_t* prw_s; const GAS bf16_t* act_p; const GAS bf16_t* act_s; GAS bf16_t* mix_p; GAS bf16_t* mix_s;
               const GAS float* shift0; const GAS float* wkv0; GAS float* wkv_out_p; GAS float* wkv_out_s; int h; };

DI void unpk8(u32x4 w, float (&o)[8]) { o[0] = bflo(w.x); o[1] = bfhi(w.x); o[2] = bflo(w.y); o[3] = bfhi(w.y); o[4] = bflo(w.z); o[5] = bfhi(w.z); o[6] = bflo(w.w); o[7] = bfhi(w.w); }
DI unsigned dpp_shr1_u(unsigned x) { return (unsigned)__builtin_amdgcn_update_dpp(0, (int)x, 0x111, 0xf, 0xf, true); }
template <int CTRL> DI float dpp_shr_f(float x) { return __builtin_bit_cast(float, __builtin_amdgcn_update_dpp(0, __builtin_bit_cast(int, x), CTRL, 0xf, 0xf, true)); }
DI void flag_wait(volatile LAS unsigned* f, unsigned v) { unsigned sp = 0; while (*f < v) { __builtin_amdgcn_s_sleep(1); if (++sp > (1u << 24)) break; } asm volatile("" ::: "memory"); }
DI void flag_set(volatile LAS unsigned* f, unsigned v, int ln) { asm volatile("s_waitcnt vmcnt(0) lgkmcnt(0)" ::: "memory"); if (ln == 0) *f = v; }
DI bf16x8 pack8f(const float (&x)[8]) { u32x4 w; w.x = pk2(x[0], x[1]); w.y = pk2(x[2], x[3]); w.z = pk2(x[4], x[5]); w.w = pk2(x[6], x[7]); return __builtin_bit_cast(bf16x8, w); }

DI void lora_act_pass(const Params& p, int G, int kwid) {
    const GAS bf16_t* PRW = (const GAS bf16_t*)(p.ws + WS_PRW); GAS bf16_t* ACTB = (GAS bf16_t*)(p.ws + WS_X1B);
    const GAS float* mu = (const GAS float*)p.in[11] + 1536; const GAS float* sh = (const GAS float*)p.in[5];
    for (int i = blockIdx.x * 512 + kwid * 64 + lane_id(); i < (MT / 4) * 36; i += G * 512) {
        const int rb = i / 36, pc = i - rb * 36, d = pc * 8, row0 = rb * 4;
        u32x4 raw[5];
        const int rp = row0 > 0 ? row0 - 1 : 0;
        raw[0] = *(const GAS u32x4*)(PRW + (size_t)rp * RW_COLS + 1536 + d);
#pragma unroll
        for (int r = 0; r < 4; ++r) raw[r + 1] = *(const GAS u32x4*)(PRW + (size_t)(row0 + r) * RW_COLS + 1536 + d);
        const f32x4 m0 = *(const GAS f32x4*)(mu + d), m1 = *(const GAS f32x4*)(mu + d + 4);
#pragma unroll
        for (int r = 0; r < 4; ++r) {
            const int row = row0 + r;
            const bool samp = row >= MP; const int t = samp ? ((row - MP) & 15) : (row & 2047);
            float c[8], pv[8], xs[8];
            unpk8(raw[r + 1], c);
            if (t > 0) unpk8(raw[r], pv);
            else if (samp) { const GAS float* sp = sh + (size_t)((row - MP) >> 4) * RW_COLS + 1536 + d; const f32x4 a4 = *(const GAS f32x4*)sp, b4 = *(const GAS f32x4*)(sp + 4);
#pragma unroll
                for (int j = 0; j < 4; ++j) { pv[j] = a4[j]; pv[4 + j] = b4[j]; } }
            else {
#pragma unroll
                for (int j = 0; j < 8; ++j) pv[j] = 0.f; }
#pragma unroll
            for (int j = 0; j < 8; ++j) {
                const float x = c[j] + (pv[j] - c[j]) * (j < 4 ? m0[j] : m1[j - 4]);
                xs[j] = d < 64 ? 1.0f - 2.0f * __builtin_amdgcn_rcpf(__expf(2.0f * x) + 1.0f) : (d < 128 ? x : __builtin_amdgcn_rcpf(1.0f + __expf(-x)));
            }
            u32x4 w; w.x = pk2(xs[0], xs[1]); w.y = pk2(xs[2], xs[3]); w.z = pk2(xs[4], xs[5]); w.w = pk2(xs[6], xs[7]);
            *(GAS u32x4*)(ACTB + (size_t)row * 288 + d) = w;
        }
    }
}
DI void rw_post_chunk(LAS unsigned char* lds, const RwSeq& sq, int m, int hw, int lane_) {
    int lane = lane_; asm volatile("" : "+v"(lane));
    LAS unsigned char* sl = lds + RW_SLOTS + hw * SLOT_BYTES;
    const bool sc = m == RW_NC - 1;
    const int tk = lane >> 2, cq = lane & 3, c0 = 16 * cq, t = sc ? tk : 16 * m + tk;
    const LAS float* yb = (const LAS float*)(sl + SL_AQ) + tk * 64 + c0;
    const LAS float* CV = (const LAS float*)(lds + RW_CV);
    f32x4 y[4]; float s = 0.f;
#pragma unroll
    for (int i = 0; i < 4; ++i) { y[i] = *(const LAS f32x4*)(yb + 4 * i); s += (y[i][0] + y[i][1]) + (y[i][2] + y[i][3]); }
    const float mu = quad_sum(s) * (1.f / 64.f);
    float qv = 0.f;
#pragma unroll
    for (int i = 0; i < 4; ++i) { y[i] = y[i] - mu; qv += (y[i][0] * y[i][0] + y[i][1] * y[i][1]) + (y[i][2] * y[i][2] + y[i][3] * y[i][3]); }
    const float rs = __builtin_amdgcn_rsqf(quad_sum(qv) * (1.f / 64.f) + 64e-5f);
    const float bon = *(const LAS float*)(sl + SL_BON + tk * 4);
    float g[16], v[16];
    { float t8[8]; const LAS bf16_t* pbp = (const LAS bf16_t*)(sl + SL_PB) + tk * 64 + c0;
      unpk8(*(const LAS u32x4*)pbp, t8);
#pragma unroll
      for (int j = 0; j < 8; ++j) g[j] = t8[j];
      unpk8(*(const LAS u32x4*)(pbp + 8), t8);
#pragma unroll
      for (int j = 0; j < 8; ++j) g[8 + j] = t8[j];
#pragma unroll
      for (int j = 0; j < 16; ++j) v[j] = bf2f(*(const LAS unsigned short*)(sl + SL_VT + (c0 + j) * T_STR + tk * 2)); }
    f32x4 o[4];
#pragma unroll
    for (int i = 0; i < 4; ++i) {
        const f32x4 lg = *(const LAS f32x4*)(CV + CV_LG * 64 + c0 + 4 * i), lb = *(const LAS f32x4*)(CV + CV_LB * 64 + c0 + 4 * i);
#pragma unroll
        for (int j = 0; j < 4; ++j) o[i][j] = ((y[i][j] * rs) * lg[j] + lb[j] + v[4 * i + j] * bon) * g[4 * i + j];
    }
    GAS bf16_t* op = (sc ? sq.mix_s : sq.mix_p) + (size_t)t * 1024 + 512 + 64 * sq.h + c0;
    *(GAS u32x4*)op = pk8(o[0], o[1]); *(GAS u32x4*)(op + 8) = pk8(o[2], o[3]);
}
DI void rw_helper_chunk(LAS unsigned char* lds, const RwSeq& sq, int m, unsigned k, int hw, int ln_) {
    int ln = ln_; asm volatile("" : "+v"(ln));
    const bool sc = m == RW_NC - 1;
    const int tk = ln & 15, q = ln >> 4, t = sc ? tk : 16 * m + tk;
    LAS unsigned char* sl = lds + RW_SLOTS + hw * SLOT_BYTES;
    const LAS float* CV = (const LAS float*)(lds + RW_CV);
    volatile LAS unsigned* FLG = (volatile LAS unsigned*)(lds + RW_FLG);
    const GAS bf16_t* prow = (sc ? sq.prw_s : sq.prw_p) + (size_t)t * RW_COLS;
    const bool tk0 = tk == 0;
    if (k > 0) { flag_wait(FLG + 8 + hw, k); rw_post_chunk(lds, sq, m - NHELP, hw, ln); LDS_WAIT(); }
    const GAS bf16_t* pprev = prow - RW_COLS;
    const bool gprev = tk0 && t > 0, sprev = tk0 && sc;
    f32x4 rr[4], kx[4];
    u32x2 vvp[4];
    float ssq = 0.f;
    bf16x8 f[9];
    {
        u32x2 rraw[3][4], rbnd[3][4];
        const GAS bf16_t* arow = (sc ? sq.act_s : sq.act_p) + (size_t)t * 288 + 8 * q;
#pragma unroll
        for (int ks = 0; ks < 9; ++ks) f[ks] = *(const GAS bf16x8*)(arow + 32 * ks);
#pragma unroll
        for (int w = 0; w < 3; ++w)
#pragma unroll
            for (int ct = 0; ct < 4; ++ct) {
                const int col = w * 512 + 64 * sq.h + 16 * ct + 4 * q;
                rraw[w][ct] = *(const GAS u32x2*)(prow + col); rbnd[w][ct] = (u32x2){0u, 0u};
                if (gprev) rbnd[w][ct] = *(const GAS u32x2*)(pprev + col);
                else if (sprev) { const f32x4 x = *(const GAS f32x4*)(sq.shift0 + col); u32x2 o; o.x = pk2(x[0], x[1]); o.y = pk2(x[2], x[3]); rbnd[w][ct] = o; }
            }
#pragma unroll
        for (int ct = 0; ct < 4; ++ct) {
            const int c = 16 * ct + 4 * q;
#pragma unroll
            for (int w = 0; w < 3; ++w) {
                u32x2 pw; pw.x = dpp_shr1_u(rraw[w][ct].x); pw.y = dpp_shr1_u(rraw[w][ct].y);
                if (tk0) pw = rbnd[w][ct];
                const f32x4 cu = (f32x4){bflo(rraw[w][ct].x), bfhi(rraw[w][ct].x), bflo(rraw[w][ct].y), bfhi(rraw[w][ct].y)};
                const f32x4 pr = (f32x4){bflo(pw.x), bfhi(pw.x), bflo(pw.y), bfhi(pw.y)};
                const f32x4 mu = *(const LAS f32x4*)(CV + (CV_MR + w) * 64 + c);
                const f32x4 xs = cu + (pr - cu) * mu;
                if (w == 0) rr[ct] = xs; else if (w == 1) kx[ct] = xs; else { u32x2 o; o.x = pk2(xs[0], xs[1]); o.y = pk2(xs[2], xs[3]); vvp[ct] = o; }
            }
            const f32x4 kkr = kx[ct] * *(const LAS f32x4*)(CV + CV_KK * 64 + c);
            ssq += (kkr[0] * kkr[0] + kkr[1] * kkr[1]) + (kkr[2] * kkr[2] + kkr[3] * kkr[3]);
        }
    }
    ssq += __shfl_xor(ssq, 16); ssq += __shfl_xor(ssq, 32);
    const float kinv = __builtin_amdgcn_rsqf(fmaxf(ssq, 1e-24f));
    u32x2 fa2[2], fb2[2], fk2[2], fr2[2];
    f32x4 Mab = {0.f, 0.f, 0.f, 0.f}, Mak = Mab, Mbr = Mab, Mkr = Mab;
    u32x2 Kbp[4];
    float bon = 0.f;
#pragma unroll
    for (int ct = 0; ct < 4; ++ct) {
        const int c = 16 * ct + 4 * q;
        asm volatile("" ::: "memory");
        f32x4 awc = {0.f, 0.f, 0.f, 0.f}, aac = awc, agc = awc;
        { const int wrow = 16 * ct + tk;
#pragma unroll
          for (int ks = 0; ks < 2; ++ks) {
              awc = MFMA16(*(const LAS bf16x8*)(lds + RW_LW2 + wrow * 144 + (32 * ks + 8 * q) * 2), f[ks], awc);
              aac = MFMA16(*(const LAS bf16x8*)(lds + RW_LA2 + wrow * 144 + (32 * ks + 8 * q) * 2), f[2 + ks], aac);
          }
#pragma unroll
          for (int ks = 0; ks < 5; ++ks) agc = MFMA16(*(const LAS bf16x8*)(lds + RW_LG2 + wrow * 336 + (32 * ks + 8 * q) * 2), f[4 + ks], agc); }
        const f32x4 w0 = *(const LAS f32x4*)(CV + CV_W0 * 64 + c), a0 = *(const LAS f32x4*)(CV + CV_A0 * 64 + c), kkc = *(const LAS f32x4*)(CV + CV_KK * 64 + c),
                    kac = *(const LAS f32x4*)(CV + CV_KA * 64 + c), rkc = *(const LAS f32x4*)(CV + CV_RK * 64 + c);
        f32x4 Bb, Kb, Wc, xa, xb, xk, xr;
#pragma unroll
        for (int j = 0; j < 4; ++j) {
            const float lw = -0.60653066f * __builtin_amdgcn_rcpf(1.0f + __expf(-(w0[j] + awc[j])));
            float cl = lw;
            cl += dpp_shr_f<0x111>(cl); cl += dpp_shr_f<0x112>(cl); cl += dpp_shr_f<0x114>(cl); cl += dpp_shr_f<0x118>(cl);
            const float E = __expf(cl), Einv = __builtin_amdgcn_rcpf(E);
            const float Ep = dpp_shr_f<0x111>(E), Em1 = tk0 ? 1.0f : Ep;
            const float WC = __shfl(E, (ln & 48) | 15);
            const float sg = __builtin_amdgcn_rcpf(1.0f + __expf(-(a0[j] + aac[j])));
            const float kp = kx[ct][j] * (1.0f + (sg - 1.0f) * kac[j]);
            const float ah = kx[ct][j] * kkc[j] * kinv;
            const float bt = ah * sg * Einv, kt = kp * Einv;
            xa[j] = -ah * Em1; xb[j] = bt; xk[j] = kt; xr[j] = rr[ct][j] * E;
            Bb[j] = bt * WC; Kb[j] = kt * WC; Wc[j] = WC;
            bon += rr[ct][j] * kp * rkc[j];
        }
        { u32x2 o; o.x = pk2(xa[0], xa[1]); o.y = pk2(xa[2], xa[3]); fa2[ct & 1] = o; o.x = pk2(xb[0], xb[1]); o.y = pk2(xb[2], xb[3]); fb2[ct & 1] = o;
          o.x = pk2(xk[0], xk[1]); o.y = pk2(xk[2], xk[3]); fk2[ct & 1] = o; o.x = pk2(xr[0], xr[1]); o.y = pk2(xr[2], xr[3]); fr2[ct & 1] = o;
          o.x = pk2(Kb[0], Kb[1]); o.y = pk2(Kb[2], Kb[3]); Kbp[ct] = o;
          const unsigned bw2[2] = {pk2(Bb[0], Bb[1]), pk2(Bb[2], Bb[3])};
#pragma unroll
          for (int j = 0; j < 4; ++j) *(LAS unsigned short*)(sl + SL_BT + (c + j) * BT_STR + tk * 2) = (unsigned short)(bw2[j >> 1] >> ((j & 1) * 16)); }
        if (tk0) *(LAS f32x4*)(sl + SL_WV + c * 4) = Wc;
        { u32x2 gw; gw.x = pk2(agc[0], agc[1]); gw.y = pk2(agc[2], agc[3]);
          *(LAS u32x2*)(sl + SL_PB + tk * 128 + c * 2) = gw; }
        { const unsigned aw2[2] = {fa2[ct & 1].x, fa2[ct & 1].y}, rw2[2] = {fr2[ct & 1].x, fr2[ct & 1].y};
#pragma unroll
          for (int j = 0; j < 4; ++j) { const int sh = (j & 1) * 16;
              *(LAS unsigned short*)(sl + SL_VT + (c + j) * T_STR + tk * 2) = (unsigned short)(aw2[j >> 1] >> sh);
              *(LAS unsigned short*)(sl + SL_KT + (c + j) * T_STR + tk * 2) = (unsigned short)(rw2[j >> 1] >> sh); } }
        if (ct & 1) {
            u32x4 w_;
#define RW_FR(P) (w_.x = P[0].x, w_.y = P[0].y, w_.z = P[1].x, w_.w = P[1].y, __builtin_bit_cast(bf16x8, w_))
            const bf16x8 ga = RW_FR(fa2), gb = RW_FR(fb2), gk = RW_FR(fk2), gr = RW_FR(fr2);
#undef RW_FR
            Mab = MFMA16(gb, ga, Mab); Mak = MFMA16(gk, ga, Mak); Mbr = MFMA16(gb, gr, Mbr); Mkr = MFMA16(gk, gr, Mkr);
        }
    }
    bon += __shfl_xor(bon, 16); bon += __shfl_xor(bon, 32);
    if (q == 0) *(LAS float*)(sl + SL_BON + tk * 4) = bon;
#pragma unroll
    for (int j = 0; j < 4; ++j) { const int s_ = 4 * q + j; if (s_ >= tk) { Mab[j] = 0.f; Mak[j] = 0.f; } if (s_ > tk) { Mbr[j] = 0.f; Mkr[j] = 0.f; } }
    LAS float* MabL = (LAS float*)(sl + SL_AQ); LAS float* MakL = MabL + 256; LAS float* MbrL = MabL + 512; LAS float* TNL = MabL + 768;
#pragma unroll
    for (int j = 0; j < 4; ++j) { const int o_ = (4 * q + j) * 16 + tk; MabL[o_] = Mab[j]; MakL[o_] = Mak[j]; MbrL[o_] = Mbr[j]; }
    LDS_WAIT();
    float Y[16];
    {
        f32x4 mm[8][2];
#pragma unroll
        for (int i = 0; i < 8; ++i) { mm[i][0] = *(const LAS f32x4*)(MabL + (8 + i) * 16 + 8); mm[i][1] = *(const LAS f32x4*)(MabL + (8 + i) * 16 + 12); }
#pragma unroll
        for (int s_ = 15; s_ >= 8; --s_) { float acc = (s_ == tk) ? 1.0f : 0.0f;
#pragma unroll
            for (int u = s_ + 1; u < 16; ++u) acc += Y[u] * mm[s_ - 8][(u - 8) >> 2][(u - 8) & 3];
            Y[s_] = acc; }
    }
    {
        f32x4 mm[4][3];
#pragma unroll
        for (int i = 0; i < 4; ++i)
#pragma unroll
            for (int g4 = 0; g4 < 3; ++g4) mm[i][g4] = *(const LAS f32x4*)(MabL + (4 + i) * 16 + 4 + 4 * g4);
#pragma unroll
        for (int s_ = 7; s_ >= 4; --s_) { float acc = (s_ == tk) ? 1.0f : 0.0f;
#pragma unroll
            for (int u = s_ + 1; u < 16; ++u) acc += Y[u] * mm[s_ - 4][(u - 4) >> 2][(u - 4) & 3];
            Y[s_] = acc; }
    }
    {
        f32x4 mm[4][4];
#pragma unroll
        for (int i = 0; i < 4; ++i)
#pragma unroll
            for (int g4 = 0; g4 < 4; ++g4) mm[i][g4] = *(const LAS f32x4*)(MabL + i * 16 + 4 * g4);
#pragma unroll
        for (int s_ = 3; s_ >= 0; --s_) { float acc = (s_ == tk) ? 1.0f : 0.0f;
#pragma unroll
            for (int u = s_ + 1; u < 16; ++u) acc += Y[u] * mm[s_][u >> 2][u & 3];
            Y[s_] = acc; }
    }
    if (q == 0) {
#pragma unroll
        for (int s_ = 0; s_ < 16; ++s_) TNL[s_ * 16 + tk] = Y[s_];
    }
    LDS_WAIT();
    float mbc[16];
#pragma unroll
    for (int u = 0; u < 16; ++u) mbc[u] = MbrL[u * 16 + tk];
    f32x4 Nq;
#pragma unroll
    for (int j = 0; j < 4; ++j) {
        const LAS float* row = TNL + (4 * q + j) * 16; float acc = 0.f;
#pragma unroll
        for (int g4 = 0; g4 < 4; ++g4) { const f32x4 x = *(const LAS f32x4*)(row + 4 * g4); acc += (x[0] * mbc[4 * g4] + x[1] * mbc[4 * g4 + 1]) + (x[2] * mbc[4 * g4 + 2] + x[3] * mbc[4 * g4 + 3]); }
        Nq[j] = acc;
    }
    LDS_WAIT();
#pragma unroll
    for (int j = 0; j < 4; ++j) TNL[(4 * q + j) * 16 + tk] = Nq[j];
    LDS_WAIT();
    float Nc[16];
#pragma unroll
    for (int u = 0; u < 16; ++u) Nc[u] = TNL[u * 16 + tk];
    f32x4 Gq, Hq;
#pragma unroll
    for (int j = 0; j < 4; ++j) {
        const LAS float* row = MakL + (4 * q + j) * 16; float ag_ = 0.f, ah_ = 0.f;
#pragma unroll
        for (int g4 = 0; g4 < 4; ++g4) { const f32x4 x = *(const LAS f32x4*)(row + 4 * g4);
            ag_ += (x[0] * Y[4 * g4] + x[1] * Y[4 * g4 + 1]) + (x[2] * Y[4 * g4 + 2] + x[3] * Y[4 * g4 + 3]);
            ah_ += (x[0] * Nc[4 * g4] + x[1] * Nc[4 * g4 + 1]) + (x[2] * Nc[4 * g4 + 2] + x[3] * Nc[4 * g4 + 3]); }
        Gq[j] = ag_; Hq[j] = ah_ + Mkr[j];
    }
    bf16x8 bA, bQ;
    { float xa[8], xq[8];
#pragma unroll
      for (int e = 0; e < 8; ++e) {
          xa[e] = (q == 2) ? Y[e] : ((q == 3) ? Y[8 + e] : 0.f);
          xq[e] = (q == 2) ? Nc[e] : ((q == 3) ? Nc[8 + e] : (((q << 3) + e == tk) ? 1.0f : 0.f));
      }
      bA = pack8f(xa); bQ = pack8f(xq); }
    f32x4 dA[4], dQ[4];
#pragma unroll
    for (int ct = 0; ct < 4; ++ct) {
        const int crow = 16 * ct + tk;
        const bf16x8 af = *(const LAS bf16x8*)(sl + ((q < 2) ? SL_KT : SL_VT) + crow * T_STR + (q & 1) * 16);
        const f32x4 z = {0.f, 0.f, 0.f, 0.f};
        dA[ct] = MFMA16(af, bA, z); dQ[ct] = MFMA16(af, bQ, z);
    }
    LDS_WAIT();
#pragma unroll
    for (int ct = 0; ct < 4; ++ct) {
        u32x2 o; o.x = pk2(dA[ct][0], dA[ct][1]); o.y = pk2(dA[ct][2], dA[ct][3]); *(LAS u32x2*)(sl + SL_AQ + tk * AQ_STR + (16 * ct + 4 * q) * 2) = o;
        o.x = pk2(dQ[ct][0], dQ[ct][1]); o.y = pk2(dQ[ct][2], dQ[ct][3]); *(LAS u32x2*)(sl + SL_AQ + (16 + tk) * AQ_STR + (16 * ct + 4 * q) * 2) = o;
    }
    { u32x2 o; o.x = pk2(Gq[0], Gq[1]); o.y = pk2(Gq[2], Gq[3]); *(LAS u32x2*)(sl + SL_GH + tk * GH_STR + (4 * q) * 2) = o;
      o.x = pk2(Hq[0], Hq[1]); o.y = pk2(Hq[2], Hq[3]); *(LAS u32x2*)(sl + SL_GH + (16 + tk) * GH_STR + (4 * q) * 2) = o; }
#pragma unroll
    for (int ct = 0; ct < 4; ++ct) {
        const unsigned kw[2] = {Kbp[ct].x, Kbp[ct].y};
        const unsigned vw[2] = {vvp[ct].x, vvp[ct].y};
#pragma unroll
        for (int j = 0; j < 4; ++j) {
            const int c = 16 * ct + 4 * q + j; const int sh = (j & 1) * 16;
            *(LAS unsigned short*)(sl + SL_KT + c * T_STR + tk * 2) = (unsigned short)(kw[j >> 1] >> sh);
            *(LAS unsigned short*)(sl + SL_VT + c * T_STR + tk * 2) = (unsigned short)(vw[j >> 1] >> sh);
        }
    }
    flag_set(FLG + hw, k + 1, ln);
}
DI bf16x8 pack_acc8(const f32x16& x, int s2) {
    u32x4 w;
    if (s2 == 0) { w.x = pk2(x[0], x[1]); w.y = pk2(x[2], x[3]); w.z = pk2(x[4], x[5]); w.w = pk2(x[6], x[7]); }
    else { w.x = pk2(x[8], x[9]); w.y = pk2(x[10], x[11]); w.z = pk2(x[12], x[13]); w.w = pk2(x[14], x[15]); }
    return __builtin_bit_cast(bf16x8, w);
}
DI void rwkv_phase(const Params& p, LAS unsigned char* lds, int G, int kwid) {
    const int wid = kwid;
    unsigned char* ws = p.ws;
    volatile LAS unsigned* FLG = (volatile LAS unsigned*)(lds + RW_FLG);
    for (int bh = blockIdx.x; bh < BATCH * 8; bh += G) {
        const int b = bh >> 3, h = bh & 7;
        RwSeq sq;
        sq.prw_p = (const GAS bf16_t*)(ws + WS_PRW) + (size_t)(b * SEQ) * RW_COLS; sq.prw_s = (const GAS bf16_t*)(ws + WS_PRW) + (size_t)(MP + b * DEC_SEQ) * RW_COLS;
        sq.act_p = (const GAS bf16_t*)(ws + WS_X1B) + (size_t)(b * SEQ) * 288; sq.act_s = (const GAS bf16_t*)(ws + WS_X1B) + (size_t)(MP + b * DEC_SEQ) * 288;
        sq.mix_p = (GAS bf16_t*)(ws + WS_MIX) + (size_t)(b * SEQ) * 1024; sq.mix_s = (GAS bf16_t*)(ws + WS_MIX) + (size_t)(MP + b * DEC_SEQ) * 1024;
        sq.shift0 = (const GAS float*)p.in[5] + (size_t)b * RW_COLS;
        sq.wkv0 = (const GAS float*)p.in[4] + (size_t)bh * 4096;
        sq.wkv_out_p = (GAS float*)p.out + O_PW + (size_t)bh * 4096; sq.wkv_out_s = (GAS float*)p.out + O_SW + (size_t)bh * 4096;
        sq.h = h;
        constexpr int NC = RW_NC;
        __syncthreads();
        int td = wid * 64 + lane_id(); asm volatile("" : "+v"(td));
        { const GAS bf16_t* W2T = (const GAS bf16_t*)(ws + WS_W2T) + (size_t)(64 * h) * 64; const GAS bf16_t* A2T = (const GAS bf16_t*)(ws + WS_A2T) + (size_t)(64 * h) * 64;
          const GAS bf16_t* G2T = (const GAS bf16_t*)(ws + WS_G2T) + (size_t)(64 * h) * 160;
          { const int row = td >> 3, ch = td & 7;
            *(LAS u32x4*)(lds + RW_LW2 + row * 144 + ch * 16) = *(const GAS u32x4*)(W2T + row * 64 + ch * 8);
            *(LAS u32x4*)(lds + RW_LA2 + row * 144 + ch * 16) = *(const GAS u32x4*)(A2T + row * 64 + ch * 8); }
          for (int i = td; i < 64 * 20; i += 512) { const int row = i / 20, ch = i % 20; *(LAS u32x4*)(lds + RW_LG2 + row * 336 + ch * 16) = *(const GAS u32x4*)(G2T + row * 160 + ch * 8); }
          LAS float* CV = (LAS float*)(lds + RW_CV);
          if (td < 64) {
              const int c = 64 * h + td;
              CV[CV_W0 * 64 + td] = ((const GAS float*)p.in[12])[c]; CV[CV_A0 * 64 + td] = ((const GAS float*)p.in[14])[c];
              CV[CV_KK * 64 + td] = ((const GAS float*)p.in[17])[c]; CV[CV_KA * 64 + td] = ((const GAS float*)p.in[18])[c];
              CV[CV_RK * 64 + td] = ((const GAS float*)p.in[19])[c]; CV[CV_LG * 64 + td] = ((const GAS float*)p.in[20])[c];
              CV[CV_LB * 64 + td] = ((const GAS float*)p.in[21])[c];
              const GAS float* mu = (const GAS float*)p.in[11];
              CV[CV_MR * 64 + td] = mu[c]; CV[CV_MK * 64 + td] = mu[512 + c]; CV[CV_MV * 64 + td] = mu[1024 + c];
          }
          if (td >= 384 && td < 384 + 16) FLG[td - 384] = 0u;
        }
        __syncthreads();
        if (wid == 0) {
            __builtin_amdgcn_s_setprio(3);
            int ln = lane_id(); asm volatile("" : "+v"(ln));
            const int r = ln & 31, hh = ln >> 5;
            f32x16 St[2][2];
#pragma unroll
            for (int jt = 0; jt < 2; ++jt)
#pragma unroll
                for (int nt = 0; nt < 2; ++nt)
#pragma unroll
                    for (int i = 0; i < 16; ++i) St[jt][nt][i] = 0.f;
            for (int m = 0; m < NC; ++m) {
                const int hw = m % NHELP; const unsigned k = (unsigned)(m / NHELP);
                LAS unsigned char* sl = lds + RW_SLOTS + hw * SLOT_BYTES;
                if (m == NC - 1) {
#pragma unroll
                    for (int jt = 0; jt < 2; ++jt)
#pragma unroll
                        for (int nt = 0; nt < 2; ++nt)
#pragma unroll
                            for (int g4 = 0; g4 < 4; ++g4) {
                                const size_t o_ = (size_t)(32 * nt + r) * 64 + 32 * jt + 8 * g4 + 4 * hh;
                                *(GAS f32x4*)(sq.wkv_out_p + o_) = (f32x4){St[jt][nt][4 * g4], St[jt][nt][4 * g4 + 1], St[jt][nt][4 * g4 + 2], St[jt][nt][4 * g4 + 3]};
                                const f32x4 x = *(const GAS f32x4*)(sq.wkv0 + o_);
                                St[jt][nt][4 * g4] = x[0]; St[jt][nt][4 * g4 + 1] = x[1]; St[jt][nt][4 * g4 + 2] = x[2]; St[jt][nt][4 * g4 + 3] = x[3];
                            }
                }
                flag_wait(FLG + hw, k + 1);
                f32x16 P1[2];
#pragma unroll
                for (int nt = 0; nt < 2; ++nt)
#pragma unroll
                    for (int i = 0; i < 16; ++i) P1[nt][i] = 0.f;
#pragma unroll
                for (int jt = 0; jt < 2; ++jt)
#pragma unroll
                    for (int s2 = 0; s2 < 2; ++s2) {
                        const LAS unsigned char* ap = sl + SL_AQ + r * AQ_STR + (32 * jt + 16 * s2 + 4 * hh) * 2;
                        const u32x2 a0 = *(const LAS u32x2*)ap, a1 = *(const LAS u32x2*)(ap + 16);
                        u32x4 aw_; aw_.x = a0.x; aw_.y = a0.y; aw_.z = a1.x; aw_.w = a1.y;
                        const bf16x8 af = __builtin_bit_cast(bf16x8, aw_);
#pragma unroll
                        for (int nt = 0; nt < 2; ++nt) P1[nt] = MFMA32(af, pack_acc8(St[jt][nt], s2), P1[nt]);
                    }
                bf16x8 vf[2];
                { const bf16x8 gf = *(const LAS bf16x8*)(sl + SL_GH + r * GH_STR + hh * 16);
#pragma unroll
                  for (int nt = 0; nt < 2; ++nt) { vf[nt] = *(const LAS bf16x8*)(sl + SL_VT + (32 * nt + r) * T_STR + hh * 16); P1[nt] = MFMA32(gf, vf[nt], P1[nt]); } }
#pragma unroll
                for (int jt = 0; jt < 2; ++jt) {
                    const LAS unsigned char* bp = sl + SL_BT + (32 * jt + r) * BT_STR + (4 * hh) * 2;
                    const u32x2 b0 = *(const LAS u32x2*)bp, b1 = *(const LAS u32x2*)(bp + 16);
                    u32x4 bw_; bw_.x = b0.x; bw_.y = b0.y; bw_.z = b1.x; bw_.w = b1.y;
                    const bf16x8 bf_ = __builtin_bit_cast(bf16x8, bw_);
                    const bf16x8 kf_ = *(const LAS bf16x8*)(sl + SL_KT + (32 * jt + r) * T_STR + hh * 16);
                    f32x4 wv[4];
#pragma unroll
                    for (int g4 = 0; g4 < 4; ++g4) wv[g4] = *(const LAS f32x4*)(sl + SL_WV + (32 * jt + 8 * g4 + 4 * hh) * 4);
#pragma unroll
                    for (int nt = 0; nt < 2; ++nt) {
                        f32x16 c_;
#pragma unroll
                        for (int i = 0; i < 16; ++i) c_[i] = St[jt][nt][i] * wv[i >> 2][i & 3];
                        c_ = MFMA32(bf_, pack_acc8(P1[nt], 0), c_);
                        St[jt][nt] = MFMA32(kf_, vf[nt], c_);
                    }
                }
                asm volatile("s_waitcnt lgkmcnt(0)" ::: "memory");
#pragma unroll
                for (int nt = 0; nt < 2; ++nt)
#pragma unroll
                    for (int i = 8; i < 16; ++i) { const int t_ = (i & 3) + 8 * ((i >> 2) & 1) + 4 * hh; *(LAS float*)(sl + SL_AQ + (t_ * 64 + 32 * nt + r) * 4) = P1[nt][i]; }
                flag_set(FLG + 8 + hw, k + 1, ln);
            }
#pragma unroll
            for (int jt = 0; jt < 2; ++jt)
#pragma unroll
                for (int nt = 0; nt < 2; ++nt)
#pragma unroll
                    for (int g4 = 0; g4 < 4; ++g4)
                        *(GAS f32x4*)(sq.wkv_out_s + (size_t)(32 * nt + r) * 64 + 32 * jt + 8 * g4 + 4 * hh) = (f32x4){St[jt][nt][4 * g4], St[jt][nt][4 * g4 + 1], St[jt][nt][4 * g4 + 2], St[jt][nt][4 * g4 + 3]};
            __builtin_amdgcn_s_setprio(0);
        } else {
            int ln = lane_id(); asm volatile("" : "+v"(ln));
            const int hw = wid - 1;
            unsigned k = 0; int mlast = -1;
            for (int m = hw; m < NC; m += NHELP, ++k) { rw_helper_chunk(lds, sq, m, k, hw, ln); mlast = m; }
            if (mlast >= 0) { flag_wait(FLG + 8 + hw, k); rw_post_chunk(lds, sq, mlast, hw, ln); }
        }
    }
    __syncthreads();
}

#define XB_TMO      128
#define XB_XCNT(j)  (256  + 64 * (j))
#define XB_XSUB(j)  (1280 + 64 * (j))
#define XB_XGEN(j)  (2304 + 64 * (j))
#define XB_TOP      3328
#define XB_TOPGEN   3392
#define XCD_BAR_WORDS 3456
#define XB_SPIN_CAP (1u << 18)

__device__ __forceinline__ unsigned xb_ld(unsigned* p)              { return __hip_atomic_load(p, __ATOMIC_RELAXED, __HIP_MEMORY_SCOPE_AGENT); }
__device__ __forceinline__ unsigned xb_add(unsigned* p, unsigned v) { return __hip_atomic_fetch_add(p, v, __ATOMIC_RELAXED, __HIP_MEMORY_SCOPE_AGENT); }
__device__ __forceinline__ unsigned xb_xcc_id() { return (unsigned)__builtin_amdgcn_s_getreg((3 << 11) | 20) & 0xFu; }
#define XB_SPIN(cond, bar) do { unsigned _sp = 0; while (cond) { __builtin_amdgcn_s_sleep(1); \
    if ((++_sp & 255u) == 0u) { if (xb_ld(&(bar)[XB_TMO])) break; if (_sp > XB_SPIN_CAP) { atomicAdd(&(bar)[XB_TMO], 1u); break; } } } } while (0)

struct XcdBarrier {
    int wid;
    unsigned* bar; unsigned x;
    volatile LAS unsigned* st;
};

__device__ __forceinline__ XcdBarrier xcd_barrier_post(unsigned* bar, volatile LAS unsigned* st, int kwid) {
    XcdBarrier b; b.wid = kwid; b.bar = bar; b.x = xb_xcc_id(); b.st = st;
    if (kwid == 0 && lane_id() == 0) (void)xb_add(&bar[XB_XCNT(b.x)], 1u);
    return b;
}
__device__ __forceinline__ void xcd_barrier_complete(unsigned* bar, unsigned x, unsigned& nloc, unsigned& nx) {
    const unsigned G = gridDim.x * gridDim.y * gridDim.z;
    unsigned sum, cnt, mine, sp = 0u;
    for (;;) {
        sum = 0u; cnt = 0u; mine = 0u;
#pragma unroll
        for (unsigned j = 0; j < 16; ++j) { const unsigned c = xb_ld(&bar[XB_XCNT(j)]); sum += c; cnt += (c > 0u) ? 1u : 0u; mine = (j == x) ? c : mine; }
        if (sum == G) break;
        __builtin_amdgcn_s_sleep(1);
        if ((++sp & 255u) == 0u) { if (xb_ld(&bar[XB_TMO])) break; if (sp > XB_SPIN_CAP) { atomicAdd(&bar[XB_TMO], 1u); break; } }
    }
    nloc = mine > 0u ? mine : 1u; nx = cnt > 0u ? cnt : 1u;
}

__device__ __forceinline__ void xcd_barrier(const XcdBarrier& b) {
    asm volatile("s_waitcnt vmcnt(0)" ::: "memory");
    __syncthreads();
    if (b.wid == 0 && lane_id() == 0) {
        unsigned* bar = b.bar;
        __builtin_amdgcn_s_waitcnt(0);
        unsigned nloc = b.st[0], nx = b.st[1];
        if (nloc == 0u) { xcd_barrier_complete(bar, b.x, nloc, nx); b.st[0] = nloc; b.st[1] = nx; }
        const unsigned old = xb_add(&bar[XB_XSUB(b.x)], 1u);
        const unsigned gen = old / nloc;
        if (old + 1u == (gen + 1u) * nloc) {
            __builtin_amdgcn_fence(__ATOMIC_RELEASE, "agent");
            asm volatile("s_waitcnt vmcnt(0)" ::: "memory");
            const unsigned og = xb_add(&bar[XB_TOP], 1u);
            const unsigned tg = og / nx;
            if (og + 1u == (tg + 1u) * nx) xb_add(&bar[XB_TOPGEN], 1u);
            else XB_SPIN(xb_ld(&bar[XB_TOPGEN]) == tg, bar);
            __builtin_amdgcn_fence(__ATOMIC_ACQUIRE, "agent");
            xb_add(&bar[XB_XGEN(b.x)], 1u);
            asm volatile("s_waitcnt vmcnt(0)" ::: "memory");
        } else {
            XB_SPIN(xb_ld(&bar[XB_XGEN(b.x)]) == gen, bar);
            __builtin_amdgcn_fence(__ATOMIC_ACQUIRE, "agent");
            asm volatile("s_waitcnt vmcnt(0)" ::: "memory");
        }
    }
    __syncthreads();
}

DI void finish_out(const Params& p, int G, int kwid) {
    const int lane = lane_id(), gw = blockIdx.x * 8 + kwid, NGW = G * 8;
    const GAS float* slab = (const GAS float*)(p.ws + WS_SLAB); const GAS float* xs = (const GAS float*)p.in[1];
    GAS float* out = (GAS float*)p.out; GAS bf16_t* X1B = (GAS bf16_t*)(p.ws + WS_X1B); const GAS float* SSQ = (const GAS float*)(p.ws + WS_SSQ); GAS float* SS1 = (GAS float*)(p.ws + WS_SS1);
    for (int r = gw; r < MS; r += NGW) {
        float ss = 0.f;
#pragma unroll
        for (int j = 0; j < 4; ++j) {
            const size_t o = (size_t)r * 1024 + 4 * lane + 256 * j;
            f32x4 v = *(const GAS f32x4*)(xs + o);
#pragma unroll
            for (int sp = 0; sp < SPLIT_OUT; ++sp) v += *(const GAS f32x4*)(slab + (size_t)sp * MS * 1024 + o);
            *(GAS f32x4*)(out + (size_t)MP * 1024 + o) = v;
            u32x2 w; w.x = pk2(v[0], v[1]); w.y = pk2(v[2], v[3]); *(GAS u32x2*)(X1B + (size_t)MP * 1024 + o) = w;
            ss += (v[0] * v[0] + v[1] * v[1]) + (v[2] * v[2] + v[3] * v[3]);
        }
        ss = wave_sum(ss);
        if (lane == 0) SS1[MP + r] = ss;
    }
    for (int r = blockIdx.x * 512 + kwid * 64 + lane; r < MP; r += G * 512) {
        const GAS f32x4* sp = (const GAS f32x4*)(SSQ + (size_t)r * 16);
        const f32x4 t4 = (sp[0] + sp[1]) + (sp[2] + sp[3]);
        SS1[r] = (t4[0] + t4[1]) + (t4[2] + t4[3]);
    }
}
DI void finish_down(const Params& p, int G, int kwid) {
    const GAS float* slab = (const GAS float*)(p.ws + WS_SLAB); GAS float* out = (GAS float*)p.out + (size_t)MP * 1024;
    for (int i = blockIdx.x * 512 + kwid * 64 + lane_id(); i < MS * 256; i += G * 512) {
        f32x4 v = *(const GAS f32x4*)(out + (size_t)i * 4);
#pragma unroll
        for (int sp = 0; sp < SPLIT_DN; ++sp) v += *(const GAS f32x4*)(slab + (size_t)sp * MS * 1024 + (size_t)i * 4);
        *(GAS f32x4*)(out + (size_t)i * 4) = v;
    }
}

__global__ void __launch_bounds__(512, 2) fwd_kernel(Params p) {
    extern __shared__ __attribute__((aligned(16))) unsigned char lds_raw[];
    LAS unsigned char* lds = (LAS unsigned char*)lds_raw;
    const int G = gridDim.x;
    unsigned char* ws = p.ws;
    const int lo = p.ph_lo, hi = p.ph_hi;
#define IN(k) (lo <= (k) && (k) < hi)
    const int kwid = __builtin_amdgcn_readfirstlane((int)(threadIdx.x >> 6));
    volatile LAS unsigned* bst = (volatile LAS unsigned*)(lds + LDS_BYTES - 16);
    if (threadIdx.x < 4) bst[threadIdx.x] = 0u;
    __syncthreads();
    const XcdBarrier bar = xcd_barrier_post((unsigned*)(ws + WS_CTL), bst, kwid);
#define SEAM(k) do { if (IN(k) && IN((k) + 1)) { xcd_barrier(bar); } } while (0)
    if (IN(0)) { phase0(p, lds, G, kwid); }
    SEAM(0);
    if (IN(1)) {
        pg8::Gemm g{(const bf16_t*)(ws + WS_H), (const bf16_t*)(ws + WS_WIN), MT, IN_PAD, 1024}; pg8::StaticOrder S; S.init(MT, IN_PAD, 1024, G, (int)blockIdx.x);
        EpiIn E{(GAS bf16_t*)(ws + WS_Q), (GAS bf16_t*)(ws + WS_K), (GAS bf16_t*)(ws + WS_V), (GAS bf16_t*)(ws + WS_PRW), (GAS float*)p.out, (const GAS float*)(ws + WS_ROPE), (const GAS float*)p.in[8], (const GAS float*)p.in[9]};
        pg8::gemm_phase<EpiIn, pg8::StaticOrder>(lds, g, S, E, kwid);
    }
    SEAM(1);
    if (IN(2)) { lora_act_pass(p, G, kwid); attn_phase(p, lds, G, kwid); xcd_barrier(bar); rwkv_phase(p, lds, G, kwid); }
    SEAM(2);
    if (IN(3)) {
        pg8::Gemm g{(const bf16_t*)(ws + WS_MIX), (const bf16_t*)(ws + WS_WOUT), MT, 1024, 1024}; pg8::StaticOrder S; S.init(MT, 1024, 1024, G, (int)blockIdx.x, MP, SPLIT_OUT);
        EpiOut E{(const GAS float*)p.in[0], (const GAS float*)p.in[1], (GAS float*)p.out, (GAS bf16_t*)(ws + WS_X1B), (GAS float*)(ws + WS_SSQ), (GAS float*)(ws + WS_SLAB)};
        pg8::gemm_phase<EpiOut, pg8::StaticOrder>(lds, g, S, E, kwid);
        xcd_barrier(bar);
        finish_out(p, G, kwid);
    }
    SEAM(3);
    if (IN(4)) {
        pg8::Gemm g{(const bf16_t*)(ws + WS_X1B), (const bf16_t*)(ws + WS_WUP), MT, D_FF, 1024}; pg8::StaticOrder S; S.init(MT, D_FF, 1024, G, (int)blockIdx.x);
        EpiUp E{(const GAS float*)(ws + WS_SS1), (GAS bf16_t*)(ws + WS_U)};
        pg8::gemm_phase<EpiUp, pg8::StaticOrder>(lds, g, S, E, kwid);
    }
    SEAM(4);
    if (IN(5)) {
        pg8::Gemm g{(const bf16_t*)(ws + WS_U), (const bf16_t*)(ws + WS_WDN), MT, 1024, D_FF}; pg8::StaticOrder S; S.init(MT, 1024, D_FF, G, (int)blockIdx.x, MP, SPLIT_DN);
        EpiDown E{(GAS float*)p.out, (GAS float*)(ws + WS_SLAB), (const GAS bf16_t*)(ws + WS_X1B)};
        pg8::gemm_phase<EpiDown, pg8::StaticOrder>(lds, g, S, E, kwid);
        xcd_barrier(bar);
        finish_down(p, G, kwid);
    }
#undef IN
#undef SEAM
}

extern "C" void kernel_launch(void* const* d_in, const int* in_sizes, int n_in, void* d_out, int out_size, void* d_ws, size_t ws_size, hipStream_t stream) {
    static int grid = 0;
    if (grid == 0) {
        if (n_in != 26 || ws_size < WS_END) { fprintf(stderr, "kernel_launch: expected 26 inputs and >= %zu bytes of workspace (got %d, %zu)\n", (size_t)WS_END, n_in, ws_size); grid = -1; return; }
        int dev = 0, cus = 0, per_cu = 0;
        hipGetDevice(&dev);
        hipDeviceGetAttribute(&cus, hipDeviceAttributeMultiprocessorCount, dev);
        if (hipFuncSetAttribute((const void*)fwd_kernel, hipFuncAttributeMaxDynamicSharedMemorySize, LDS_BYTES) != hipSuccess) { fprintf(stderr, "kernel_launch: hipFuncSetAttribute failed\n"); grid = -1; return; }
        if (hipOccupancyMaxActiveBlocksPerMultiprocessor(&per_cu, (const void*)fwd_kernel, 512, LDS_BYTES) != hipSuccess || per_cu < 1) { fprintf(stderr, "kernel_launch: occupancy query failed (%d)\n", per_cu); (void)hipGetLastError(); per_cu = 1; }
        grid = cus * per_cu;
        if (grid > 256) grid = 256;
    }
    if (grid < 0) return;
    Params a{};
    for (int i = 0; i < 26; ++i) a.in[i] = (const float*)d_in[i];
    a.out = (float*)d_out; a.ws = (unsigned char*)d_ws;
#if MK_N_LAUNCHES == 1
    a.ph_lo = 0; a.ph_hi = 6;
    if (hipMemsetAsync((char*)d_ws + WS_CTL, 0, CTL_BYTES, stream) != hipSuccess) { fprintf(stderr, "kernel_launch: memset of the barrier words failed\n"); return; }
    hipLaunchKernelGGL(fwd_kernel, dim3(grid), dim3(512), LDS_BYTES, stream, a);
    { const hipError_t e = hipPeekAtLastError(); if (e != hipSuccess) fprintf(stderr, "launch failed: %s (grid %d)\n", hipGetErrorString(e), grid); }
#else
    for (int ph = 0; ph < 6; ++ph) {
        a.ph_lo = ph; a.ph_hi = ph + 1;
        hipLaunchKernelGGL(fwd_kernel, dim3(grid), dim3(512), LDS_BYTES, stream, a);
    }
#endif
}
```
